# Optimizing an MI355X kernel written in HIP

```python
import math
import jax
import jax.numpy as jnp
from jax import lax
import numpy as np

D_MODEL = 1024
BATCH = 8
SEQ = 4096
DEPTH = 4

CTX_LEN = 256
GRID_W = 64
N_MIXERS = 3
EPS = 1e-6

NA_HEADS = 16
NA_HEAD_DIM = D_MODEL // NA_HEADS
NA_WIN_H = 8
NA_WIN_W = 16
NA_QBLOCK_W = NA_WIN_W
NA_KBLOCK_W = 2 * NA_WIN_W

ML_HEADS = 4
ML_INNER = 2 * D_MODEL
ML_HEAD_DIM = ML_INNER // ML_HEADS
ML_BLOCK = 4
ML_CONV_K = 5
ML_CHUNK = 64

DA_HEADS = 8
DA_HEAD_DIM = D_MODEL // (2 * DA_HEADS)
DA_QBLOCK = 128
ROPE_BASE = 10000.0

MOE_GROUPS = 4
MOE_EXPERTS_PER_GROUP = 8
MOE_N_EXPERTS = MOE_GROUPS * MOE_EXPERTS_PER_GROUP
MOE_TOP_K = 2
MOE_HIDDEN = 512

kernel_name = 'hybrid_natten_mlstm_diffattn_hmoe_dit'


def rms_norm(x, g):
    xf = x.astype(jnp.float32)
    y = xf * lax.rsqrt(jnp.mean(xf * xf, axis=-1, keepdims=True) + EPS)
    return (y * g.astype(jnp.float32)).astype(x.dtype)


def modulate(x, g, shift, scale):
    return rms_norm(x, g) * (1.0 + scale) + shift


def _col_tables():
    n_cb = GRID_W // NA_QBLOCK_W
    q_col = np.arange(GRID_W).reshape(n_cb, NA_QBLOCK_W)
    k_start = np.clip(q_col[:, 0] - NA_WIN_W // 2, 0, GRID_W - NA_KBLOCK_W)
    k_col = k_start[:, None] + np.arange(NA_KBLOCK_W)
    w_start = np.clip(q_col - NA_WIN_W // 2, 0, GRID_W - NA_WIN_W)
    valid = (k_col[:, None, :] >= w_start[..., None]) & (k_col[:, None, :] < w_start[..., None] + NA_WIN_W)
    dx = np.clip(k_col[:, None, :] - q_col[..., None], -(NA_WIN_W - 1), NA_WIN_W - 1) + NA_WIN_W - 1
    return k_start, valid, dx


def neighbourhood_attention(hx, hc, w_qkv, w_o, rpb, with_ctx_out):
    b, s, d = hx.shape
    n_ctx = hc.shape[1]
    rows = s // GRID_W
    kh = min(NA_WIN_H, rows)
    n_cb = GRID_W // NA_QBLOCK_W
    nw = kh * NA_KBLOCK_W
    scale = NA_HEAD_DIM ** -0.5
    qkv = (hx @ w_qkv).reshape(b, s, 3, NA_HEADS, NA_HEAD_DIM)
    qg = qkv[:, :, 0].reshape(b, rows, n_cb, NA_QBLOCK_W, NA_HEADS, NA_HEAD_DIM)
    kg = qkv[:, :, 1].reshape(b, rows, GRID_W, NA_HEADS, NA_HEAD_DIM)
    vg = qkv[:, :, 2].reshape(b, rows, GRID_W, NA_HEADS, NA_HEAD_DIM)
    kvc = (hc @ w_qkv[:, d:]).reshape(b, n_ctx, 2, NA_HEADS, NA_HEAD_DIM)
    kc, vc = kvc[:, :, 0], kvc[:, :, 1]
    k_start, valid, dx = _col_tables()
    mask = jnp.asarray(np.broadcast_to(valid[:, :, None, :], (n_cb, NA_QBLOCK_W, kh, NA_KBLOCK_W)).reshape(n_cb, NA_QBLOCK_W, nw))

    def row_block(r):
        rs = jnp.clip(r - kh // 2, 0, rows - kh)
        kr = lax.dynamic_slice_in_dim(kg, rs, kh, axis=1)
        vr = lax.dynamic_slice_in_dim(vg, rs, kh, axis=1)
        kb = jnp.stack([kr[:, :, int(ks):int(ks) + NA_KBLOCK_W] for ks in k_start], axis=1).reshape(b, n_cb, nw, NA_HEADS, NA_HEAD_DIM)
        vb = jnp.stack([vr[:, :, int(ks):int(ks) + NA_KBLOCK_W] for ks in k_start], axis=1).reshape(b, n_cb, nw, NA_HEADS, NA_HEAD_DIM)
        qr = lax.dynamic_index_in_dim(qg, r, axis=1, keepdims=False)
        dy = rs - r + jnp.arange(kh) + NA_WIN_H - 1
        bias = rpb[:, dy][:, :, dx]
        bias = bias.transpose(0, 2, 3, 1, 4).reshape(NA_HEADS, n_cb, NA_QBLOCK_W, nw).astype(jnp.float32)
        s_win = jnp.einsum('bnqhd,bnkhd->bhnqk', qr, kb).astype(jnp.float32) * scale + bias
        s_win = jnp.where(mask, s_win, -jnp.inf)
        s_ctx = jnp.einsum('bnqhd,bkhd->bhnqk', qr, kc).astype(jnp.float32) * scale
        p = jax.nn.softmax(jnp.concatenate([s_win, s_ctx], axis=-1), axis=-1).astype(hx.dtype)
        return (jnp.einsum('bhnqk,bnkhd->bnqhd', p[..., :nw], vb)
                + jnp.einsum('bhnqk,bkhd->bnqhd', p[..., nw:], vc))

    o = lax.map(row_block, jnp.arange(rows))
    ox = jnp.moveaxis(o, 0, 1).reshape(b, s, d) @ w_o
    oc = None
    if with_ctx_out:
        qc = (hc @ w_qkv[:, :d]).reshape(b, n_ctx, NA_HEADS, NA_HEAD_DIM)
        sc = jnp.einsum('bqhd,bkhd->bhqk', qc, kc).astype(jnp.float32) * scale
        pc = jax.nn.softmax(sc, axis=-1).astype(hc.dtype)
        oc = jnp.einsum('bhqk,bkhd->bqhd', pc, vc).reshape(b, n_ctx, d) @ w_o
    return ox, oc


def _centred_dwconv(x, w, bias):
    k, ch = w.shape
    y = lax.conv_general_dilated(x, w[:, None, :].astype(x.dtype), window_strides=(1,),
                                 padding=[(k // 2, k // 2)], dimension_numbers=('NWC', 'WIO', 'NWC'),
                                 feature_group_count=ch)
    return y + bias


def _headwise(x, w):
    b, t, _ = x.shape
    return jnp.einsum('btgi,gio->btgo', x.reshape(b, t, -1, ML_BLOCK), w).reshape(b, t, -1)


def _to_heads(a):
    b, t, _ = a.shape
    return a.reshape(b, t, ML_HEADS, ML_HEAD_DIM).transpose(0, 2, 1, 3).astype(jnp.float32)


def _mlstm_scan(q, k, v, i_pre, log_f, state):
    b, h, t, dh = q.shape
    nc = t // ML_CHUNK
    causal = jnp.tril(jnp.ones((ML_CHUNK, ML_CHUNK), dtype=bool))

    def to_chunks(a):
        return jnp.moveaxis(a.reshape(b, h, nc, ML_CHUNK, *a.shape[3:]), 2, 0)

    def step(carry, xs):
        c_prev, n_prev, m_prev = carry
        qc, kc, vc, ic, fc = xs
        bcum = jnp.cumsum(fc, axis=-1)
        logd = bcum[..., :, None] - bcum[..., None, :] + ic[..., None, :]
        logd = jnp.where(causal, logd, -jnp.inf)
        log_inter = bcum + m_prev[..., None]
        m_j = jnp.maximum(log_inter, jnp.max(logd, axis=-1))
        dmat = jnp.exp(logd - m_j[..., None])
        inter = jnp.exp(log_inter - m_j)
        sc = jnp.einsum('bhjd,bhsd->bhjs', qc, kc) * dmat
        num = inter[..., None] * jnp.einsum('bhjd,bhde->bhje', qc, c_prev) + jnp.einsum('bhjs,bhse->bhje', sc, vc)
        den = inter * jnp.einsum('bhjd,bhd->bhj', qc, n_prev) + jnp.sum(sc, axis=-1)
        h_out = num / jnp.maximum(jnp.abs(den), jnp.exp(-m_j))[..., None]
        b_last = bcum[..., -1]
        log_state = b_last[..., None] - bcum + ic
        m_new = jnp.maximum(b_last + m_prev, jnp.max(log_state, axis=-1))
        w_s = jnp.exp(log_state - m_new[..., None])
        decay = jnp.exp(b_last + m_prev - m_new)
        c_new = decay[..., None, None] * c_prev + jnp.einsum('bhs,bhsd,bhse->bhde', w_s, kc, vc)
        n_new = decay[..., None] * n_prev + jnp.einsum('bhs,bhsd->bhd', w_s, kc)
        return (c_new, n_new, m_new), h_out

    state, hs = lax.scan(step, state, (to_chunks(q), to_chunks(k), to_chunks(v), to_chunks(i_pre), to_chunks(log_f)))
    return jnp.moveaxis(hs, 0, 2).reshape(b, h, t, dh), state


def mlstm_mixer(hx, hc, w_up, conv_w, conv_b, w_q, w_k, w_v, w_gate, b_gate, gn_w, skip, w_down, with_ctx_out):
    def prep(h):
        bsz, t, _ = h.shape
        xm, z = jnp.split(h @ w_up, 2, axis=-1)
        xc = jax.nn.silu(_centred_dwconv(xm, conv_w, conv_b))
        q = _headwise(xc, w_q)
        k = _headwise(xc, w_k)
        v = _headwise(xm, w_v)
        g = (jnp.concatenate([q, k, v], axis=-1) @ w_gate + b_gate).astype(jnp.float32)
        g = g.reshape(bsz, t, 2, 2, ML_HEADS)
        i_pre = jnp.moveaxis(g[:, :, :, 0], 1, 3)
        log_f = jax.nn.log_sigmoid(jnp.moveaxis(g[:, :, :, 1], 1, 3))
        return xc, z, _to_heads(q) * ML_HEAD_DIM ** -0.5, _to_heads(k), _to_heads(v), i_pre, log_f

    def bidir(qh, kh, vh, i_pre, log_f, st_fwd, st_bwd):
        h_f, st_f = _mlstm_scan(qh, kh, vh, i_pre[:, 0], log_f[:, 0], st_fwd)
        rev = lambda a: jnp.flip(a, axis=2)
        h_b, st_b = _mlstm_scan(rev(qh), rev(kh), rev(vh), rev(i_pre[:, 1]), rev(log_f[:, 1]), st_bwd)
        return h_f + rev(h_b), st_f, st_b

    def finish(hh, xc, z):
        bsz, _, t, _ = hh.shape
        mu = jnp.mean(hh, axis=-1, keepdims=True)
        var = jnp.mean(jnp.square(hh - mu), axis=-1, keepdims=True)
        hn = ((hh - mu) * lax.rsqrt(var + EPS)).transpose(0, 2, 1, 3).reshape(bsz, t, ML_INNER).astype(xc.dtype) * gn_w
        return ((hn + skip * xc) * jax.nn.silu(z)) @ w_down

    b = hx.shape[0]
    zero = (jnp.zeros((b, ML_HEADS, ML_HEAD_DIM, ML_HEAD_DIM), jnp.float32),
            jnp.zeros((b, ML_HEADS, ML_HEAD_DIM), jnp.float32),
            jnp.full((b, ML_HEADS), -jnp.inf, jnp.float32))
    xc_c, z_c, q_c, k_c, v_c, i_c, f_c = prep(hc)
    h_c, st_f, st_b = bidir(q_c, k_c, v_c, i_c, f_c, zero, zero)
    xc_x, z_x, q_x, k_x, v_x, i_x, f_x = prep(hx)
    h_x, _, _ = bidir(q_x, k_x, v_x, i_x, f_x, st_f, st_b)
    ox = finish(h_x, xc_x, z_x)
    oc = finish(h_c, xc_c, z_c) if with_ctx_out else None
    return ox, oc


def rope_2d(x, row, col):
    half = x.shape[-1] // 2
    freqs = ROPE_BASE ** (-jnp.arange(0, half, 2, dtype=jnp.float32) / half)

    def rot(xa, pos):
        ang = pos.astype(jnp.float32)[:, None] * freqs
        cos = jnp.cos(ang)[:, None, None, :].astype(x.dtype)
        sin = jnp.sin(ang)[:, None, None, :].astype(x.dtype)
        x1, x2 = xa[..., :half // 2], xa[..., half // 2:]
        return jnp.concatenate([x1 * cos - x2 * sin, x2 * cos + x1 * sin], axis=-1)

    return jnp.concatenate([rot(x[..., :half], row), rot(x[..., half:], col)], axis=-1)


def diff_attention(hx, hc, w_qkv, lam, subln_g, w_o, lambda_init, with_ctx_out):
    b, s, d = hx.shape
    n_ctx = hc.shape[1]
    t = jnp.arange(s)
    row, col = t // GRID_W, t % GRID_W
    qkv = (hx @ w_qkv).reshape(b, s, 3, d)
    q = rope_2d(qkv[:, :, 0].reshape(b, s, DA_HEADS, 2, DA_HEAD_DIM), row, col)
    k = rope_2d(qkv[:, :, 1].reshape(b, s, DA_HEADS, 2, DA_HEAD_DIM), row, col)
    v = qkv[:, :, 2].reshape(b, s, DA_HEADS, 2 * DA_HEAD_DIM)
    kvc = (hc @ w_qkv[:, d:]).reshape(b, n_ctx, 2, d)
    kc = kvc[:, :, 0].reshape(b, n_ctx, DA_HEADS, 2, DA_HEAD_DIM)
    vc = kvc[:, :, 1].reshape(b, n_ctx, DA_HEADS, 2 * DA_HEAD_DIM)
    lf = lam.astype(jnp.float32)
    lam_full = jnp.exp(jnp.sum(lf[0] * lf[1])) - jnp.exp(jnp.sum(lf[2] * lf[3])) + lambda_init
    scale = DA_HEAD_DIM ** -0.5

    def attend(qb, keys, vals):
        sc = jnp.einsum('bqhmd,bkhmd->bhmqk', qb, keys).astype(jnp.float32) * scale
        p = jax.nn.softmax(sc, axis=-1)
        a = (p[:, :, 0] - lam_full * p[:, :, 1]).astype(qb.dtype)
        o = jnp.einsum('bhqk,bkhe->bqhe', a, vals)
        return rms_norm(o, subln_g) * (1.0 - lambda_init)

    k_all = jnp.concatenate([kc, k], axis=1)
    v_all = jnp.concatenate([vc, v], axis=1)
    qblocks = jnp.moveaxis(q.reshape(b, s // DA_QBLOCK, DA_QBLOCK, DA_HEADS, 2, DA_HEAD_DIM), 1, 0)
    o = lax.map(lambda qb: attend(qb, k_all, v_all), qblocks)
    ox = jnp.moveaxis(o, 0, 1).reshape(b, s, d) @ w_o
    oc = None
    if with_ctx_out:
        qc = (hc @ w_qkv[:, :d]).reshape(b, n_ctx, DA_HEADS, 2, DA_HEAD_DIM)
        oc = attend(qc, kc, vc).reshape(b, n_ctx, d) @ w_o
    return ox, oc


def hier_moe(h, w_group, b_group, w_router, b_router, w1, w3, w2):
    shape = h.shape
    xt = h.reshape(-1, shape[-1])
    n = xt.shape[0]
    g_prob = jax.nn.softmax((xt @ w_group).astype(jnp.float32) + b_group.astype(jnp.float32), axis=-1)
    g_val, g_idx = lax.top_k(g_prob, 1)
    e_logits = ((xt @ w_router).astype(jnp.float32) + b_router.astype(jnp.float32)).reshape(n, MOE_GROUPS, MOE_EXPERTS_PER_GROUP)
    e_logits = jnp.take_along_axis(e_logits, g_idx[:, :, None], axis=1)[:, 0]
    e_val, e_idx = lax.top_k(jax.nn.softmax(e_logits, axis=-1), MOE_TOP_K)
    w_tok = g_val * e_val / jnp.sum(e_val, axis=-1, keepdims=True)
    ids = g_idx * MOE_EXPERTS_PER_GROUP + e_idx
    gates = jnp.sum(jax.nn.one_hot(ids, MOE_N_EXPERTS, dtype=jnp.float32) * w_tok[..., None], axis=1).astype(h.dtype)
    y = jnp.zeros_like(xt)
    for e in range(MOE_N_EXPERTS):
        he = jax.nn.silu(xt @ w1[e]) * (xt @ w3[e])
        y = y + (he @ w2[e]) * gates[:, e:e + 1]
    return y.reshape(shape)


def setup_inputs(seed: int = 0) -> dict:
    key = jax.random.key(seed)
    keys = iter(jax.random.split(key, 40))
    f32 = jnp.float32
    D = D_MODEL

    def normal(shape, scale):
        return jax.random.normal(next(keys), shape, f32) * scale

    def gain(shape):
        return 1.0 + normal(shape, 0.05)

    n_a = len(range(0, DEPTH, N_MIXERS))
    n_b = len(range(1, DEPTH, N_MIXERS))
    n_c = len(range(2, DEPTH, N_MIXERS))
    bg = normal((n_b, 2, 2, ML_HEADS), 0.1)
    bg = bg.at[:, :, 1, :].add(jnp.linspace(3.0, 6.0, ML_HEADS, dtype=f32))
    return {
        'x': normal((BATCH, SEQ, D), 1.0),
        'c': normal((BATCH, D), 1.0),
        'ctx': normal((BATCH, CTX_LEN, D), 1.0),
        'c_ctx': normal((D,), 1.0),
        'mod_w': normal((DEPTH, D, 6 * D), 0.5 * D ** -0.5),
        'mod_b': normal((DEPTH, 6 * D), 0.02),
        'norm_g': gain((DEPTH, 2, D)),
        'final_g': gain((D,)),
        'na_w_qkv': normal((n_a, D, 3 * D), D ** -0.5),
        'na_w_o': normal((n_a, D, D), D ** -0.5),
        'na_rpb': normal((n_a, NA_HEADS, 2 * NA_WIN_H - 1, 2 * NA_WIN_W - 1), 0.1),
        'ml_w_up': normal((n_b, D, 2 * ML_INNER), D ** -0.5),
        'ml_conv_w': normal((n_b, ML_CONV_K, ML_INNER), ML_CONV_K ** -0.5),
        'ml_conv_b': normal((n_b, ML_INNER), 0.02),
        'ml_w_q': normal((n_b, ML_INNER // ML_BLOCK, ML_BLOCK, ML_BLOCK), ML_BLOCK ** -0.5),
        'ml_w_k': normal((n_b, ML_INNER // ML_BLOCK, ML_BLOCK, ML_BLOCK), ML_BLOCK ** -0.5),
        'ml_w_v': normal((n_b, ML_INNER // ML_BLOCK, ML_BLOCK, ML_BLOCK), ML_BLOCK ** -0.5),
        'ml_w_gate': normal((n_b, 3 * ML_INNER, 4 * ML_HEADS), (3 * ML_INNER) ** -0.5),
        'ml_b_gate': bg.reshape(n_b, 4 * ML_HEADS),
        'ml_gn_w': gain((n_b, ML_INNER)),
        'ml_skip': gain((n_b, ML_INNER)),
        'ml_w_down': normal((n_b, ML_INNER, D), ML_INNER ** -0.5),
        'da_w_qkv': normal((n_c, D, 3 * D), D ** -0.5),
        'da_lambda': normal((n_c, 4, DA_HEAD_DIM), 0.1),
        'da_subln_g': gain((n_c, 2 * DA_HEAD_DIM)),
        'da_w_o': normal((n_c, D, D), D ** -0.5),
        'moe_w_group': normal((DEPTH, D, MOE_GROUPS), D ** -0.5),
        'moe_b_group': normal((DEPTH, MOE_GROUPS), 0.01),
        'moe_w_router': normal((DEPTH, D, MOE_N_EXPERTS), D ** -0.5),
        'moe_b_router': normal((DEPTH, MOE_N_EXPERTS), 0.01),
        'moe_w1': normal((DEPTH, MOE_N_EXPERTS, D, MOE_HIDDEN), D ** -0.5),
        'moe_w3': normal((DEPTH, MOE_N_EXPERTS, D, MOE_HIDDEN), D ** -0.5),
        'moe_w2': normal((DEPTH, MOE_N_EXPERTS, MOE_HIDDEN, D), MOE_HIDDEN ** -0.5),
    }


def reference(x, c, ctx, c_ctx, mod_w, mod_b, norm_g, final_g,
              na_w_qkv, na_w_o, na_rpb,
              ml_w_up, ml_conv_w, ml_conv_b, ml_w_q, ml_w_k, ml_w_v, ml_w_gate, ml_b_gate,
              ml_gn_w, ml_skip, ml_w_down,
              da_w_qkv, da_lambda, da_subln_g, da_w_o,
              moe_w_group, moe_b_group, moe_w_router, moe_b_router, moe_w1, moe_w3, moe_w2):
    b, s, d = x.shape
    n_ctx = ctx.shape[1]
    xs, cs = x, ctx
    silu_c = jax.nn.silu(c)
    silu_cc = jax.nn.silu(c_ctx)
    for i in range(DEPTH):
        last = i == DEPTH - 1
        kind, j = i % N_MIXERS, i // N_MIXERS
        sh1, sc1, g1, sh2, sc2, g2 = jnp.split((silu_c @ mod_w[i] + mod_b[i])[:, None, :], 6, axis=-1)
        csh1, csc1, cg1, csh2, csc2, cg2 = jnp.split(silu_cc @ mod_w[i] + mod_b[i], 6)
        hx = modulate(xs, norm_g[i, 0], sh1, sc1)
        hc = modulate(cs, norm_g[i, 0], csh1, csc1)
        if kind == 0:
            ox, oc = neighbourhood_attention(hx, hc, na_w_qkv[j], na_w_o[j], na_rpb[j], not last)
        elif kind == 1:
            ox, oc = mlstm_mixer(hx, hc, ml_w_up[j], ml_conv_w[j], ml_conv_b[j], ml_w_q[j], ml_w_k[j], ml_w_v[j],
                                 ml_w_gate[j], ml_b_gate[j], ml_gn_w[j], ml_skip[j], ml_w_down[j], not last)
        else:
            lambda_init = 0.8 - 0.6 * math.exp(-0.3 * i)
            ox, oc = diff_attention(hx, hc, da_w_qkv[j], da_lambda[j], da_subln_g[j], da_w_o[j], lambda_init, not last)
        xs = xs + g1 * ox
        hx = modulate(xs, norm_g[i, 1], sh2, sc2)
        moe_args = (moe_w_group[i], moe_b_group[i], moe_w_router[i], moe_b_router[i], moe_w1[i], moe_w3[i], moe_w2[i])
        if last:
            xs = xs + g2 * hier_moe(hx, *moe_args)
        else:
            cs = cs + cg1 * oc
            hc = modulate(cs, norm_g[i, 1], csh2, csc2)
            y = hier_moe(jnp.concatenate([hc, hx], axis=1), *moe_args)
            cs = cs + cg2 * y[:, :n_ctx]
            xs = xs + g2 * y[:, n_ctx:]
    return rms_norm(xs, final_g)
```

```cpp
#include <hip/hip_runtime.h>
#include <cstdio>
#include <cstdint>

#define DI __device__ __forceinline__
#define LAS __attribute__((address_space(3)))
typedef unsigned short bf16_t;
typedef short bf16x8 __attribute__((ext_vector_type(8)));
typedef short s16x4 __attribute__((ext_vector_type(4)));
typedef float f32x2 __attribute__((ext_vector_type(2)));
typedef float f32x4 __attribute__((ext_vector_type(4)));
typedef float f32x16 __attribute__((ext_vector_type(16)));
typedef unsigned u32x2 __attribute__((ext_vector_type(2)));
typedef unsigned u32x4 __attribute__((ext_vector_type(4)));
typedef __bf16 nbf2 __attribute__((ext_vector_type(2)));
typedef int i32x4 __attribute__((ext_vector_type(4)));
typedef int i32x8 __attribute__((ext_vector_type(8)));

#ifndef MK_PER_PHASE
#define MK_PER_PHASE 0
#endif
#ifndef MK_DUP
#define MK_DUP 0ull
#endif
#ifndef SCAN_DUP
#define SCAN_DUP 0
#endif
#ifndef MK_ONLY
#define MK_ONLY (-1)
#endif
#ifndef MK_LAST_PHASE
#define MK_LAST_PHASE 1000
#endif

constexpr int D = 1024, NB = 8, SEQ = 4096, NCTX = 256, TPB = SEQ + NCTX  , T = NB * TPB  ;
constexpr int NRT = T / 256;
constexpr float EPS = 1e-6f;
constexpr int ML_INNER = 2048;
constexpr int MOE_H = 512, NEXP = 32;
constexpr int MAXTILES = 304;

constexpr size_t MiB = 1u << 20;
constexpr size_t WS_CTL = 0, CTL_BYTES = 1 * MiB;
constexpr size_t WS_MODV = 1 * MiB;
constexpr size_t WS_MISC = 2 * MiB;
constexpr size_t WS_WNAQKV = 3 * MiB;
constexpr size_t WS_WNAO = 15 * MiB;
constexpr size_t WS_WMLUP = 19 * MiB;
constexpr size_t WS_WMLDN = 27 * MiB;
constexpr size_t WS_WDAQKV = 31 * MiB;
constexpr size_t WS_WDAO = 37 * MiB;
constexpr size_t WS_WMOE13 = 39 * MiB;
constexpr size_t WS_WMOE2 = 71 * MiB;
constexpr size_t WS_HB8 = 88 * MiB;
constexpr size_t WS_XS = 135 * MiB;
constexpr size_t WS_HB = 271 * MiB;
constexpr size_t WS_ROUTE = 339 * MiB;
constexpr size_t WS_R = 346 * MiB;
constexpr size_t R_QKV = WS_R;
constexpr size_t R_AO = WS_R + 204 * MiB;
constexpr size_t R_XM = WS_R;
constexpr size_t R_Z = WS_R + 136 * MiB;
constexpr size_t R_XC = WS_R + 272 * MiB;
constexpr size_t R_V = WS_R + 408 * MiB;
constexpr size_t R_HBW = WS_R + 544 * MiB;
constexpr size_t R_GATES = WS_R + 680 * MiB;
constexpr size_t R_HMID = WS_R;
constexpr size_t R_Y = WS_R + 76 * MiB;
constexpr size_t WS_END = WS_R + 683 * MiB;
constexpr int CW_BAR = 4096;
constexpr int CW_CNT = 16384;

constexpr int LDS_BYTES = 163840;
constexpr int LDS_CTL = LDS_BYTES - 256;

DI unsigned pk2(float lo, float hi) { f32x2 v = {lo, hi}; nbf2 r = __builtin_convertvector(v, nbf2); return __builtin_bit_cast(unsigned, r); }
DI unsigned pk4_fp8(float a, float b, float c, float d) { int r = 0; r = __builtin_amdgcn_cvt_pk_fp8_f32(a, b, r, false); r = __builtin_amdgcn_cvt_pk_fp8_f32(c, d, r, true); return (unsigned)r; }
DI float bflo(unsigned u) { return __builtin_bit_cast(float, u << 16); }
DI float bfhi(unsigned u) { return __builtin_bit_cast(float, u & 0xffff0000u); }
DI float bf2f(bf16_t b) { return __builtin_bit_cast(float, ((unsigned)b) << 16); }
DI int hw_lane() { int l; asm volatile("v_mbcnt_lo_u32_b32 %0, -1, 0\n\tv_mbcnt_hi_u32_b32 %0, -1, %0" : "=v"(l)); return l; }
DI int opaque(int v) { asm volatile("" : "+v"(v)); return v; }
DI int opaque_dep(int v, float dep) { asm volatile("" : "+v"(v) : "v"(dep)); return v; }
DI float xhalf_max(float x) { unsigned a = __builtin_bit_cast(unsigned, x), c = a; asm volatile("" : "+v"(c)); const auto r = __builtin_amdgcn_permlane32_swap(a, c, false, false); return fmaxf(__builtin_bit_cast(float, r[0]), __builtin_bit_cast(float, r[1])); }
DI float xhalf_sum(float x) { return x + __shfl_xor(x, 32); }
DI float xhalf_sum_pl(float x) { unsigned a = __builtin_bit_cast(unsigned, x), c = a; asm volatile("" : "+v"(c)); const auto r = __builtin_amdgcn_permlane32_swap(a, c, false, false); return __builtin_bit_cast(float, r[0]) + __builtin_bit_cast(float, r[1]); }
DI float wave_sum(float v) {
#pragma unroll
    for (int o = 1; o < 64; o <<= 1) v += __shfl_xor(v, o);
    return v;
}
DI float fast_exp2(float x) { return __builtin_amdgcn_exp2f(x); }
DI float fast_exp(float x) { return __builtin_amdgcn_exp2f(x * 1.4426950408889634f); }
DI float fast_rcp(float x) { return __builtin_amdgcn_rcpf(x); }
DI float silu_f(float x) { return x * fast_rcp(1.f + fast_exp(-x)); }
DI f32x16 mfma32(bf16x8 a, bf16x8 b, f32x16 c) { return __builtin_amdgcn_mfma_f32_32x32x16_bf16(a, b, c, 0, 0, 0); }
DI f32x4 mfma16(bf16x8 a, bf16x8 b, f32x4 c) { return __builtin_amdgcn_mfma_f32_16x16x32_bf16(a, b, c, 0, 0, 0); }
DI int crow(int reg, int h) { return (reg & 3) + 8 * (reg >> 2) + 4 * h; }
DI bf16x8 pack_step(const f32x16& x, int s) {
    u32x4 p; p.x = pk2(x[8 * s], x[8 * s + 1]); p.y = pk2(x[8 * s + 2], x[8 * s + 3]); p.z = pk2(x[8 * s + 4], x[8 * s + 5]); p.w = pk2(x[8 * s + 6], x[8 * s + 7]);
    return __builtin_bit_cast(bf16x8, p);
}
DI s16x4 tr_read(const LAS unsigned char* p) { return __builtin_amdgcn_ds_read_tr16_b64_v4i16((LAS s16x4*)p); }
DI bf16x8 cat4(s16x4 lo, s16x4 hi) { return __builtin_shufflevector(lo, hi, 0, 1, 2, 3, 4, 5, 6, 7); }

#define XB_TMO      128
#define XB_XCNT(j)  (256  + 64 * (j))
#define XB_XSUB(j)  (1280 + 64 * (j))
#define XB_XGEN(j)  (2304 + 64 * (j))
#define XB_TOP      3328
#define XB_TOPGEN   3392
#define XCD_BAR_WORDS 3456
#define XB_SPIN_CAP (1u << 22)
DI unsigned xb_ld(unsigned* p)              { return __hip_atomic_load(p, __ATOMIC_RELAXED, __HIP_MEMORY_SCOPE_AGENT); }
DI unsigned xb_add(unsigned* p, unsigned v) { return __hip_atomic_fetch_add(p, v, __ATOMIC_RELAXED, __HIP_MEMORY_SCOPE_AGENT); }
DI unsigned xb_xcc_id() { return (unsigned)__builtin_amdgcn_s_getreg((3 << 11) | 20) & 0xFu; }
#define XB_SPIN(cond, bar) do { unsigned _sp = 0; while (cond) { __builtin_amdgcn_s_sleep(1); \
    if ((++_sp & 255u) == 0u) { if (xb_ld(&(bar)[XB_TMO])) break; if (_sp > XB_SPIN_CAP) { atomicAdd(&(bar)[XB_TMO], 1u); break; } } } } while (0)
struct XcdBarrier { unsigned* bar; unsigned x; volatile LAS unsigned* st; };
DI XcdBarrier xcd_barrier_post(unsigned* bar, volatile LAS unsigned* st, bool t0) {
    XcdBarrier b; b.bar = bar; b.x = xb_xcc_id(); b.st = st;
    if (t0) (void)xb_add(&bar[XB_XCNT(b.x)], 1u);
    return b;
}
DI void xcd_barrier_complete(unsigned* bar, unsigned x, unsigned& nloc, unsigned& nx) {
    const unsigned G = gridDim.x * gridDim.y * gridDim.z;
    unsigned sum, cnt, mine, sp = 0u;
    for (;;) {
        sum = 0u; cnt = 0u; mine = 0u;
#pragma unroll
        for (unsigned j = 0; j < 16; ++j) { const unsigned c = xb_ld(&bar[XB_XCNT(j)]); sum += c; cnt += (c > 0u) ? 1u : 0u; mine = (j == x) ? c : mine; }
        if (sum == G) break;
        __builtin_amdgcn_s_sleep(1);
        if ((++sp & 255u) == 0u) { if (xb_ld(&bar[XB_TMO])) break; if (sp > XB_SPIN_CAP) { atomicAdd(&bar[XB_TMO], 1u); break; } }
    }
    nloc = mine > 0u ? mine : 1u; nx = cnt > 0u ? cnt : 1u;
}
DI void xcd_barrier(const XcdBarrier& b, bool t0) {
    asm volatile("s_waitcnt vmcnt(0)" ::: "memory");
    __syncthreads();
    if (t0) {
        unsigned* bar = b.bar;
        __builtin_amdgcn_s_waitcnt(0);
        unsigned nloc = b.st[0], nx = b.st[1];
        if (nloc == 0u) { xcd_barrier_complete(bar, b.x, nloc, nx); b.st[0] = nloc; b.st[1] = nx; }
        const unsigned old = xb_add(&bar[XB_XSUB(b.x)], 1u);
        const unsigned gen = old / nloc;
        if (old + 1u == (gen + 1u) * nloc) {
            __builtin_amdgcn_fence(__ATOMIC_RELEASE, "agent");
            asm volatile("s_waitcnt vmcnt(0)" ::: "memory");
            const unsigned og = xb_add(&bar[XB_TOP], 1u);
            const unsigned tg = og / nx;
            if (og + 1u == (tg + 1u) * nx) xb_add(&bar[XB_TOPGEN], 1u);
            else XB_SPIN(xb_ld(&bar[XB_TOPGEN]) == tg, bar);
            __builtin_amdgcn_fence(__ATOMIC_ACQUIRE, "agent");
            xb_add(&bar[XB_XGEN(b.x)], 1u);
            asm volatile("s_waitcnt vmcnt(0)" ::: "memory");
        } else {
            XB_SPIN(xb_ld(&bar[XB_XGEN(b.x)]) == gen, bar);
            __builtin_amdgcn_fence(__ATOMIC_ACQUIRE, "agent");
            asm volatile("s_waitcnt vmcnt(0)" ::: "memory");
        }
    }
    __syncthreads();
}

namespace pg8 {
constexpr int BM = 256, BK = 64, HALF = 128, HTB = HALF * BK * 2, STAGE_BYTES = 8 * HTB, NXCD = 8, WGM = 8;
DI int lds_byte(int r, int c) { const int st = (r >> 4) * 2 + (c >> 5), rr = r & 15, cc = c & 31, ob = rr * 64 + cc * 2; return st * 1024 + (ob ^ (((ob >> 9) & 1) << 5)); }
DI void stage_rc(int b, int& R, int& C) { const int st = b / 1024, sb = b % 1024, swz = sb ^ (((sb >> 9) & 1) << 5); R = (st >> 1) * 16 + swz / 64; C = (st & 1) * 32 + (swz % 64) / 2; }
DI int perm32(int rho) { const int n = rho >> 4, i = rho & 15; return 8 * (i >> 2) + 4 * n + (i & 3); }
struct Unit { int pm, pn; const char* a; const char* b; int e, r0, cnt; };

struct DenseOrder {
    int nM, nN, nwg, G, c; const char* A; const char* Bt; size_t tstep;
    DI void init(const bf16_t* A_, const bf16_t* Bt_, int M, int N, int K, int G_, int c_) { nM = M / BM; nN = N / BM; nwg = nM * nN; G = G_; c = c_; A = (const char*)A_; Bt = (const char*)Bt_; tstep = (size_t)BM * K * 2; }
    DI bool next(int i, Unit& u) const {
        const long L = (long)i * G + c; if (L >= nwg) return false;
        int wgid = (int)L; { const int q = nwg / NXCD, r = nwg % NXCD, xcd = wgid % NXCD, off = wgid / NXCD; wgid = (xcd < r ? xcd * (q + 1) : r * (q + 1) + (xcd - r) * q) + off; }
        const int nig = WGM * nN, gid = wgid / nig, fm = gid * WGM, gsz = (nM - fm) < WGM ? (nM - fm) : WGM;
        u.pm = fm + ((wgid % nig) % gsz); u.pn = (wgid % nig) / gsz; u.a = A + (size_t)u.pm * tstep; u.b = Bt + (size_t)u.pn * tstep; u.e = 0; u.r0 = 0; u.cnt = 0; return true;
    }
    DI void aoff(const Unit&, int K, const int (&R)[2], const int (&C)[2], unsigned (&va)[2][2]) const {
#pragma unroll
        for (int h = 0; h < 2; ++h)
#pragma unroll
            for (int i = 0; i < 2; ++i) va[h][i] = (unsigned)((R[i] + HALF * h) * K + C[i]) * 2u;
    }
};

template <class Epi, class Sched, bool FP8 = false>
DI void gemm_phase(LAS unsigned char* lds, const int K, const Sched& S, const Epi& E, const int tid) {
    const int wid = __builtin_amdgcn_readfirstlane(tid >> 6), lane = tid & 63, wr = wid >> 2, wc = wid & 3, fr = lane & 15, fq = lane >> 4;
    const int nt = K / BK;
    int Rr[2], Cc[2]; unsigned vb[2][2];
#pragma unroll
    for (int i = 0; i < 2; ++i) { stage_rc(tid * 16 + i * 8192, Rr[i], Cc[i]); const int Rb = Epi::PERM ? ((Rr[i] & ~31) + perm32(Rr[i] & 31)) : Rr[i];
#pragma unroll
        for (int h = 0; h < 2; ++h) vb[h][i] = (unsigned)((Rb + HALF * h) * K + Cc[i]) * 2u; }
    const size_t kstep = (size_t)(BK * 2);
    const unsigned ldsw = (unsigned)wid * 1024u;
    const int aoff = lds_byte(wr * 64 + fr, fq * 8), boff = lds_byte(wc * 32 + fr, fq * 8);
#define PG8_SA(b, h) (((b) * 2 + (h)) * HTB)
#define PG8_SB(b, h) ((4 + (b) * 2 + (h)) * HTB)
#define PG8_STAGE(bufoff, gbase, voff) do { _Pragma("unroll") for (int _i = 0; _i < 2; ++_i) \
        __builtin_amdgcn_global_load_lds((const unsigned*)((const char*)(gbase) + (voff)[_i]), (LAS unsigned*)(lds + (bufoff) + ldsw + _i * 8192), 16, 0, 0); } while (0)
#define PG8_LDA(dst, b, h) do { _Pragma("unroll") for (int m = 0; m < 4; ++m) { const i32x4 l_ = *(const LAS i32x4*)(lds + PG8_SA(b, h) + aoff + m * 2048); const i32x4 h_ = *(const LAS i32x4*)(lds + PG8_SA(b, h) + aoff + m * 2048 + 1024); dst[m] = __builtin_shufflevector(l_, h_, 0, 1, 2, 3, 4, 5, 6, 7); } } while (0)
#define PG8_LDB(dst, b, h) do { _Pragma("unroll") for (int n = 0; n < 2; ++n) { const i32x4 l_ = *(const LAS i32x4*)(lds + PG8_SB(b, h) + boff + n * 2048); const i32x4 h_ = *(const LAS i32x4*)(lds + PG8_SB(b, h) + boff + n * 2048 + 1024); dst[n] = __builtin_shufflevector(l_, h_, 0, 1, 2, 3, 4, 5, 6, 7); } } while (0)
#define PG8_LO(v) __builtin_bit_cast(bf16x8, __builtin_shufflevector(v, v, 0, 1, 2, 3))
#define PG8_HI(v) __builtin_bit_cast(bf16x8, __builtin_shufflevector(v, v, 4, 5, 6, 7))
#define PG8_MMA(ai, bj, At, Bt) do { __builtin_amdgcn_s_setprio(1); _Pragma("unroll") for (int m = 0; m < 4; ++m) _Pragma("unroll") for (int n = 0; n < 2; ++n) { \
        if constexpr (FP8) asm volatile("v_mfma_scale_f32_16x16x128_f8f6f4 %0, %1, %2, %0, %3, %3 op_sel_hi:[0,0,0]" : "+v"(acc[ai][bj][m][n]) : "v"(Bt[n]), "v"(At[m]), "v"(fp8_unit_scale)); \
        else { acc[ai][bj][m][n] = __builtin_amdgcn_mfma_f32_16x16x32_bf16(PG8_LO(Bt[n]), PG8_LO(At[m]), acc[ai][bj][m][n], 0, 0, 0); \
               acc[ai][bj][m][n] = __builtin_amdgcn_mfma_f32_16x16x32_bf16(PG8_HI(Bt[n]), PG8_HI(At[m]), acc[ai][bj][m][n], 0, 0, 0); } } __builtin_amdgcn_s_setprio(0); } while (0)
#define PG8_WAIT_V(n) asm volatile("s_waitcnt vmcnt(" #n ")" ::: "memory")
#define PG8_WAIT_L(n) asm volatile("s_waitcnt lgkmcnt(" #n ")" ::: "memory")
#define PG8_BAR __builtin_amdgcn_s_barrier()
#define PG8_SCHED __builtin_amdgcn_sched_barrier(0)
    Unit cur, nxt; int ui = 0;
    if (!S.next(0, cur)) return;
    f32x4 acc[2][2][4][2];
#pragma unroll
    for (int a = 0; a < 2; ++a)
#pragma unroll
        for (int b = 0; b < 2; ++b)
#pragma unroll
            for (int m = 0; m < 4; ++m)
#pragma unroll
                for (int n = 0; n < 2; ++n) acc[a][b][m][n] = (f32x4){0.f, 0.f, 0.f, 0.f};
    i32x8 At[4], B0[2], B1[2];
    const int fp8_unit_scale = 0x7f7f7f7f;
    unsigned vac[2][2], van[2][2];
    S.aoff(cur, K, Rr, Cc, vac);
    const char* cA = cur.a; const char* cB = cur.b;
    PG8_STAGE(PG8_SB(0, 0), cB, vb[0]); PG8_STAGE(PG8_SB(0, 1), cB, vb[1]); PG8_STAGE(PG8_SA(0, 0), cA, vac[0]); PG8_STAGE(PG8_SA(0, 1), cA, vac[1]);
    if (wr == 1) PG8_BAR;
    PG8_WAIT_V(2); PG8_BAR;
    PG8_STAGE(PG8_SB(1, 0), cB + kstep, vb[0]); PG8_STAGE(PG8_SA(1, 0), cA + kstep, vac[0]); PG8_STAGE(PG8_SB(1, 1), cB + kstep, vb[1]);
    PG8_WAIT_V(6); PG8_BAR;
    for (;;) {
        const bool has_next = S.next(ui + 1, nxt);
        const char* nA = has_next ? nxt.a : cA; const char* nB = has_next ? nxt.b : cB;
        if (has_next) S.aoff(nxt, K, Rr, Cc, van);
        else {
#pragma unroll
            for (int h = 0; h < 2; ++h)
#pragma unroll
                for (int i = 0; i < 2; ++i) van[h][i] = vac[h][i]; }
#pragma nounroll
        for (int t = 0; t < nt; t += 2) {
            const bool last = (t == nt - 2);
            const char* a1 = cA + (size_t)(t + 1) * kstep;
            const char* a2 = last ? nA : cA + (size_t)(t + 2) * kstep; const char* b2 = last ? nB : cB + (size_t)(t + 2) * kstep;
            const char* a3 = a2 + kstep; const char* b3 = b2 + kstep;
            unsigned v2[2][2];
#pragma unroll
            for (int h = 0; h < 2; ++h)
#pragma unroll
                for (int i = 0; i < 2; ++i) v2[h][i] = last ? van[h][i] : vac[h][i];
            PG8_LDB(B0, 0, 0); PG8_LDB(B1, 0, 1); PG8_SCHED; PG8_LDA(At, 0, 0); PG8_STAGE(PG8_SA(1, 1), a1, vac[1]);
            PG8_WAIT_V(8); PG8_WAIT_L(0); PG8_BAR; PG8_MMA(0, 0, At, B0); PG8_MMA(0, 1, At, B1); PG8_BAR; PG8_SCHED;
            PG8_LDA(At, 0, 1); PG8_STAGE(PG8_SB(0, 0), b2, vb[0]); PG8_STAGE(PG8_SB(0, 1), b2, vb[1]); PG8_STAGE(PG8_SA(0, 0), a2, v2[0]);
            PG8_WAIT_V(8); PG8_WAIT_L(0); PG8_BAR; PG8_MMA(1, 0, At, B0); PG8_MMA(1, 1, At, B1); PG8_BAR; PG8_SCHED;
            PG8_LDB(B0, 1, 0); PG8_LDB(B1, 1, 1); PG8_SCHED; PG8_LDA(At, 1, 0); PG8_STAGE(PG8_SA(0, 1), a2, v2[1]);
            PG8_WAIT_V(8); PG8_WAIT_L(0); PG8_BAR; PG8_MMA(0, 0, At, B0); PG8_MMA(0, 1, At, B1); PG8_BAR; PG8_SCHED;
            PG8_LDA(At, 1, 1); PG8_STAGE(PG8_SB(1, 0), b3, vb[0]); PG8_STAGE(PG8_SB(1, 1), b3, vb[1]); PG8_STAGE(PG8_SA(1, 0), a3, v2[0]);
            PG8_WAIT_V(8); PG8_WAIT_L(0); PG8_BAR; PG8_MMA(1, 0, At, B0); PG8_MMA(1, 1, At, B1); PG8_BAR; PG8_SCHED;
        }
        if (wr == 0) PG8_BAR;
        if constexpr (FP8) asm volatile("s_nop 15\n\ts_nop 15\n\ts_nop 15" ::: "memory");
        E(acc, cur, wr, wc, fr, fq);
        if (!has_next) break;
#pragma unroll
        for (int a = 0; a < 2; ++a)
#pragma unroll
            for (int b = 0; b < 2; ++b)
#pragma unroll
                for (int m = 0; m < 4; ++m)
#pragma unroll
                    for (int n = 0; n < 2; ++n) acc[a][b][m][n] = (f32x4){0.f, 0.f, 0.f, 0.f};
        cur = nxt; cA = nA; cB = nB; ++ui;
#pragma unroll
        for (int h = 0; h < 2; ++h)
#pragma unroll
            for (int i = 0; i < 2; ++i) vac[h][i] = van[h][i];
        if (wr == 1) PG8_BAR;
    }
    PG8_WAIT_V(0);
    PG8_BAR;
#undef PG8_SA
#undef PG8_SB
#undef PG8_STAGE
#undef PG8_LDA
#undef PG8_LDB
#undef PG8_MMA
#undef PG8_WAIT_V
#undef PG8_WAIT_L
#undef PG8_BAR
#undef PG8_SCHED
}

struct EpiBf16 {
    static constexpr bool PERM = true;
    bf16_t* O; int ldc; int split_cols; size_t split_stride; int qtiles; float qs; float os;
    DI void operator()(const f32x4 (&acc)[2][2][4][2], const Unit& u, int wr, int wc, int fr, int fq) const {
        const int row0 = u.pm * BM + wr * 64 + fr; int colt = u.pn * BM; bf16_t* base = O;
        if (split_cols) { const int t = colt / split_cols; base += (size_t)t * split_stride; colt -= t * split_cols; }
        const int col0 = colt + wc * 32 + 8 * fq; const float sc = ((u.pn < qtiles) ? qs : 1.0f) * os;
#pragma unroll
        for (int ai = 0; ai < 2; ++ai)
#pragma unroll
            for (int m = 0; m < 4; ++m) { bf16_t* rowp = base + (size_t)(row0 + ai * HALF + m * 16) * ldc + col0;
#pragma unroll
                for (int bj = 0; bj < 2; ++bj) { const f32x4 v0 = acc[ai][bj][m][0] * sc, v1 = acc[ai][bj][m][1] * sc;
                    u32x4 w; w.x = pk2(v0[0], v0[1]); w.y = pk2(v0[2], v0[3]); w.z = pk2(v1[0], v1[1]); w.w = pk2(v1[2], v1[3]);
                    *(u32x4*)(rowp + bj * HALF) = w; } }
    }
};
struct EpiBf16Rope {
    static constexpr bool PERM = true;
    bf16_t* O; const float* rope; float os;
    DI void operator()(const f32x4 (&acc)[2][2][4][2], const Unit& u, int wr, int wc, int fr, int fq) const {
        const int row0 = u.pm * BM + wr * 64 + fr; const int col0 = u.pn * BM + wc * 32 + 8 * fq;
        const int jj = u.pm % 17; const bool dorope = (u.pn < 8) && (jj != 0);
        const float qs = ((u.pn < 4) ? 0.125f * 1.4426950408889634f : 1.0f) * os;
        const bool first = fq < 2; const int fbase = 8 * (fq & 1);
#pragma unroll
        for (int ai = 0; ai < 2; ++ai)
#pragma unroll
            for (int m = 0; m < 4; ++m) { bf16_t* rowp = O + (size_t)(row0 + ai * HALF + m * 16) * 3072 + col0;
                const int pos = (wc & 1) ? (16 * m + fr) : ((jj - 1) * 4 + 2 * ai + wr);
                const float* tb = rope + ((dorope ? pos : 0) * 16 + fbase) * 2;
                const f32x4 t0 = *(const f32x4*)(tb), t1 = *(const f32x4*)(tb + 4), t2 = *(const f32x4*)(tb + 8), t3 = *(const f32x4*)(tb + 12);
                const float cs[8] = {t0[0], t0[2], t1[0], t1[2], t2[0], t2[2], t3[0], t3[2]}, sn[8] = {t0[1], t0[3], t1[1], t1[3], t2[1], t2[3], t3[1], t3[3]};
#pragma unroll
                for (int bj = 0; bj < 2; ++bj) { f32x4 v0 = acc[ai][bj][m][0], v1 = acc[ai][bj][m][1];
                    if (dorope) {
                        float x[8] = {v0[0], v0[1], v0[2], v0[3], v1[0], v1[1], v1[2], v1[3]};
#pragma unroll
                        for (int e = 0; e < 8; ++e) { const float p = __shfl_xor(x[e], 32); x[e] = first ? (x[e] * cs[e] - p * sn[e]) : (x[e] * cs[e] + p * sn[e]); }
                        v0 = (f32x4){x[0], x[1], x[2], x[3]}; v1 = (f32x4){x[4], x[5], x[6], x[7]};
                    }
                    v0 = v0 * qs; v1 = v1 * qs;
                    u32x4 w; w.x = pk2(v0[0], v0[1]); w.y = pk2(v0[2], v0[3]); w.z = pk2(v1[0], v1[1]); w.w = pk2(v1[2], v1[3]);
                    *(u32x4*)(rowp + bj * HALF) = w; } }
    }
};
struct EpiMoE1 {
    static constexpr bool PERM = true;
    unsigned char* O;
    DI void operator()(const f32x4 (&acc)[2][2][4][2], const Unit& u, int wr, int wc, int fr, int fq) const {
        const int row0 = u.pm * BM + wr * 64 + fr; const int col0 = (u.pn * BM + wc * 32 + 8 * fq) >> 1;
        const float is = 1.0f / 32.0f;
#pragma unroll
        for (int ai = 0; ai < 2; ++ai)
#pragma unroll
            for (int m = 0; m < 4; ++m) { unsigned char* rowp = O + (size_t)(row0 + ai * HALF + m * 16) * MOE_H + col0;
#pragma unroll
                for (int bj = 0; bj < 2; ++bj) { const f32x4 a = acc[ai][bj][m][0] * is, b = acc[ai][bj][m][1] * (is * 8.0f);
                    *(unsigned*)(rowp + bj * (HALF / 2)) = pk4_fp8(silu_f(a[0]) * b[0], silu_f(a[1]) * b[1], silu_f(a[2]) * b[2], silu_f(a[3]) * b[3]); } }
    }
};
struct EpiMoE2 {
    static constexpr bool PERM = true;
    bf16_t* O;
    DI void operator()(const f32x4 (&acc)[2][2][4][2], const Unit& u, int wr, int wc, int fr, int fq) const {
        const int row0 = u.pm * BM + wr * 64 + fr; const int col0 = u.pn * BM + wc * 32 + 8 * fq;
        const float is = 1.0f / 256.0f;
#pragma unroll
        for (int ai = 0; ai < 2; ++ai)
#pragma unroll
            for (int m = 0; m < 4; ++m) { bf16_t* rowp = O + (size_t)(row0 + ai * HALF + m * 16) * D + col0;
#pragma unroll
                for (int bj = 0; bj < 2; ++bj) { const f32x4 v0 = acc[ai][bj][m][0] * is, v1 = acc[ai][bj][m][1] * is;
                    u32x4 w; w.x = pk2(v0[0], v0[1]); w.y = pk2(v0[2], v0[3]); w.z = pk2(v1[0], v1[1]); w.w = pk2(v1[2], v1[3]);
                    *(u32x4*)(rowp + bj * HALF) = w; } }
    }
};
struct EpiResid {
    static constexpr bool PERM = false;
    bf16_t* XS; const float* modv_gate; float os;
    DI void operator()(const f32x4 (&acc)[2][2][4][2], const Unit& u, int wr, int wc, int fr, int fq) const {
        const int row0 = u.pm * BM + wr * 64 + fr, col0 = u.pn * BM + wc * 32 + 4 * fq;
        const int bb = u.pm / 17, jj = u.pm - bb * 17; const int mr = (jj == 0) ? 8 : bb;
        const float* gp = modv_gate + (size_t)mr * 6144 + col0;
        f32x4 gv[2][2];
#pragma unroll
        for (int bj = 0; bj < 2; ++bj)
#pragma unroll
            for (int n = 0; n < 2; ++n) gv[bj][n] = *(const f32x4*)(gp + bj * HALF + n * 16) * os;
#pragma unroll
        for (int ai = 0; ai < 2; ++ai)
#pragma unroll
            for (int m = 0; m < 4; ++m) { bf16_t* rowp = XS + (size_t)(row0 + ai * HALF + m * 16) * D + col0;
#pragma unroll
                for (int bj = 0; bj < 2; ++bj)
#pragma unroll
                    for (int n = 0; n < 2; ++n) { u32x2* p = (u32x2*)(rowp + bj * HALF + n * 16); const u32x2 o = *p; const f32x4 a = acc[ai][bj][m][n], g = gv[bj][n];
                        u32x2 w; w.x = pk2(bflo(o.x) + g[0] * a[0], bfhi(o.x) + g[1] * a[1]); w.y = pk2(bflo(o.y) + g[2] * a[2], bfhi(o.y) + g[3] * a[3]); *p = w; } }
    }
};
}

struct Args { const float* in[33]; float* out; unsigned char* ws; int ph_lo, ph_hi; };
struct Frame {
    LAS unsigned char* lds;
    unsigned char* ws;
    const float* const* in;
    float* out;
    int tid, lane, wave, G, bid;
};
#define IN_X 0
#define IN_C 1
#define IN_CTX 2
#define IN_CCTX 3
#define IN_MODW 4
#define IN_MODB 5
#define IN_NORMG 6
#define IN_FINALG 7
#define IN_NAQKV 8
#define IN_NAO 9
#define IN_NARPB 10
#define IN_MLUP 11
#define IN_MLCONVW 12
#define IN_MLCONVB 13
#define IN_MLWQ 14
#define IN_MLWK 15
#define IN_MLWV 16
#define IN_MLWGATE 17
#define IN_MLBGATE 18
#define IN_MLGNW 19
#define IN_MLSKIP 20
#define IN_MLDOWN 21
#define IN_DAQKV 22
#define IN_DALAM 23
#define IN_DASUBLN 24
#define IN_DAO 25
#define IN_MOEWG 26
#define IN_MOEBG 27
#define IN_MOEWR 28
#define IN_MOEBR 29
#define IN_MOEW1 30
#define IN_MOEW3 31
#define IN_MOEW2 32

DI void transpose_item(const float* W, int ldw, int K, bf16_t* WT, int k0, int n0src, int n0dst, LAS float* scr, int lane) {
#pragma unroll
    for (int i = 0; i < 32; ++i) { const int kk = 2 * i + (lane >> 5); scr[kk * 33 + (lane & 31)] = W[(size_t)(k0 + kk) * ldw + n0src + (lane & 31)]; }
    asm volatile("s_waitcnt lgkmcnt(0)" ::: "memory");
    const int c = lane & 7;
#pragma unroll
    for (int j = 0; j < 4; ++j) { const int n = (lane >> 3) + 8 * j; const LAS float* s = scr + (8 * c) * 33 + n;
        u32x4 o; o.x = pk2(s[0 * 33], s[1 * 33]); o.y = pk2(s[2 * 33], s[3 * 33]); o.z = pk2(s[4 * 33], s[5 * 33]); o.w = pk2(s[6 * 33], s[7 * 33]);
        *(u32x4*)(WT + (size_t)(n0dst + n) * K + k0 + 8 * c) = o; }
    asm volatile("s_waitcnt lgkmcnt(0)" ::: "memory");
}
DI void convert_matrix(Frame& F, const float* W, int K, int N, bf16_t* WT, int gw0, int ngw, LAS float* scr) {
    const int nblk = N / 32, nitems = (K / 64) * nblk;
    for (int it = gw0; it < nitems; it += ngw) { const int kb = it / nblk, nb = it - kb * nblk; transpose_item(W, N, K, WT, kb * 64, nb * 32, nb * 32, scr, F.lane); }
}
template <class RowMap>
DI void transpose_item_fp8(const float* W, int ldw, int K, unsigned char* WT, int k0, int n0src, const RowMap& drow, LAS float* scr, int lane) {
#pragma unroll
    for (int i = 0; i < 32; ++i) { const int kk = 2 * i + (lane >> 5); scr[kk * 33 + (lane & 31)] = W[(size_t)(k0 + kk) * ldw + n0src + (lane & 31)] * 32.0f; }
    asm volatile("s_waitcnt lgkmcnt(0)" ::: "memory");
    const int n = lane >> 1, hf = lane & 1; const LAS float* sp = scr + (32 * hf) * 33 + n;
    u32x4 o0, o1;
    o0.x = pk4_fp8(sp[0 * 33], sp[1 * 33], sp[2 * 33], sp[3 * 33]); o0.y = pk4_fp8(sp[4 * 33], sp[5 * 33], sp[6 * 33], sp[7 * 33]);
    o0.z = pk4_fp8(sp[8 * 33], sp[9 * 33], sp[10 * 33], sp[11 * 33]); o0.w = pk4_fp8(sp[12 * 33], sp[13 * 33], sp[14 * 33], sp[15 * 33]);
    o1.x = pk4_fp8(sp[16 * 33], sp[17 * 33], sp[18 * 33], sp[19 * 33]); o1.y = pk4_fp8(sp[20 * 33], sp[21 * 33], sp[22 * 33], sp[23 * 33]);
    o1.z = pk4_fp8(sp[24 * 33], sp[25 * 33], sp[26 * 33], sp[27 * 33]); o1.w = pk4_fp8(sp[28 * 33], sp[29 * 33], sp[30 * 33], sp[31 * 33]);
    unsigned char* dp = WT + (size_t)drow(n0src + n) * K + k0 + 32 * hf;
    *(u32x4*)dp = o0; *(u32x4*)(dp + 16) = o1;
    asm volatile("s_waitcnt lgkmcnt(0)" ::: "memory");
}
DI void convert_matrix_fp8(Frame& F, const float* W, int K, int N, unsigned char* WT, int gw0, int ngw, LAS float* scr) {
    const int nblk = N / 32, nitems = (K / 64) * nblk;
    auto rm = [&](int col) -> int { return col; };
    for (int it = gw0; it < nitems; it += ngw) { const int kb = it / nblk, nb = it - kb * nblk; transpose_item_fp8(W, N, K, WT, kb * 64, nb * 32, rm, scr, F.lane); }
}
DI void convert_moe(Frame& F, int layer, int gw0, int ngw, LAS float* scr) {
    const float* w1 = F.in[IN_MOEW1] + (size_t)layer * NEXP * D * MOE_H;
    const float* w3 = F.in[IN_MOEW3] + (size_t)layer * NEXP * D * MOE_H;
    const float* w2 = F.in[IN_MOEW2] + (size_t)layer * NEXP * MOE_H * D;
    unsigned char* W13T = F.ws + WS_WMOE13; unsigned char* W2T = F.ws + WS_WMOE2;
    const int per_mat = 16 * 16, per_e13 = 2 * per_mat, per_e2 = 8 * 32, per_e = per_e13 + per_e2, nitems = NEXP * per_e;
    const int lane = F.lane;
    for (int it = gw0; it < nitems; it += ngw) {
        const int e = it / per_e; int r = it - e * per_e;
        if (r < per_e13) {
            const int which = r / per_mat; r -= which * per_mat; const int kb = r >> 4, nb = r & 15;
            const float* W = (which ? w3 : w1) + (size_t)e * D * MOE_H;
            auto rm = [&](int col) -> int { return 8 * (col >> 2) + (col & 3) + 4 * which; };
            transpose_item_fp8(W, MOE_H, D, W13T + (size_t)e * 1024 * D, kb * 64, nb * 32, rm, scr, lane);
        } else {
            r -= per_e13; const int kb = r >> 5, nb = r & 31;
            auto rm = [&](int col) -> int { return col; };
            transpose_item_fp8(w2 + (size_t)e * MOE_H * D, D, MOE_H, W2T + (size_t)e * D * MOE_H, kb * 64, nb * 32, rm, scr, lane);
        }
    }
}

DI void phase_prologue(Frame& F) {
    LAS float* scr = (LAS float*)(F.lds + F.wave * 16384);
    const int gw = F.bid * 8 + F.wave, NGW = F.G * 8;
    for (int j = 0; j < 2; ++j) {
        convert_matrix_fp8(F, F.in[IN_NAQKV] + (size_t)j * D * 3072, D, 3072, F.ws + WS_WNAQKV + (size_t)j * 3072 * D, gw, NGW, scr);
        convert_matrix_fp8(F, F.in[IN_NAO] + (size_t)j * D * D, D, D, F.ws + WS_WNAO + (size_t)j * D * D, gw, NGW, scr);
    }
    convert_matrix(F, F.in[IN_MLUP], D, 4096, (bf16_t*)(F.ws + WS_WMLUP), gw, NGW, scr);
    convert_matrix(F, F.in[IN_MLDOWN], ML_INNER, D, (bf16_t*)(F.ws + WS_WMLDN), gw, NGW, scr);
    convert_matrix_fp8(F, F.in[IN_DAQKV], D, 3072, F.ws + WS_WDAQKV, gw, NGW, scr);
    convert_matrix_fp8(F, F.in[IN_DAO], D, D, F.ws + WS_WDAO, gw, NGW, scr);
    {
        bf16_t* WrT = (bf16_t*)(F.ws + WS_MISC);
        const int gt = F.bid * 512 + F.tid, NT = F.G * 512;
        for (int i = gt; i < 4 * 48 * 1024; i += NT) {
            const int l = i / (48 * 1024), r = i - l * 48 * 1024, n = r >> 10, k = r & 1023; float v = 0.f;
            if (n < 4) v = F.in[IN_MOEWG][((size_t)l * D + k) * 4 + n]; else if (n < 36) v = F.in[IN_MOEWR][((size_t)l * D + k) * 32 + (n - 4)];
            WrT[i] = (bf16_t)(pk2(v, 0.f) & 0xffffu);
        }
        bf16_t* WGt = (bf16_t*)(F.ws + WS_MISC + 512 * 1024);
        const float* wq = F.in[IN_MLWQ]; const float* wk = F.in[IN_MLWK]; const float* wv = F.in[IN_MLWV]; const float* wg = F.in[IN_MLWGATE];
        for (int i = gt; i < 16 * 4096; i += NT) {
            const int n = i >> 12, k = i & 4095; float v = 0.f;
            if (k < 2048) { const int g = k >> 2, ii = k & 3;
                for (int o = 0; o < 4; ++o) v += wq[g * 16 + ii * 4 + o] * wg[(size_t)(4 * g + o) * 16 + n] + wk[g * 16 + ii * 4 + o] * wg[(size_t)(2048 + 4 * g + o) * 16 + n];
            } else { const int kk = k - 2048, g = kk >> 2, ii = kk & 3;
                for (int o = 0; o < 4; ++o) v += wv[g * 16 + ii * 4 + o] * wg[(size_t)(4096 + 4 * g + o) * 16 + n]; }
            WGt[i] = (bf16_t)(pk2(v, 0.f) & 0xffffu);
        }
        float* rope = (float*)(F.ws + WS_MISC + 768 * 1024);
        for (int i = gt; i < 64 * 16; i += NT) { const int pos = i >> 4, f = i & 15; const float fr = powf(10000.0f, -(float)(2 * f) / 32.0f); const float ang = (float)pos * fr;
            rope[2 * i] = cosf(ang); rope[2 * i + 1] = sinf(ang); }
    }
    {
        __syncthreads();
        LAS float* sc = (LAS float*)F.lds;
        LAS float* red = (LAS float*)(F.lds + 65536);
        for (int i = F.tid; i < 9 * 1024; i += 512) { const int r = i >> 10, k = i & 1023; const float v = (r < 8) ? F.in[IN_C][r * 1024 + k] : F.in[IN_CCTX][k]; sc[i] = silu_f(v); }
        __syncthreads();
        float* modv = (float*)(F.ws + WS_MODV);
        const int col = F.tid & 63, kg = F.tid >> 6;
        for (int it = F.bid; it < 4 * 96; it += F.G) {
            const int l = it / 96, n0 = (it - l * 96) * 64;
            const float* W = F.in[IN_MODW] + (size_t)l * D * 6144 + n0 + col;
            float a[9];
#pragma unroll
            for (int r = 0; r < 9; ++r) a[r] = 0.f;
#pragma unroll 16
            for (int k = kg * 128; k < kg * 128 + 128; ++k) { const float w = W[(size_t)k * 6144];
#pragma unroll
                for (int r = 0; r < 9; ++r) a[r] += sc[r * 1024 + k] * w; }
#pragma unroll
            for (int r = 0; r < 9; ++r) red[(kg * 9 + r) * 64 + col] = a[r];
            __syncthreads();
            for (int i = F.tid; i < 9 * 64; i += 512) { const int r = i >> 6, c2 = i & 63; float s = F.in[IN_MODB][l * 6144 + n0 + c2];
#pragma unroll
                for (int g = 0; g < 8; ++g) s += red[(g * 9 + r) * 64 + c2];
                modv[((size_t)l * 9 + r) * 6144 + n0 + c2] = s; }
            __syncthreads();
        }
    }
    convert_moe(F, 0, gw, NGW, scr);
}

struct RouteRec { int e0, e1, r0, r1; float w0, w1; int p0, p1; };
template <int MODE>
DI void phase_modulate(Frame& F, int layer) {
    const int gw = F.bid * 8 + F.wave, NGW = F.G * 8, lane = F.lane;
    const int RPW = (T + NGW - 1) / NGW;
    const int r_begin = gw * RPW, r_end = (r_begin + RPW < T) ? r_begin + RPW : T;
    bf16_t* XS = (bf16_t*)(F.ws + WS_XS); bf16_t* HB = (bf16_t*)(F.ws + WS_HB);
    const float* modv = (const float*)(F.ws + WS_MODV);
    const RouteRec* route = (const RouteRec*)(F.ws + WS_ROUTE);
    const bf16_t* Y = (const bf16_t*)(F.ws + R_Y);
    const int sh_off = (MODE == 2) ? 3072 : 0, sc_off = sh_off + 1024;
    const float* ng = F.in[IN_NORMG] + (size_t)layer * 2 * D + ((MODE == 2) ? D : 0);
    constexpr bool COMB = (MODE == 1 || MODE == 3);
    constexpr int NR = COMB ? 2 : 4;
    int tb = 0;
    if (COMB) {
        const int pl = (MODE == 3) ? 3 : layer - 1;
        unsigned* cntp = (unsigned*)(F.ws + WS_CTL) + CW_CNT + pl * 32 * 64;
        int c = (lane < 32) ? (int)__hip_atomic_load(cntp + lane * 64, __ATOMIC_RELAXED, __HIP_MEMORY_SCOPE_AGENT) : 0;
        int ntl = (c + 255) >> 8, incl = ntl;
#pragma unroll
        for (int o = 1; o < 32; o <<= 1) { const int t = __shfl_up(incl, o); if ((lane & 31) >= o) incl += t; }
        tb = incl - ntl;
    }
    const float* gnp = (MODE == 3) ? F.in[IN_FINALG] : ng;
    for (int rb = r_begin; rb < r_end; rb += NR) {
        f32x4 v[NR][4]; int rr[NR]; bool ok[NR];
#pragma unroll
        for (int k = 0; k < NR; ++k) { ok[k] = rb + k < r_end; rr[k] = ok[k] ? rb + k : r_end - 1; }
#pragma unroll
        for (int k = 0; k < NR; ++k) {
            const int r = rr[k]; const int b = r / TPB, t = r - b * TPB; const bool isctx = t < NCTX;
            if (MODE == 0) { const float* src = isctx ? F.in[IN_CTX] + ((size_t)b * NCTX + t) * D : F.in[IN_X] + ((size_t)b * SEQ + (t - NCTX)) * D;
#pragma unroll
                for (int j = 0; j < 4; ++j) v[k][j] = *(const f32x4*)(src + 4 * lane + 256 * j);
            } else {
#pragma unroll
                for (int j = 0; j < 4; ++j) { const u32x2 u = *(const u32x2*)(XS + (size_t)r * D + 4 * lane + 256 * j); v[k][j] = (f32x4){bflo(u.x), bfhi(u.x), bflo(u.y), bfhi(u.y)}; }
            }
        }
        if (COMB) {
            const int pl = (MODE == 3) ? 3 : layer - 1;
            u32x2 y0[NR][4], y1[NR][4]; float w0[NR], w1[NR];
#pragma unroll
            for (int k = 0; k < NR; ++k) {
                const RouteRec rec = route[rr[k]];
                const int s0 = __shfl(tb, rec.e0) * 256 + rec.r0, s1 = __shfl(tb, rec.e1) * 256 + rec.r1; w0[k] = rec.w0; w1[k] = rec.w1;
#pragma unroll
                for (int j = 0; j < 4; ++j) { y0[k][j] = *(const u32x2*)(Y + (size_t)s0 * D + 4 * lane + 256 * j); y1[k][j] = *(const u32x2*)(Y + (size_t)s1 * D + 4 * lane + 256 * j); }
            }
#pragma unroll
            for (int k = 0; k < NR; ++k) {
                const int r = rr[k]; const int b = r / TPB, t = r - b * TPB; const int mr = (t < NCTX) ? 8 : b;
                const float* g2 = modv + ((size_t)pl * 9 + mr) * 6144 + 5120;
#pragma unroll
                for (int j = 0; j < 4; ++j) {
                    const f32x4 gg = *(const f32x4*)(g2 + 4 * lane + 256 * j);
                    f32x4 yy; yy[0] = w0[k] * bflo(y0[k][j].x) + w1[k] * bflo(y1[k][j].x); yy[1] = w0[k] * bfhi(y0[k][j].x) + w1[k] * bfhi(y1[k][j].x);
                    yy[2] = w0[k] * bflo(y0[k][j].y) + w1[k] * bflo(y1[k][j].y); yy[3] = w0[k] * bfhi(y0[k][j].y) + w1[k] * bfhi(y1[k][j].y);
                    v[k][j] = v[k][j] + gg * yy;
                }
            }
        }
#pragma unroll
        for (int k = 0; k < NR; ++k) {
            if (!ok[k]) continue;
            const int r = rr[k]; const int b = r / TPB, t = r - b * TPB; const bool isctx = t < NCTX; const int mr = isctx ? 8 : b;
            if (MODE == 0 || MODE == 1) {
#pragma unroll
                for (int j = 0; j < 4; ++j) { u32x2 w; w.x = pk2(v[k][j][0], v[k][j][1]); w.y = pk2(v[k][j][2], v[k][j][3]); *(u32x2*)(XS + (size_t)r * D + 4 * lane + 256 * j) = w; }
            }
            float ss = 0.f;
#pragma unroll
            for (int j = 0; j < 4; ++j) ss += (v[k][j][0] * v[k][j][0] + v[k][j][1] * v[k][j][1]) + (v[k][j][2] * v[k][j][2] + v[k][j][3] * v[k][j][3]);
            const float rstd = 1.0f / sqrtf(wave_sum(ss) * (1.0f / D) + EPS);
            if (MODE == 3) {
                if (!isctx) { float* o = F.out + ((size_t)b * SEQ + (t - NCTX)) * D;
#pragma unroll
                    for (int j = 0; j < 4; ++j) *(f32x4*)(o + 4 * lane + 256 * j) = v[k][j] * rstd * *(const f32x4*)(gnp + 4 * lane + 256 * j); }
            } else {
                const float* mv = modv + ((size_t)layer * 9 + mr) * 6144;
#pragma unroll
                for (int j = 0; j < 4; ++j) {
                    const f32x4 sh = *(const f32x4*)(mv + sh_off + 4 * lane + 256 * j), sc = *(const f32x4*)(mv + sc_off + 4 * lane + 256 * j);
                    const f32x4 o = v[k][j] * rstd * *(const f32x4*)(gnp + 4 * lane + 256 * j) * (sc + 1.0f) + sh;
                    if (MODE == 2 || (MODE == 1 && layer == 1)) { u32x2 w; w.x = pk2(o[0], o[1]); w.y = pk2(o[2], o[3]); *(u32x2*)(HB + (size_t)r * D + 4 * lane + 256 * j) = w; }
                    if (!(MODE == 1 && layer == 1)) *(unsigned*)(F.ws + WS_HB8 + (size_t)r * D + 4 * lane + 256 * j) = pk4_fp8(o[0], o[1], o[2], o[3]);
                }
            }
        }
    }
    if (MODE == 2) {
        asm volatile("s_waitcnt vmcnt(0)" ::: "memory");
        const bf16_t* WrT = (const bf16_t*)(F.ws + WS_MISC) + (size_t)layer * 48 * 1024;
        LAS float* lg = (LAS float*)(F.lds + F.wave * 3072);
        unsigned* cntp = (unsigned*)(F.ws + WS_CTL) + CW_CNT + layer * 32 * 64;
        RouteRec* routew = (RouteRec*)(F.ws + WS_ROUTE);
        int* idx = (int*)(F.ws + WS_ROUTE + 2 * MiB);
        const float* bg = F.in[IN_MOEBG] + layer * 4; const float* br = F.in[IN_MOEBR] + layer * 32;
        for (int t0 = r_begin; t0 < r_end; t0 += 16) {
            int ar = t0 + (lane & 15); if (ar >= r_end) ar = r_end - 1;
            const bf16_t* ap = HB + (size_t)ar * D + 8 * (lane >> 4);
            const bf16_t* bp = WrT + (size_t)(lane & 15) * D + 8 * (lane >> 4);
            f32x4 a0 = {0.f, 0.f, 0.f, 0.f}, a1 = a0, a2 = a0;
#pragma unroll 8
            for (int ks = 0; ks < 32; ++ks) {
                const bf16x8 af = *(const bf16x8*)(ap + 32 * ks);
                a0 = mfma16(af, *(const bf16x8*)(bp + 32 * ks), a0);
                a1 = mfma16(af, *(const bf16x8*)(bp + 16 * D + 32 * ks), a1);
                a2 = mfma16(af, *(const bf16x8*)(bp + 32 * D + 32 * ks), a2);
            }
#pragma unroll
            for (int i = 0; i < 4; ++i) { const int row = (lane >> 4) * 4 + i; lg[row * 48 + (lane & 15)] = a0[i]; lg[row * 48 + 16 + (lane & 15)] = a1[i]; lg[row * 48 + 32 + (lane & 15)] = a2[i]; }
            asm volatile("s_waitcnt lgkmcnt(0)" ::: "memory");
            const int row = t0 + lane;
            if (lane < 16 && row < r_end) {
                const LAS float* L = lg + lane * 48;
                float gl[4]; int gi = 0; float gm = -3.0e38f;
#pragma unroll
                for (int k = 0; k < 4; ++k) { gl[k] = L[k] + bg[k]; if (gl[k] > gm) { gm = gl[k]; gi = k; } }
                float gs = 0.f;
#pragma unroll
                for (int k = 0; k < 4; ++k) gs += fast_exp(gl[k] - gm);
                const float gval = 1.0f / gs;
                float el[8]; float em = -3.0e38f; int i0 = 0;
#pragma unroll
                for (int k = 0; k < 8; ++k) { el[k] = L[4 + 8 * gi + k] + br[8 * gi + k]; if (el[k] > em) { em = el[k]; i0 = k; } }
                float em2 = -3.0e38f; int i1 = 0;
#pragma unroll
                for (int k = 0; k < 8; ++k) if (k != i0 && el[k] > em2) { em2 = el[k]; i1 = k; }
                const float p0 = 1.0f, p1 = fast_exp(em2 - em);
                const float inv = 1.0f / (p0 + p1);
                RouteRec rec; rec.e0 = gi * 8 + i0; rec.e1 = gi * 8 + i1; rec.w0 = gval * p0 * inv; rec.w1 = gval * p1 * inv;
                rec.r0 = (int)__hip_atomic_fetch_add(cntp + rec.e0 * 64, 1u, __ATOMIC_RELAXED, __HIP_MEMORY_SCOPE_AGENT);
                rec.r1 = (int)__hip_atomic_fetch_add(cntp + rec.e1 * 64, 1u, __ATOMIC_RELAXED, __HIP_MEMORY_SCOPE_AGENT);
                rec.p0 = 0; rec.p1 = 0;
                routew[row] = rec;
                idx[(size_t)rec.e0 * T + rec.r0] = row; idx[(size_t)rec.e1 * T + rec.r1] = row;
            }
            asm volatile("s_waitcnt lgkmcnt(0)" ::: "memory");
        }
    }
}

struct MoeOrder {
    int G, c, ntiles, K; const char* A; const char* Bt; size_t bstride; const int* idx; bool gather;
    const LAS int* tbl;
    DI bool next(int i, pg8::Unit& u) const {
        const long L = (long)i * G + c; if (L >= (long)ntiles * 4) return false;
        const int rt = (int)(L >> 2), pn = (int)(L & 3);
        int e = 0;
        for (int k = 1; k < 32; ++k) if (tbl[k] <= rt) e = k;
        u.pm = rt; u.pn = pn; u.e = e; u.r0 = (rt - tbl[e]) * 256; u.cnt = tbl[64 + e];
        u.a = gather ? A : A + (size_t)rt * 256 * K * 2;
        u.b = Bt + (size_t)e * bstride + (size_t)pn * 256 * K * 2;
        return true;
    }
    DI void aoff(const pg8::Unit& u, int K_, const int (&R)[2], const int (&C)[2], unsigned (&va)[2][2]) const {
#pragma unroll
        for (int h = 0; h < 2; ++h)
#pragma unroll
            for (int i = 0; i < 2; ++i) {
                if (gather) { int rr = u.r0 + R[i] + 128 * h; if (rr >= u.cnt) rr = 0; const int tok = idx[(size_t)u.e * T + rr]; va[h][i] = (unsigned)(tok * K_ + C[i]) * 2u; }
                else va[h][i] = (unsigned)((R[i] + 128 * h) * K_ + C[i]) * 2u;
            }
    }
};
DI int moe_build_table(Frame& F, int layer, LAS int* tbl) {
    __syncthreads();
    if (F.tid < 64) {
        unsigned* cntp = (unsigned*)(F.ws + WS_CTL) + CW_CNT + layer * 32 * 64;
        const int lane = F.tid;
        int c = (lane < 32) ? (int)__hip_atomic_load(cntp + lane * 64, __ATOMIC_RELAXED, __HIP_MEMORY_SCOPE_AGENT) : 0;
        int ntl = (c + 255) >> 8, incl = ntl;
#pragma unroll
        for (int o = 1; o < 32; o <<= 1) { const int t = __shfl_up(incl, o); if ((lane & 31) >= o) incl += t; }
        if (lane < 32) { tbl[lane] = incl - ntl; tbl[64 + lane] = c; }
        if (lane == 31) tbl[32] = incl;
    }
    __syncthreads();
    return tbl[32];
}

template <int DV> struct FlashSt { f32x16 o[DV / 32]; float m, l; };
template <int DV, int KSTR, int VSTR, bool MASK, class SF>
DI void flash_subtile(const LAS unsigned char* kb, const LAS unsigned char* vb, const bf16x8 (&qf)[4], FlashSt<DV>& st, const float scale_l2e, const int lane, const SF& sfun) {
    const int r = lane & 31, h = lane >> 5;
    f32x16 s;
#pragma unroll
    for (int i = 0; i < 16; ++i) s[i] = 0.f;
#pragma unroll
    for (int ks = 0; ks < 4; ++ks) { const bf16x8 a = *(const LAS bf16x8*)(kb + r * KSTR + (16 * ks + 8 * h) * 2); s = mfma32(a, qf[ks], s); }
    float mx = -INFINITY;
#pragma unroll
    for (int i = 0; i < 16; ++i) { s[i] = s[i] * scale_l2e; if (MASK) s[i] += sfun(i); mx = fmaxf(mx, s[i]); }
    mx = fmaxf(mx, __shfl_xor(mx, 32));
    const float mnew = fmaxf(st.m, mx);
    const float muse = (mnew == -INFINITY) ? 0.f : mnew;
    const float alpha = fast_exp2(st.m - muse);
    float rs = 0.f;
#pragma unroll
    for (int i = 0; i < 16; ++i) { s[i] = fast_exp2(s[i] - muse); rs += s[i]; }
    rs += __shfl_xor(rs, 32);
    st.l = st.l * alpha + rs; st.m = mnew;
#pragma unroll
    for (int d = 0; d < DV / 32; ++d)
#pragma unroll
        for (int i = 0; i < 16; ++i) st.o[d][i] *= alpha;
    const bf16x8 p0 = pack_step(s, 0), p1 = pack_step(s, 1);
    const int i16 = lane & 15, q = i16 >> 2, p = i16 & 3, blk = (lane >> 4) & 1;
    const LAS unsigned char* vl = vb + (4 * h + q) * VSTR + (16 * blk + 4 * p) * 2;
#pragma unroll
    for (int d = 0; d < DV / 32; ++d) {
        const s16x4 lo0 = tr_read(vl + d * 64), hi0 = tr_read(vl + 8 * VSTR + d * 64);
        const s16x4 lo1 = tr_read(vl + 16 * VSTR + d * 64), hi1 = tr_read(vl + 24 * VSTR + d * 64);
        st.o[d] = mfma32(cat4(lo0, hi0), p0, st.o[d]);
        st.o[d] = mfma32(cat4(lo1, hi1), p1, st.o[d]);
    }
}

DI int naf(int row) { return (((row >> 1) & 1) << 2) | ((row >> 2) & 3); }
DI void phase_na_attn(Frame& F, int j  , bool with_ctx) {
    const bf16_t* QKV = (const bf16_t*)(F.ws + R_QKV); unsigned char* AO = F.ws + R_AO;
    const float* rpb = F.in[IN_NARPB] + (size_t)j * 16 * 15 * 31;
    LAS unsigned char* L = F.lds;
    LAS float* bias = (LAS float*)(L + 65536);
    const int w = F.wave;
    const int n_lat = NB * 16 * 8, n_units = n_lat + (with_ctx ? NB * 16 : 0);
    const int ncb = w & 3, rq = w >> 2;
    const int kst = min(max(16 * ncb - 8, 0), 32);
    for (int unit = F.bid; unit < n_units; unit += F.G) {
    const int lane = opaque(F.lane), tid = w * 64 + lane, r32 = lane & 31, hh = lane >> 5;
    const int q4 = (lane & 15) >> 2, p4 = lane & 3, blk = (lane >> 4) & 1, LP = 2 * blk + (p4 >> 1);
    const int K0w = (kst + r32) * 128 + ((hh ^ naf(kst + r32)) << 4), K0c = r32 * 128 + ((hh ^ naf(r32)) << 4);
    const int xbw = (kst >> 2) & 3;
    const int V0w = (4 * hh + q4) * 128 + ((q4 >> 1) << 6) + ((LP ^ ((xbw + hh) & 3)) << 4) + (p4 & 1) * 8;
    const int V0c = (4 * hh + q4) * 128 + ((q4 >> 1) << 6) + ((LP ^ (hh & 3)) << 4) + (p4 & 1) * 8;
    const int drow0 = 16 * w + (lane >> 3), dpos = lane & 7;
    const int dsrc0 = (dpos ^ naf(drow0)) * 8, dsrc1 = (dpos ^ naf(drow0 + 8)) * 8;
    {
        const bool lat = unit < n_lat;
        int b, head, rg = 0;
        if (lat) { b = unit >> 7; head = (unit >> 3) & 15; rg = unit & 7; } else { const int u2 = unit - n_lat; b = u2 >> 4; head = u2 & 15; }
        const int r0 = 8 * rg;
        const int kr_lo = min(max(r0 - 4, 0), 56), kr_hi = min(max(r0 + 3, 0), 56) + 7;
        const int nwin = lat ? (kr_hi - kr_lo + 2) / 2 : 0, ntile = 2 + nwin;
        __syncthreads();
        if (tid < 15 * 31) bias[tid] = rpb[head * 465 + tid] * 1.4426950408889634f;
        const bf16_t* kvbase = QKV + (size_t)(b * TPB) * 3072 + 1024 + head * 64;
        auto issue = [&](int t) {
            LAS unsigned char* dst = L + (t & 1) * 32768 + w * 2048;
            int tok0, tok1;
            if (t < 2) { tok0 = 128 * t + drow0; tok1 = tok0 + 8; }
            else { const int kr0 = kr_lo + 2 * (t - 2); const int ra = drow0, rb = drow0 + 8;
                tok0 = NCTX + min(kr0 + (ra >> 6), 63) * 64 + (ra & 63); tok1 = NCTX + min(kr0 + (rb >> 6), 63) * 64 + (rb & 63); }
            const bf16_t* p0 = kvbase + (size_t)tok0 * 3072 + dsrc0; const bf16_t* p1 = kvbase + (size_t)tok1 * 3072 + dsrc1;
            __builtin_amdgcn_global_load_lds((const unsigned*)p0, (LAS unsigned*)dst, 16, 0, 0);
            __builtin_amdgcn_global_load_lds((const unsigned*)p1, (LAS unsigned*)(dst + 1024), 16, 0, 0);
            __builtin_amdgcn_global_load_lds((const unsigned*)(p0 + 1024), (LAS unsigned*)(dst + 16384), 16, 0, 0);
            __builtin_amdgcn_global_load_lds((const unsigned*)(p1 + 1024), (LAS unsigned*)(dst + 16384 + 1024), 16, 0, 0);
        };
        issue(0);
        int qtok[2], qr[2]; const int qc = 16 * ncb + (r32 & 15);
#pragma unroll
        for (int qi = 0; qi < 2; ++qi) {
            if (lat) { qr[qi] = r0 + 4 * rq + 2 * qi + (r32 >> 4); qtok[qi] = b * TPB + NCTX + qr[qi] * 64 + qc; }
            else { qr[qi] = 0; qtok[qi] = b * TPB + 32 * w + r32; }
        }
        bf16x8 qf[2][4];
#pragma unroll
        for (int qi = 0; qi < 2; ++qi)
#pragma unroll
            for (int ks = 0; ks < 4; ++ks) qf[qi][ks] = *(const bf16x8*)(QKV + (size_t)qtok[qi] * 3072 + head * 64 + 16 * ks + 8 * hh);
        const int wst = min(max(qc - 8, 0), 48);
        unsigned colmask = 0u;
#pragma unroll
        for (int i = 0; i < 16; ++i) { const int kc = kst + crow(i, hh); if (kc >= wst && kc < wst + 16) colmask |= 1u << i; }
        const int wr0 = r0 + 4 * rq; const int wlo = min(max(wr0 - 4, 0), 56), whi = min(max(wr0 + 3 - 4, 0), 56) + 7;
        f32x16 O[2][2]; float mrun[2], lrun[2];
#pragma unroll
        for (int qi = 0; qi < 2; ++qi) { mrun[qi] = -INFINITY; lrun[qi] = 0.f;
#pragma unroll
            for (int d = 0; d < 2; ++d)
#pragma unroll
                for (int i = 0; i < 16; ++i) O[qi][d][i] = 0.f; }
        auto subtile = [&](const LAS unsigned char* kb, const LAS unsigned char* vb, const int K0x, const int V0x, const bool masked, const int kr) {
            const int K0t = opaque(K0x), V0t = opaque(V0x);
            bf16x8 P[2][2];
#pragma unroll
            for (int qi = 0; qi < 2; ++qi) {
                f32x16 s;
#pragma unroll
                for (int i = 0; i < 16; ++i) s[i] = 0.f;
#pragma unroll
                for (int ks = 0; ks < 4; ++ks) { const bf16x8 kf = *(const LAS bf16x8*)(kb + (K0t ^ (ks << 5))); s = mfma32(kf, qf[qi][ks], s); }
                if (masked) {
                    const int rs = min(max(qr[qi] - 4, 0), 56); const bool rowok = (kr >= rs) && (kr < rs + 8);
                    const int dyc = min(max(kr - qr[qi] + 7, 0), 14);
                    const LAS float* bp = bias + opaque(dyc * 31 + 15 - qc + kst + 4 * hh);
                    const unsigned cm = rowok ? colmask : 0u;
#pragma unroll
                    for (int i = 0; i < 16; ++i) s[i] = ((cm >> i) & 1u) ? (s[i] + bp[(i & 3) + 8 * (i >> 2)]) : -INFINITY;
                }
                float mx = s[0];
#pragma unroll
                for (int i = 1; i < 16; ++i) mx = fmaxf(mx, s[i]);
                mx = fmaxf(mx, __shfl_xor(mx, 32));
                if (__any(mx > mrun[qi])) {
                    const float mnew = fmaxf(mrun[qi], mx); const float alpha = fast_exp2(mrun[qi] - mnew);
                    mrun[qi] = mnew; lrun[qi] *= alpha;
#pragma unroll
                    for (int d = 0; d < 2; ++d)
#pragma unroll
                        for (int i = 0; i < 16; ++i) O[qi][d][i] *= alpha;
                }
                const float mu = mrun[qi]; float rsum = 0.f;
#pragma unroll
                for (int i = 0; i < 16; ++i) { s[i] = fast_exp2(s[i] - mu); rsum += s[i]; }
                rsum += __shfl_xor(rsum, 32);
                lrun[qi] += rsum;
                P[qi][0] = pack_step(s, 0); P[qi][1] = pack_step(s, 1);
            }
#pragma unroll
            for (int d = 0; d < 2; ++d)
#pragma unroll
                for (int s2 = 0; s2 < 2; ++s2) {
                    const int va = V0t ^ (d << 6); const s16x4 lo = tr_read(vb + s2 * 2048 + va), hi = tr_read(vb + s2 * 2048 + 1024 + (va ^ 32));
                    const bf16x8 vf = cat4(lo, hi);
                    O[0][d] = mfma32(vf, P[0][s2], O[0][d]);
                    O[1][d] = mfma32(vf, P[1][s2], O[1][d]);
                }
        };
        for (int t = 0; t < ntile; ++t) {
            asm volatile("s_waitcnt vmcnt(0)" ::: "memory"); __builtin_amdgcn_s_barrier(); asm volatile("" ::: "memory");
            if (t + 1 < ntile) issue(t + 1);
            const LAS unsigned char* Kb = L + (t & 1) * 32768; const LAS unsigned char* Vb = Kb + 16384;
            if (t < 2) {
#pragma nounroll
                for (int sb = 0; sb < 4; ++sb) subtile(Kb + sb * 4096, Vb + sb * 4096, K0c, V0c, false, 0);
            } else {
#pragma nounroll
                for (int jr = 0; jr < 2; ++jr) { const int kr = kr_lo + 2 * (t - 2) + jr;
                    if (kr >= wlo && kr <= whi) subtile(Kb + jr * 8192, Vb + jr * 8192 + kst * 128, K0w, V0w, true, kr); }
            }
        }
#pragma unroll
        for (int qi = 0; qi < 2; ++qi) {
            if (!lat && qi == 1) continue;
            const float inv = 1.0f / lrun[qi];
            unsigned char* op = AO + (size_t)qtok[qi] * D + head * 64 + 4 * hh;
#pragma unroll
            for (int d = 0; d < 2; ++d)
#pragma unroll
                for (int g = 0; g < 4; ++g) *(unsigned*)(op + 32 * d + 8 * g) = pk4_fp8(O[qi][d][4 * g] * inv, O[qi][d][4 * g + 1] * inv, O[qi][d][4 * g + 2] * inv, O[qi][d][4 * g + 3] * inv);
        }
    }
    }
}

DI int gsw(int p) { return ((p & 3) << 2) | ((p >> 2) & 3); }
DI void phase_da_attn(Frame& F, bool with_ctx) {
    const bf16_t* QKV = (const bf16_t*)(F.ws + R_QKV); unsigned char* AO = F.ws + R_AO;
    LAS unsigned char* L = F.lds;
    LAS float* xch = (LAS float*)L;
    LAS float* misc = (LAS float*)(L + 131072);
    const int w = F.wave;
    const float lambda_init = 0.8f - 0.6f * expf(-0.3f * 2.0f);
    __syncthreads();
    if (w == 0) { const int lane = F.lane; const float* lam = F.in[IN_DALAM]; const float a = wave_sum(lam[lane] * lam[64 + lane]), c2 = wave_sum(lam[128 + lane] * lam[192 + lane]);
        if (lane == 0) misc[0] = expf(a) - expf(c2) + lambda_init; }
    __syncthreads();
    const float lam_full = misc[0];
    const int n_lat = NB * 8 * 16, n_units = n_lat + (with_ctx ? NB * 8 : 0);
    const int map = w >> 2, qw = w & 3;
    for (int unit = F.bid; unit < n_units; unit += F.G) {
        const int lane = hw_lane(), r32 = lane & 31, hh = lane >> 5;
        const int K0 = r32 * 256 + ((((map * 8 + hh) ^ gsw(r32))) << 4);
        const int q4 = (lane & 15) >> 2, p4 = lane & 3, blk = (lane >> 4) & 1, LP = 2 * blk + (p4 >> 1);
        const int V0 = (4 * hh + q4) * 256 + (q4 << 6) + ((LP ^ (hh & 3)) << 4) + (p4 & 1) * 8;
        const int drow0 = 8 * w + (lane >> 4), dpos = lane & 15;
        const int dsrc0 = (dpos ^ gsw(drow0)) * 8, dsrc1 = (dpos ^ gsw(drow0 + 4)) * 8;
        const bool lat = unit < n_lat;
        int b, head, qb;
        if (lat) { b = unit >> 7; head = (unit >> 4) & 7; qb = unit & 15; } else { const int u2 = unit - n_lat; b = u2 >> 3; head = u2 & 7; qb = 0; }
        const int qtok0 = b * TPB + (lat ? NCTX : 0) + qb * 256 + qw * 64;
        __syncthreads();
        const bf16_t* kbase = QKV + (size_t)(b * TPB) * 3072 + 1024 + head * 128;
        auto issue = [&](int t) {
            LAS unsigned char* dst = L + (t & 1) * 32768 + w * 2048;
            const bf16_t* r0 = kbase + (size_t)(t * 64 + drow0) * 3072; const bf16_t* r1 = r0 + (size_t)4 * 3072;
            __builtin_amdgcn_global_load_lds((const unsigned*)(r0 + dsrc0), (LAS unsigned*)dst, 16, 0, 0);
            __builtin_amdgcn_global_load_lds((const unsigned*)(r1 + dsrc1), (LAS unsigned*)(dst + 1024), 16, 0, 0);
            __builtin_amdgcn_global_load_lds((const unsigned*)(r0 + 1024 + dsrc0), (LAS unsigned*)(dst + 16384), 16, 0, 0);
            __builtin_amdgcn_global_load_lds((const unsigned*)(r1 + 1024 + dsrc1), (LAS unsigned*)(dst + 16384 + 1024), 16, 0, 0);
        };
        issue(0);
        bf16x8 qf[2][4];
#pragma unroll
        for (int qi = 0; qi < 2; ++qi)
#pragma unroll
            for (int ks = 0; ks < 4; ++ks) qf[qi][ks] = *(const bf16x8*)(QKV + (size_t)(qtok0 + 32 * qi + r32) * 3072 + head * 128 + map * 64 + 16 * ks + 8 * hh);
        f32x16 O[2][4]; float mrun[2], lrun[2];
#pragma unroll
        for (int qi = 0; qi < 2; ++qi) { mrun[qi] = -INFINITY; lrun[qi] = 0.f;
#pragma unroll
            for (int d = 0; d < 4; ++d)
#pragma unroll
                for (int i = 0; i < 16; ++i) O[qi][d][i] = 0.f; }
        const int ntile = lat ? 68 : 4;
        for (int t = 0; t < ntile; ++t) {
            asm volatile("s_waitcnt vmcnt(0)" ::: "memory"); __builtin_amdgcn_s_barrier(); asm volatile("" ::: "memory");
            if (t + 1 < ntile) issue(t + 1);
            const LAS unsigned char* Kb = L + (t & 1) * 32768; const LAS unsigned char* Vb = Kb + 16384;
#pragma unroll
            for (int kb = 0; kb < 2; ++kb) {
                const int K0t = opaque(K0), V0t = opaque(V0);
                bf16x8 P[2][2];
#pragma unroll
                for (int qi = 0; qi < 2; ++qi) {
                    f32x16 s;
#pragma unroll
                    for (int i = 0; i < 16; ++i) s[i] = 0.f;
#pragma unroll
                    for (int ks = 0; ks < 4; ++ks) { const bf16x8 kf = *(const LAS bf16x8*)(Kb + kb * 8192 + (K0t ^ (ks << 5))); s = mfma32(kf, qf[qi][ks], s); }
                    float mx = s[0];
#pragma unroll
                    for (int i = 1; i < 16; ++i) mx = fmaxf(mx, s[i]);
                    mx = xhalf_max(mx);
                    if (__any(mx > mrun[qi])) {
                        const float mnew = fmaxf(mrun[qi], mx); const float alpha = fast_exp2(mrun[qi] - mnew);
                        mrun[qi] = mnew; lrun[qi] *= alpha;
#pragma unroll
                        for (int d = 0; d < 4; ++d)
#pragma unroll
                            for (int i = 0; i < 16; ++i) O[qi][d][i] *= alpha;
                    }
                    const float mu = mrun[qi]; float rs = 0.f;
#pragma unroll
                    for (int i = 0; i < 16; ++i) { s[i] = fast_exp2(s[i] - mu); rs += s[i]; }
                    lrun[qi] += rs;
                    P[qi][0] = pack_step(s, 0); P[qi][1] = pack_step(s, 1);
                }
#pragma unroll
                for (int d = 0; d < 4; ++d)
#pragma unroll
                    for (int s2 = 0; s2 < 2; ++s2) {
                        const int va = V0t ^ (d << 6); const s16x4 lo = tr_read(Vb + (32 * kb + 16 * s2) * 256 + va), hi = tr_read(Vb + (32 * kb + 16 * s2) * 256 + 2048 + (va ^ 32));
                        const bf16x8 vf = cat4(lo, hi);
                        O[0][d] = mfma32(vf, P[0][s2], O[0][d]);
                        O[1][d] = mfma32(vf, P[1][s2], O[1][d]);
                    }
            }
        }
        lrun[0] = xhalf_sum_pl(lrun[0]); lrun[1] = xhalf_sum_pl(lrun[1]);
        __syncthreads();
        const int lane2 = hw_lane(), r32b = lane2 & 31, hhb = lane2 >> 5;
        if (map == 1) {
#pragma unroll
            for (int qi = 0; qi < 2; ++qi) { const float inv = 1.0f / lrun[qi];
#pragma unroll
                for (int d = 0; d < 4; ++d)
#pragma unroll
                    for (int i = 0; i < 16; ++i) xch[(qw * 128 + qi * 64 + d * 16 + i) * 64 + lane2] = O[qi][d][i] * inv; }
        }
        __syncthreads();
        if (map == 0) {
            const float* sg = F.in[IN_DASUBLN];
#pragma unroll
            for (int qi = 0; qi < 2; ++qi) {
                const float inv = 1.0f / lrun[qi]; float ss = 0.f;
#pragma unroll
                for (int d = 0; d < 4; ++d)
#pragma unroll
                    for (int i = 0; i < 16; ++i) { const float v = O[qi][d][i] * inv - lam_full * xch[(qw * 128 + qi * 64 + d * 16 + i) * 64 + lane2]; O[qi][d][i] = v; ss += v * v; }
                ss += __shfl_xor(ss, 32);
                const float rn = (1.0f - lambda_init) / sqrtf(ss * (1.0f / 128.0f) + EPS);
                unsigned char* op = AO + (size_t)(b * TPB + (lat ? NCTX : 0) + qb * 256 + qw * 64 + 32 * qi + r32b) * D + head * 128 + 4 * hhb;
#pragma unroll
                for (int d = 0; d < 4; ++d)
#pragma unroll
                    for (int g = 0; g < 4; ++g) { const f32x4 gg = *(const f32x4*)(sg + 32 * d + 8 * g + 4 * hhb);
                        *(unsigned*)(op + 32 * d + 8 * g) = pk4_fp8(O[qi][d][4 * g] * rn * gg[0], O[qi][d][4 * g + 1] * rn * gg[1], O[qi][d][4 * g + 2] * rn * gg[2], O[qi][d][4 * g + 3] * rn * gg[3]); }
            }
        }
    }
}

DI void phase_ml_prep(Frame& F) {
    const bf16_t* XM = (const bf16_t*)(F.ws + R_XM); bf16_t* XC = (bf16_t*)(F.ws + R_XC); bf16_t* V = (bf16_t*)(F.ws + R_V); float* GATES = (float*)(F.ws + R_GATES);
    const bf16_t* WGt = (const bf16_t*)(F.ws + WS_MISC + 512 * 1024);
    LAS float* part = (LAS float*)F.lds;
    const int tid = F.tid, lane = F.lane, w = F.wave;
    const int g = tid;
    float cw[5][4], cb[4], wv[16];
#pragma unroll
    for (int jj = 0; jj < 5; ++jj)
#pragma unroll
        for (int o = 0; o < 4; ++o) cw[jj][o] = F.in[IN_MLCONVW][jj * ML_INNER + 4 * g + o];
#pragma unroll
    for (int o = 0; o < 4; ++o) cb[o] = F.in[IN_MLCONVB][4 * g + o];
#pragma unroll
    for (int i = 0; i < 16; ++i) wv[i] = F.in[IN_MLWV][g * 16 + i];
    for (int tile = F.bid; tile < T / 16; tile += F.G) {
        const int t0 = tile * 16;
        const int b = t0 / TPB, tt = t0 - b * TPB; const int seg0 = b * TPB + (tt < NCTX ? 0 : NCTX), seg1 = b * TPB + (tt < NCTX ? NCTX : TPB);
        u32x2 raw[20];
#pragma unroll
        for (int i = 0; i < 20; ++i) { const int row = t0 - 2 + i; const bool in = (row >= seg0 && row < seg1); const int rc = in ? row : t0;
            raw[i] = *(const u32x2*)(XM + (size_t)rc * ML_INNER + 4 * g); if (!in) { raw[i].x = 0u; raw[i].y = 0u; } }
        auto up = [&](const u32x2 u) -> f32x4 { f32x4 r; r[0] = bflo(u.x); r[1] = bfhi(u.x); r[2] = bflo(u.y); r[3] = bfhi(u.y); return r; };
#pragma unroll
        for (int i = 0; i < 16; ++i) {
            f32x4 win[5];
#pragma unroll
            for (int jj = 0; jj < 5; ++jj) win[jj] = up(raw[i + jj]);
            f32x4 xc, vv;
#pragma unroll
            for (int o = 0; o < 4; ++o) { float a = cb[o];
#pragma unroll
                for (int jj = 0; jj < 5; ++jj) a += cw[jj][o] * win[jj][o];
                xc[o] = silu_f(a);
                vv[o] = win[2][0] * wv[o] + win[2][1] * wv[4 + o] + win[2][2] * wv[8 + o] + win[2][3] * wv[12 + o]; }
            u32x2 a; a.x = pk2(xc[0], xc[1]); a.y = pk2(xc[2], xc[3]); *(u32x2*)(XC + (size_t)(t0 + i) * ML_INNER + 4 * g) = a;
            u32x2 c; c.x = pk2(vv[0], vv[1]); c.y = pk2(vv[2], vv[3]); *(u32x2*)(V + (size_t)(t0 + i) * ML_INNER + 4 * g) = c;
        }
        asm volatile("s_waitcnt vmcnt(0)" ::: "memory");
        __syncthreads();
        {
            const bf16_t* src = (w < 4) ? XC : XM; const int kb = (w & 3) * 512;
            const bf16_t* ap = src + (size_t)(t0 + (lane & 15)) * ML_INNER + kb + 8 * (lane >> 4);
            const bf16_t* bp = WGt + (size_t)(lane & 15) * 4096 + w * 512 + 8 * (lane >> 4);
            f32x4 acc = {0.f, 0.f, 0.f, 0.f};
#pragma unroll 4
            for (int ks = 0; ks < 16; ++ks) acc = mfma16(*(const bf16x8*)(ap + 32 * ks), *(const bf16x8*)(bp + 32 * ks), acc);
#pragma unroll
            for (int i = 0; i < 4; ++i) part[w * 256 + ((lane >> 4) * 4 + i) * 16 + (lane & 15)] = acc[i];
        }
        __syncthreads();
        if (tid < 256) { const int row = tid >> 4, n = tid & 15; float s = F.in[IN_MLBGATE][n];
#pragma unroll
            for (int ww = 0; ww < 8; ++ww) s += part[ww * 256 + tid];
            if ((n >> 2) & 1) s = fminf(s, 0.f) - log1pf(expf(-fabsf(s)));
            GATES[(size_t)(t0 + row) * 16 + n] = s; }
        __syncthreads();
    }
}

constexpr int SC_Q = 0, SC_K = 65536, SC_V = 131072, SC_S = 147456  , SC_VEC = 156672  ;
constexpr int SC_STR = 144;
DI int qk_off(int p, int qd) { const int grp = qd >> 2, q4 = qd & 3; const int pq = (q4 == 1) ? 2 : (q4 == 2) ? 1 : q4; const int c = grp * 2 + (pq >> 1); return p * 1024 + ((c ^ gsw(p)) << 4) + ((pq & 1) << 3); }
DI int qk_chunk(int p, int c) { return p * 1024 + ((c ^ gsw(p)) << 4); }
DI int v_off(int s, int qd) { const int c = qd >> 1; return s * 256 + ((c ^ gsw(s)) << 4) + ((qd & 1) << 3); }

DI void phase_ml_scan(Frame& F) {
    const bf16_t* XC = (const bf16_t*)(F.ws + R_XC); const bf16_t* V = (const bf16_t*)(F.ws + R_V); const float* GATES = (const float*)(F.ws + R_GATES);
    bf16_t* HF = (bf16_t*)(F.ws + R_XM); bf16_t* HBk = (bf16_t*)(F.ws + R_HBW);
    LAS unsigned char* L = F.lds;
    LAS float* vecA = (LAS float*)(L + SC_VEC);
    LAS float* vecM = vecA + 64;
    LAS float* vecI = vecA + 128;
    LAS float* vecW = vecA + 192;
    LAS float* vecRS = vecA + 256;
    LAS float* vecQN = vecA + 512;
    LAS float* vecN = vecA + 576;
    LAS float* vecS = vecA + 1088;
    LAS float* vecFL = vecA + 1152;
    LAS float* red = (LAS float*)(L + SC_Q);
    LAS float* npart = (LAS float*)(L + SC_Q + 32768);
    const int w = F.wave;
    const int etile = w & 3, dhalf = w >> 2;
    for (int unit = F.bid; unit < 256; unit += F.G) {
        const int chain = unit >> 2, es = unit & 3; const int b = chain >> 3, dir = (chain >> 2) & 1, head = chain & 3;
        bf16_t* HO = dir ? HBk : HF;
        f32x16 C[8];
#pragma unroll
        for (int t = 0; t < 8; ++t)
#pragma unroll
            for (int i = 0; i < 16; ++i) C[t][i] = 0.f;
        __syncthreads();
        vecN[F.tid] = 0.f; float nreg = 0.f;
        if (F.tid == 0) { vecS[1] = -INFINITY; }
        { const int j = F.tid >> 4, c4 = F.tid & 15; *(LAS unsigned*)(L + SC_S + j * SC_STR + 64 + 4 * c4) = 0u; if (F.tid < 32) vecRS[64 + F.tid] = 0.f; }
        u32x2 xr[16]; u32x4 vr[2]; float g_i = 0.f, g_f = 0.f;
        auto rowof = [&](int c, int p) -> int { const bool cx = c < 4; const int cc = cx ? c : c - 4; const int seglen = cx ? NCTX : SEQ; const int st = 64 * cc + p; const int segtok = dir ? (seglen - 1 - st) : st; return b * TPB + (cx ? 0 : NCTX) + segtok; };
        auto issue = [&](int c) {
            const int tid = opaque(F.tid); const int sg = tid & 127, stq = tid >> 7;
#pragma unroll
            for (int i = 0; i < 16; ++i) { const int p = stq + 4 * i; xr[i] = *(const u32x2*)(XC + (size_t)rowof(c, p) * ML_INNER + head * 512 + 4 * sg); }
#pragma unroll
            for (int i = 0; i < 2; ++i) { const int id = tid + 512 * i; const int p = id >> 4, ch = id & 15; vr[i] = *(const u32x4*)(V + (size_t)rowof(c, p) * ML_INNER + head * 512 + es * 128 + 8 * ch); }
            if (w == 0) { const int row = rowof(c, tid); g_i = GATES[(size_t)row * 16 + dir * 8 + head]; g_f = GATES[(size_t)row * 16 + dir * 8 + 4 + head]; }
        };
        issue(0);
        for (int c = 0; c < 68; ++c) {
            __syncthreads();
            for (int rp_ = 0; rp_ < ((SCAN_DUP & 1) ? 2 : 1); ++rp_) {
                const int tid = opaque(F.tid); const int sg = tid & 127, stq = tid >> 7;
                float wq[16], wk[16];
                { const int wofs = (head * 128 + sg) * 16;
                  const f32x4* pq = (const f32x4*)(F.in[IN_MLWQ] + wofs); const f32x4* pk = (const f32x4*)(F.in[IN_MLWK] + wofs);
#pragma unroll
                  for (int i = 0; i < 4; ++i) { const f32x4 a = pq[i], bq = pk[i];
#pragma unroll
                      for (int o = 0; o < 4; ++o) { wq[4 * i + o] = a[o] * 0.044194173824159216f; wk[4 * i + o] = bq[o]; } } }
#pragma unroll
                for (int i = 0; i < 16; ++i) { const int p = stq + 4 * i; const float x0 = bflo(xr[i].x), x1 = bfhi(xr[i].x), x2 = bflo(xr[i].y), x3 = bfhi(xr[i].y);
                    float qo[4], ko[4];
#pragma unroll
                    for (int o = 0; o < 4; ++o) { qo[o] = x0 * wq[o] + x1 * wq[4 + o] + x2 * wq[8 + o] + x3 * wq[12 + o]; ko[o] = x0 * wk[o] + x1 * wk[4 + o] + x2 * wk[8 + o] + x3 * wk[12 + o]; }
                    u32x2 qq; qq.x = pk2(qo[0], qo[1]); qq.y = pk2(qo[2], qo[3]); u32x2 kk; kk.x = pk2(ko[0], ko[1]); kk.y = pk2(ko[2], ko[3]);
                    const int off = qk_off(p, sg); *(LAS u32x2*)(L + SC_Q + off) = qq; *(LAS u32x2*)(L + SC_K + off) = kk; }
#pragma unroll
                for (int i = 0; i < 2; ++i) { const int id = tid + 512 * i; const int p = id >> 4, ch = id & 15; *(LAS u32x4*)(L + SC_V + p * 256 + ((ch ^ gsw(p)) << 4)) = vr[i]; }
            }
            if (w == 0) {
                const int lane = opaque(F.lane);
                const float ig = g_i, lf = g_f;
                float bc = lf;
#pragma unroll
                for (int o = 1; o < 64; o <<= 1) { const float t = __shfl_up(bc, o); if (lane >= o) bc += t; }
                const float a = ig - bc; float pm = a;
#pragma unroll
                for (int o = 1; o < 64; o <<= 1) { const float t = __shfl_up(pm, o); if (lane >= o) pm = fmaxf(pm, t); }
                const float mprev = vecS[1];
                const float M = fmaxf(mprev, pm);
                const float M63 = __shfl(M, 63), blast = __shfl(bc, 63);
                vecA[lane] = a; vecM[lane] = M; vecI[lane] = fast_exp(mprev - M); vecW[lane] = fast_exp(a - M63);
                vecFL[lane] = fast_exp(-(bc + M));
                if (lane == 0) { vecS[0] = fast_exp(mprev - M63); vecS[2] = blast + M63; }
            }
            __syncthreads();
            __builtin_amdgcn_sched_barrier(0);
            for (int rp_ = 0; rp_ < ((SCAN_DUP & 2) ? 2 : 1); ++rp_) {
            {
                const int tid = opaque(F.tid);
                const int j = tid >> 3, part = tid & 7; float s = 0.f;
#pragma unroll
                for (int cc = 0; cc < 8; ++cc) { const int chunk = part * 8 + cc; const u32x4 u = *(const LAS u32x4*)(L + SC_Q + qk_chunk(j, chunk));
                    const int grp = chunk >> 1, hq = chunk & 1; const int d0 = grp * 16 + (hq ? 4 : 0), d1 = grp * 16 + (hq ? 12 : 8);
                    const f32x4 n0 = *(const LAS f32x4*)(vecN + d0), n1 = *(const LAS f32x4*)(vecN + d1);
                    s += bflo(u.x) * n0[0] + bfhi(u.x) * n0[1] + bflo(u.y) * n0[2] + bfhi(u.y) * n0[3];
                    s += bflo(u.z) * n1[0] + bfhi(u.z) * n1[1] + bflo(u.w) * n1[2] + bfhi(u.w) * n1[3]; }
                s += __shfl_xor(s, 1); s += __shfl_xor(s, 2); s += __shfl_xor(s, 4);
                if (part == 0) vecQN[j] = s;
            }
            __builtin_amdgcn_sched_barrier(0);
            if (w < 3) {
                const int lane = opaque(F.lane); const int r32 = lane & 31, hh = lane >> 5;
                const int jb = (w == 0) ? 0 : 1, sb = (w == 2) ? 1 : 0;
                const int srow = 32 * sb + r32, jrow = 32 * jb + r32;
                f32x16 g0, g1;
#pragma unroll
                for (int i = 0; i < 16; ++i) { g0[i] = 0.f; g1[i] = 0.f; }
#pragma unroll 4
                for (int ks = 0; ks < 32; ks += 2) {
                    const bf16x8 a0 = *(const LAS bf16x8*)(L + SC_K + qk_chunk(srow, 2 * ks + hh)), b0 = *(const LAS bf16x8*)(L + SC_Q + qk_chunk(jrow, 2 * ks + hh));
                    const bf16x8 a1 = *(const LAS bf16x8*)(L + SC_K + qk_chunk(srow, 2 * ks + 2 + hh)), b1 = *(const LAS bf16x8*)(L + SC_Q + qk_chunk(jrow, 2 * ks + 2 + hh));
                    g0 = mfma32(a0, b0, g0); g1 = mfma32(a1, b1, g1);
                }
                const float Mj = vecM[jrow]; float rs = 0.f;
#pragma unroll
                for (int g = 0; g < 4; ++g) {
                    const int s0 = 32 * sb + 8 * g + 4 * hh; const f32x4 av = *(const LAS f32x4*)(vecA + s0); float sc[4];
#pragma unroll
                    for (int i = 0; i < 4; ++i) { const float dm = (s0 + i <= jrow) ? fast_exp(av[i] - Mj) : 0.f; sc[i] = (g0[4 * g + i] + g1[4 * g + i]) * dm; rs += sc[i]; }
                    u32x2 pkv; pkv.x = pk2(sc[0], sc[1]); pkv.y = pk2(sc[2], sc[3]);
                    *(LAS u32x2*)(L + SC_S + jrow * SC_STR + s0 * 2) = pkv;
                }
                rs = xhalf_sum(rs);
                if (hh == 0) vecRS[sb * 64 + jrow] = rs;
            }
            }
            __syncthreads();
            __builtin_amdgcn_sched_barrier(0);
            f32x16 O[2];
            for (int rp_ = 0; rp_ < ((SCAN_DUP & 4) ? 2 : 1); ++rp_) {
#pragma unroll
            for (int jb = 0; jb < 2; ++jb)
#pragma unroll
                for (int i = 0; i < 16; ++i) O[jb][i] = 0.f;
                const int lane = opaque(F.lane); const int r32 = lane & 31, hh = lane >> 5;
#pragma unroll
                for (int t = 0; t < 8; ++t) {
#pragma unroll
                    for (int s2 = 0; s2 < 2; ++s2) {
                        const bf16x8 xs = pack_step(C[t], s2);
                        const int chunk = (dhalf * 256 + 32 * t + 16 * s2) / 8 + hh;
#pragma unroll
                        for (int jb = 0; jb < 2; ++jb) { const bf16x8 qb = *(const LAS bf16x8*)(L + SC_Q + qk_chunk(32 * jb + r32, chunk)); O[jb] = mfma32(xs, qb, O[jb]); }
                    }
                    if (t & 1) __builtin_amdgcn_sched_barrier(0);
                }
#pragma unroll
                for (int jb = 0; jb < 2; ++jb) { const float it = vecI[32 * jb + r32];
#pragma unroll
                    for (int i = 0; i < 16; ++i) O[jb][i] *= it; }
                const int i16 = lane & 15, tq = i16 >> 2, tp = i16 & 3, blk = (lane >> 4) & 1;
#pragma unroll
                for (int ks = 0; ks < 2; ++ks) {
                    const int s0 = 32 * dhalf + 16 * ks + 8 * hh;
                    const int qd = (32 * etile + 16 * blk + 4 * tp) >> 2;
                    const s16x4 lo = tr_read(L + SC_V + v_off(s0 + tq, qd)), hi = tr_read(L + SC_V + v_off(s0 + 4 + tq, qd));
                    const bf16x8 af = cat4(lo, hi);
#pragma unroll
                    for (int jb = 0; jb < 2; ++jb) { const bf16x8 sb = *(const LAS bf16x8*)(L + SC_S + (32 * jb + r32) * SC_STR + (32 * dhalf + 16 * ks + 8 * hh) * 2); O[jb] = mfma32(af, sb, O[jb]); }
                }
            }
            __syncthreads();
            __builtin_amdgcn_sched_barrier(0);
            if (dhalf == 1) {
                const int lane = opaque(F.lane);
#pragma unroll
                for (int jb = 0; jb < 2; ++jb)
#pragma unroll
                    for (int i = 0; i < 16; ++i) red[(etile * 32 + jb * 16 + i) * 64 + lane] = O[jb][i];
            }
            __syncthreads();
            __builtin_amdgcn_sched_barrier(0);
            if (dhalf == 0) {
                const int lane = opaque(F.lane); const int r32 = lane & 31, hh = lane >> 5;
#pragma unroll
                for (int jb = 0; jb < 2; ++jb) {
                    const int j = 32 * jb + r32;
                    const float den = vecI[j] * vecQN[j] + (vecRS[j] + vecRS[64 + j]);
                    const float dinv = 1.0f / fmaxf(fabsf(den), vecFL[j]);
                    bf16_t* op = HO + (size_t)rowof(c, j) * ML_INNER + head * 512 + es * 128 + etile * 32 + 4 * hh;
#pragma unroll
                    for (int g = 0; g < 4; ++g) { float v[4];
#pragma unroll
                        for (int i = 0; i < 4; ++i) v[i] = (O[jb][4 * g + i] + red[(etile * 32 + jb * 16 + 4 * g + i) * 64 + lane]) * dinv;
                        u32x2 wv; wv.x = pk2(v[0], v[1]); wv.y = pk2(v[2], v[3]); *(u32x2*)(op + 8 * g) = wv; }
                }
            }
            __builtin_amdgcn_sched_barrier(0);
            if (c + 1 < 68) issue(c + 1);
            __builtin_amdgcn_sched_barrier(0);
            float decay_keep;
            {
                const float decay = vecS[0]; decay_keep = decay;
                float ndep;
                { const int tid = opaque(F.tid); const int qd = tid & 127, sq = tid >> 7; f32x4 acc = {0.f, 0.f, 0.f, 0.f};
#pragma unroll
                    for (int i = 0; i < 16; ++i) { const int s = 16 * sq + i; const u32x2 kv = *(const LAS u32x2*)(L + SC_K + qk_off(s, qd)); const float ws_ = vecW[s];
                        acc[0] += ws_ * bflo(kv.x); acc[1] += ws_ * bfhi(kv.x); acc[2] += ws_ * bflo(kv.y); acc[3] += ws_ * bfhi(kv.y); }
                    *(LAS f32x4*)(npart + sq * 512 + 4 * qd) = acc; ndep = acc[0]; }
                __builtin_amdgcn_sched_barrier(0);
                int lane = opaque_dep(F.lane, ndep);
#pragma unroll
                for (int t = 0; t < 8; ++t)
#pragma unroll
                    for (int i = 0; i < 16; ++i) C[t][i] *= decay;
                bf16x8 vf[4];
                {
                    const int hh = lane >> 5, i16 = lane & 15, tq = i16 >> 2, tp = i16 & 3, blk = (lane >> 4) & 1;
#pragma unroll
                    for (int ks = 0; ks < 4; ++ks) {
                        const int s0 = 16 * ks + 8 * hh; const int qd = (32 * etile + 16 * blk + 4 * tp) >> 2;
                        const s16x4 lo = tr_read(L + SC_V + v_off(s0 + tq, qd)), hi = tr_read(L + SC_V + v_off(s0 + 4 + tq, qd));
                        const f32x4 w0 = *(const LAS f32x4*)(vecW + s0), w1 = *(const LAS f32x4*)(vecW + s0 + 4);
                        u32x4 pkv;
                        pkv.x = pk2(bf2f((bf16_t)lo[0]) * w0[0], bf2f((bf16_t)lo[1]) * w0[1]); pkv.y = pk2(bf2f((bf16_t)lo[2]) * w0[2], bf2f((bf16_t)lo[3]) * w0[3]);
                        pkv.z = pk2(bf2f((bf16_t)hi[0]) * w1[0], bf2f((bf16_t)hi[1]) * w1[1]); pkv.w = pk2(bf2f((bf16_t)hi[2]) * w1[2], bf2f((bf16_t)hi[3]) * w1[3]);
                        vf[ks] = __builtin_bit_cast(bf16x8, pkv);
                    }
                }
                __builtin_amdgcn_sched_barrier(0);
#pragma unroll
                for (int t = 0; t < 8; ++t) {
                    if (t >= 3) lane = opaque_dep(lane, C[t - 3][0]);
                    const int hh = lane >> 5, i16 = lane & 15, tq = i16 >> 2, tp = i16 & 3, blk = (lane >> 4) & 1;
                    const int qd = (dhalf * 256 + 32 * t + 16 * blk + 4 * tp) >> 2;
#pragma unroll
                    for (int ks = 0; ks < 4; ++ks) {
                        const int s0 = 16 * ks + 8 * hh;
                        const s16x4 lo = tr_read(L + SC_K + qk_off(s0 + tq, qd)), hi = tr_read(L + SC_K + qk_off(s0 + 4 + tq, qd));
                        C[t] = mfma32(cat4(lo, hi), vf[ks], C[t]);
                    }
                }
            }
            __syncthreads();
            nreg = nreg * decay_keep + ((npart[F.tid] + npart[512 + F.tid]) + (npart[1024 + F.tid] + npart[1536 + F.tid]));
            vecN[F.tid] = nreg;
            if (F.tid == 0) vecS[1] = vecS[2];
        }
    }
}

DI void phase_ml_finish(Frame& F) {
    const bf16_t* HF = (const bf16_t*)(F.ws + R_XM); const bf16_t* HBk = (const bf16_t*)(F.ws + R_HBW); const bf16_t* Z = (const bf16_t*)(F.ws + R_Z); bf16_t* XC = (bf16_t*)(F.ws + R_XC);
    const int gw = F.bid * 8 + F.wave, NGW = F.G * 8, lane = F.lane;
    for (int r = gw; r < T; r += NGW) {
#pragma unroll
        for (int hd = 0; hd < 4; ++hd) {
            const size_t off = (size_t)r * ML_INNER + hd * 512 + 8 * lane;
            const u32x4 a = *(const u32x4*)(HF + off), bq = *(const u32x4*)(HBk + off), zc = *(const u32x4*)(Z + off), xq = *(const u32x4*)(XC + off);
            float h[8];
            h[0] = bflo(a.x) + bflo(bq.x); h[1] = bfhi(a.x) + bfhi(bq.x); h[2] = bflo(a.y) + bflo(bq.y); h[3] = bfhi(a.y) + bfhi(bq.y);
            h[4] = bflo(a.z) + bflo(bq.z); h[5] = bfhi(a.z) + bfhi(bq.z); h[6] = bflo(a.w) + bflo(bq.w); h[7] = bfhi(a.w) + bfhi(bq.w);
            float s = 0.f;
#pragma unroll
            for (int i = 0; i < 8; ++i) s += h[i];
            const float mu = wave_sum(s) * (1.0f / 512.0f); float q = 0.f;
#pragma unroll
            for (int i = 0; i < 8; ++i) { h[i] -= mu; q += h[i] * h[i]; }
            const float rstd = 1.0f / sqrtf(wave_sum(q) * (1.0f / 512.0f) + EPS);
            const float* gw_ = F.in[IN_MLGNW] + hd * 512 + 8 * lane; const float* sk = F.in[IN_MLSKIP] + hd * 512 + 8 * lane;
            float zf[8], xf[8];
            zf[0] = bflo(zc.x); zf[1] = bfhi(zc.x); zf[2] = bflo(zc.y); zf[3] = bfhi(zc.y); zf[4] = bflo(zc.z); zf[5] = bfhi(zc.z); zf[6] = bflo(zc.w); zf[7] = bfhi(zc.w);
            xf[0] = bflo(xq.x); xf[1] = bfhi(xq.x); xf[2] = bflo(xq.y); xf[3] = bfhi(xq.y); xf[4] = bflo(xq.z); xf[5] = bfhi(xq.z); xf[6] = bflo(xq.w); xf[7] = bfhi(xq.w);
            float o[8];
#pragma unroll
            for (int i = 0; i < 8; ++i) o[i] = (h[i] * rstd * gw_[i] + sk[i] * xf[i]) * silu_f(zf[i]);
            u32x4 wv; wv.x = pk2(o[0], o[1]); wv.y = pk2(o[2], o[3]); wv.z = pk2(o[4], o[5]); wv.w = pk2(o[6], o[7]);
            *(u32x4*)(XC + off) = wv;
        }
    }
}

__global__ void __launch_bounds__(512, 2) mk_fwd(Args args) {
    extern __shared__ __attribute__((aligned(16))) unsigned char lds_raw[];
    Frame F;
    F.lds = (LAS unsigned char*)lds_raw; F.ws = args.ws; F.in = args.in; F.out = args.out;
    F.wave = __builtin_amdgcn_readfirstlane((int)threadIdx.x >> 6); F.lane = hw_lane(); F.tid = F.wave * 64 + F.lane; F.G = gridDim.x; F.bid = blockIdx.x;
    volatile LAS unsigned* lctl = (volatile LAS unsigned*)(F.lds + LDS_CTL);
    if (F.tid < 64) lctl[F.tid] = 0u;
    __syncthreads();
    unsigned* ctl = (unsigned*)(F.ws + WS_CTL);
    XcdBarrier bar; bar.bar = ctl + CW_BAR; bar.x = 0; bar.st = nullptr;
    if (!MK_PER_PHASE) bar = xcd_barrier_post(ctl + CW_BAR, lctl, F.tid == 0);
    const int lo = args.ph_lo, hi = args.ph_hi;
    int ph = 0;
#define NREP_(p) ((((unsigned long long)(MK_DUP) >> (p)) & 1ull) ? 2 : 1)
#define PHASE_BEGIN if (lo <= ph && ph < hi && ph <= MK_LAST_PHASE && (MK_ONLY < 0 || ph == MK_ONLY)) { for (int rep_ = 0; rep_ < NREP_(ph); ++rep_) { F.lane = hw_lane(); F.tid = F.wave * 64 + F.lane;
#define PHASE_END   if (!MK_PER_PHASE && (ph + 1 < hi || rep_ + 1 < NREP_(ph))) { const int l0 = hw_lane(); xcd_barrier(bar, F.wave == 0 && l0 == 0); } } } ++ph;

    bf16_t* HB = (bf16_t*)(F.ws + WS_HB);
    bf16_t* XS = (bf16_t*)(F.ws + WS_XS);
    const float* modv = (const float*)(F.ws + WS_MODV);
    LAS int* tbl = (LAS int*)(F.lds + pg8::STAGE_BYTES);

    PHASE_BEGIN phase_prologue(F); PHASE_END

#define MOE_BLOCK(layer) \
    PHASE_BEGIN phase_modulate<2>(F, layer); PHASE_END \
    PHASE_BEGIN { const int ntl = moe_build_table(F, layer, tbl); \
        MoeOrder S; S.G = F.G; S.c = F.bid; S.ntiles = ntl; S.K = D / 2; S.A = (const char*)(F.ws + WS_HB8); S.Bt = (const char*)(F.ws + WS_WMOE13); S.bstride = (size_t)1024 * D; \
        S.idx = (const int*)(F.ws + WS_ROUTE + 2 * MiB); S.gather = true; S.tbl = tbl; \
        pg8::EpiMoE1 E{F.ws + R_HMID}; pg8::gemm_phase<pg8::EpiMoE1, MoeOrder, true>(F.lds, D / 2, S, E, F.tid); } PHASE_END \
    PHASE_BEGIN { const int ntl = moe_build_table(F, layer, tbl); \
        MoeOrder S; S.G = F.G; S.c = F.bid; S.ntiles = ntl; S.K = MOE_H / 2; S.A = (const char*)(F.ws + R_HMID); S.Bt = (const char*)(F.ws + WS_WMOE2); S.bstride = (size_t)1024 * MOE_H; \
        S.idx = nullptr; S.gather = false; S.tbl = tbl; \
        pg8::EpiMoE2 E{(bf16_t*)(F.ws + R_Y)}; pg8::gemm_phase<pg8::EpiMoE2, MoeOrder, true>(F.lds, MOE_H / 2, S, E, F.tid); } PHASE_END

#define GEMM_DENSE8(Aptr, Wptr, N_, K_, EPI_T, ...) { pg8::DenseOrder S; S.init((const bf16_t*)(Aptr), (const bf16_t*)(Wptr), T, N_, (K_) / 2, F.G, F.bid); EPI_T E{__VA_ARGS__}; pg8::gemm_phase<EPI_T, pg8::DenseOrder, true>(F.lds, (K_) / 2, S, E, F.tid); }
#define GEMM_DENSE(Aptr, Wptr, N_, K_, EPI_T, ...) { pg8::DenseOrder S; S.init((const bf16_t*)(Aptr), (const bf16_t*)(Wptr), T, N_, K_, F.G, F.bid); EPI_T E{__VA_ARGS__}; pg8::gemm_phase<EPI_T, pg8::DenseOrder>(F.lds, K_, S, E, F.tid); }

    PHASE_BEGIN phase_modulate<0>(F, 0); PHASE_END
    PHASE_BEGIN GEMM_DENSE8(F.ws + WS_HB8, F.ws + WS_WNAQKV, 3072, D, pg8::EpiBf16, (bf16_t*)(F.ws + R_QKV), 3072, 0, 0, 4, 0.125f * 1.4426950408889634f, 1.0f / 32.0f) PHASE_END
    PHASE_BEGIN phase_na_attn(F, 0, true); PHASE_END
    PHASE_BEGIN GEMM_DENSE8(F.ws + R_AO, F.ws + WS_WNAO, D, D, pg8::EpiResid, XS, modv + (size_t)0 * 9 * 6144 + 2048, 1.0f / 32.0f) PHASE_END
    MOE_BLOCK(0)
    PHASE_BEGIN phase_modulate<1>(F, 1); { LAS float* scr = (LAS float*)(F.lds + F.wave * 16384); __syncthreads(); convert_moe(F, 1, F.bid * 8 + F.wave, F.G * 8, scr); } PHASE_END
    PHASE_BEGIN GEMM_DENSE(HB, F.ws + WS_WMLUP, 4096, D, pg8::EpiBf16, (bf16_t*)(F.ws + R_XM), ML_INNER, ML_INNER, (size_t)(R_Z - R_XM) / 2, 0, 1.0f, 1.0f) PHASE_END
    PHASE_BEGIN phase_ml_prep(F); PHASE_END
    PHASE_BEGIN phase_ml_scan(F); PHASE_END
    PHASE_BEGIN phase_ml_finish(F); PHASE_END
    PHASE_BEGIN GEMM_DENSE(F.ws + R_XC, F.ws + WS_WMLDN, D, ML_INNER, pg8::EpiResid, XS, modv + (size_t)1 * 9 * 6144 + 2048, 1.0f) PHASE_END
    MOE_BLOCK(1)
    PHASE_BEGIN phase_modulate<1>(F, 2); { LAS float* scr = (LAS float*)(F.lds + F.wave * 16384); __syncthreads(); convert_moe(F, 2, F.bid * 8 + F.wave, F.G * 8, scr); } PHASE_END
    PHASE_BEGIN GEMM_DENSE8(F.ws + WS_HB8, F.ws + WS_WDAQKV, 3072, D, pg8::EpiBf16Rope, (bf16_t*)(F.ws + R_QKV), (const float*)(F.ws + WS_MISC + 768 * 1024), 1.0f / 32.0f) PHASE_END
    PHASE_BEGIN phase_da_attn(F, true); PHASE_END
    PHASE_BEGIN GEMM_DENSE8(F.ws + R_AO, F.ws + WS_WDAO, D, D, pg8::EpiResid, XS, modv + (size_t)2 * 9 * 6144 + 2048, 1.0f / 32.0f) PHASE_END
    MOE_BLOCK(2)
    PHASE_BEGIN phase_modulate<1>(F, 3); { LAS float* scr = (LAS float*)(F.lds + F.wave * 16384); __syncthreads(); convert_moe(F, 3, F.bid * 8 + F.wave, F.G * 8, scr); } PHASE_END
    PHASE_BEGIN GEMM_DENSE8(F.ws + WS_HB8, F.ws + WS_WNAQKV + (size_t)3072 * D, 3072, D, pg8::EpiBf16, (bf16_t*)(F.ws + R_QKV), 3072, 0, 0, 4, 0.125f * 1.4426950408889634f, 1.0f / 32.0f) PHASE_END
    PHASE_BEGIN phase_na_attn(F, 1, false); PHASE_END
    PHASE_BEGIN GEMM_DENSE8(F.ws + R_AO, F.ws + WS_WNAO + (size_t)D * D, D, D, pg8::EpiResid, XS, modv + (size_t)3 * 9 * 6144 + 2048, 1.0f / 32.0f) PHASE_END
    MOE_BLOCK(3)
    if (lo <= ph && ph < hi) { F.lane = hw_lane(); F.tid = F.wave * 64 + F.lane; phase_modulate<3>(F, 3); } ++ph;
}
constexpr int N_PHASES = 1 + 7 + 9 + 7 + 7 + 1;

extern "C" void kernel_launch(void* const* d_in, const int* in_sizes, int n_in, void* d_out, int out_size, void* d_ws, size_t ws_size, hipStream_t stream) {
    static int grid = 0;
    if (grid == 0) {
        if (n_in != 33 || ws_size < WS_END) { fprintf(stderr, "kernel_launch: unexpected n_in %d or ws_size %zu (< %zu)\n", n_in, ws_size, (size_t)WS_END); grid = -1; return; }
        int dev = 0, cus = 0;
        if (hipGetDevice(&dev) != hipSuccess || hipDeviceGetAttribute(&cus, hipDeviceAttributeMultiprocessorCount, dev) != hipSuccess) { grid = -1; return; }
        if (hipFuncSetAttribute((const void*)mk_fwd, hipFuncAttributeMaxDynamicSharedMemorySize, LDS_BYTES) != hipSuccess) { fprintf(stderr, "kernel_launch: hipFuncSetAttribute failed\n"); grid = -1; return; }
        int per_cu = 0;
        if (hipOccupancyMaxActiveBlocksPerMultiprocessor(&per_cu, (const void*)mk_fwd, 512, LDS_BYTES) != hipSuccess || per_cu < 1) fprintf(stderr, "kernel_launch: occupancy query says %d\n", per_cu);
        (void)hipGetLastError();
        grid = cus;
    }
    if (grid < 0) return;
    (void)hipMemsetAsync((char*)d_ws + WS_CTL, 0, CTL_BYTES, stream);
    Args a{};
    for (int i = 0; i < 33; ++i) a.in[i] = (const float*)d_in[i];
    a.out = (float*)d_out; a.ws = (unsigned char*)d_ws;
#if MK_PER_PHASE
    for (int p = 0; p < N_PHASES; ++p) { a.ph_lo = p; a.ph_hi = p + 1; hipLaunchKernelGGL(mk_fwd, dim3(grid), dim3(512), LDS_BYTES, stream, a); }
#else
    a.ph_lo = 0; a.ph_hi = N_PHASES;
    hipLaunchKernelGGL(mk_fwd, dim3(grid), dim3(512), LDS_BYTES, stream, a);
#endif
}
```

```cpp
#include <hip/hip_runtime.h>
#include <cstdio>
#include <cstdint>

#define DI __device__ __forceinline__
#define LAS __attribute__((address_space(3)))
typedef unsigned short bf16_t;
typedef short bf16x8 __attribute__((ext_vector_type(8)));
typedef short s16x4 __attribute__((ext_vector_type(4)));
typedef float f32x2 __attribute__((ext_vector_type(2)));
typedef float f32x4 __attribute__((ext_vector_type(4)));
typedef float f32x16 __attribute__((ext_vector_type(16)));
typedef unsigned u32x2 __attribute__((ext_vector_type(2)));
typedef unsigned u32x4 __attribute__((ext_vector_type(4)));
typedef __bf16 nbf2 __attribute__((ext_vector_type(2)));
typedef int i32x4 __attribute__((ext_vector_type(4)));
typedef int i32x8 __attribute__((ext_vector_type(8)));

#ifndef MK_PER_PHASE
#define MK_PER_PHASE 0
#endif
#ifndef MK_DUP
#define MK_DUP 0ull
#endif
#ifndef SCAN_PROBE
#define SCAN_PROBE 0
#endif
#ifndef PREP_PROBE
#define PREP_PROBE 0
#endif
#ifndef PHASE_PROBE
#define PHASE_PROBE (-1)
#endif
#ifndef SCAN_DUP
#define SCAN_DUP 0
#endif
#ifndef MK_ONLY
#define MK_ONLY (-1)
#endif
#ifndef MK_LAST_PHASE
#define MK_LAST_PHASE 1000
#endif

constexpr int D = 1024, NB = 8, SEQ = 4096, NCTX = 256, TPB = SEQ + NCTX  , T = NB * TPB  ;
constexpr int NRT = T / 256;
constexpr float EPS = 1e-6f;
constexpr int ML_INNER = 2048;
constexpr int MOE_H = 512, NEXP = 32;
constexpr int MAXTILES = 304;

constexpr size_t MiB = 1u << 20;
constexpr size_t WS_CTL = 0, CTL_BYTES = 1 * MiB;
constexpr size_t WS_MODV = 1 * MiB;
constexpr size_t WS_MISC = 2 * MiB;
constexpr size_t WS_WNAQKV = 3 * MiB;
constexpr size_t WS_WNAO = 15 * MiB;
constexpr size_t WS_WMLUP = 19 * MiB;
constexpr size_t WS_WMLDN = 27 * MiB;
constexpr size_t WS_WDAQKV = 31 * MiB;
constexpr size_t WS_WDAO = 37 * MiB;
constexpr size_t WS_WMOE13 = 39 * MiB;
constexpr size_t WS_WMOE2 = 71 * MiB;
constexpr size_t WS_HB8 = 88 * MiB;
constexpr size_t WS_XS = 135 * MiB;
constexpr size_t WS_HB = 271 * MiB;
constexpr size_t WS_ROUTE = 339 * MiB;
constexpr size_t WS_R = 346 * MiB;
constexpr size_t R_QKV = WS_R;
constexpr size_t R_AO = WS_R + 204 * MiB;
constexpr size_t R_XM = WS_R;
constexpr size_t R_Z = WS_R + 136 * MiB;
constexpr size_t R_XC = WS_R + 272 * MiB;
constexpr size_t R_V = WS_R + 408 * MiB;
constexpr size_t R_HBW = WS_R + 544 * MiB;
constexpr size_t R_GATES = WS_R + 680 * MiB;
constexpr size_t R_HMID = WS_R;
constexpr size_t R_Y = WS_R + 76 * MiB;
constexpr size_t WS_END = WS_R + 683 * MiB;
constexpr int CW_BAR = 4096;
constexpr int CW_CNT = 16384;

constexpr int LDS_BYTES = 163840;
constexpr int LDS_CTL = LDS_BYTES - 256;

DI unsigned pk2(float lo, float hi) { f32x2 v = {lo, hi}; nbf2 r = __builtin_convertvector(v, nbf2); return __builtin_bit_cast(unsigned, r); }
DI unsigned pk4_fp8(float a, float b, float c, float d) { int r = 0; r = __builtin_amdgcn_cvt_pk_fp8_f32(a, b, r, false); r = __builtin_amdgcn_cvt_pk_fp8_f32(c, d, r, true); return (unsigned)r; }
DI float bflo(unsigned u) { return __builtin_bit_cast(float, u << 16); }
DI float bfhi(unsigned u) { return __builtin_bit_cast(float, u & 0xffff0000u); }
DI float bf2f(bf16_t b) { return __builtin_bit_cast(float, ((unsigned)b) << 16); }
DI int hw_lane() { int l; asm volatile("v_mbcnt_lo_u32_b32 %0, -1, 0\n\tv_mbcnt_hi_u32_b32 %0, -1, %0" : "=v"(l)); return l; }
DI int opaque(int v) { asm volatile("" : "+v"(v)); return v; }
DI int opaque_dep(int v, float dep) { asm volatile("" : "+v"(v) : "v"(dep)); return v; }
DI void dma16(const void* g, LAS unsigned char* dst) {
    unsigned keep;
    asm volatile("s_mov_b32 %0, m0\n\ts_mov_b32 m0, %2\n\ts_nop 0\n\tglobal_load_lds_dwordx4 %1, off\n\ts_mov_b32 m0, %0" : "=&s"(keep) : "v"(g), "s"((unsigned)(__UINTPTR_TYPE__)dst) : "memory");
}
DI float xhalf_max(float x) { unsigned a = __builtin_bit_cast(unsigned, x), c = a; asm volatile("" : "+v"(c)); const auto r = __builtin_amdgcn_permlane32_swap(a, c, false, false); return fmaxf(__builtin_bit_cast(float, r[0]), __builtin_bit_cast(float, r[1])); }
DI float xhalf_sum(float x) { return x + __shfl_xor(x, 32); }
DI float xhalf_sum_pl(float x) { unsigned a = __builtin_bit_cast(unsigned, x), c = a; asm volatile("" : "+v"(c)); const auto r = __builtin_amdgcn_permlane32_swap(a, c, false, false); return __builtin_bit_cast(float, r[0]) + __builtin_bit_cast(float, r[1]); }
DI float wave_sum(float v) {
#pragma unroll
    for (int o = 1; o < 64; o <<= 1) v += __shfl_xor(v, o);
    return v;
}
DI float fast_exp2(float x) { return __builtin_amdgcn_exp2f(x); }
DI float fast_exp(float x) { return __builtin_amdgcn_exp2f(x * 1.4426950408889634f); }
DI float fast_rcp(float x) { return __builtin_amdgcn_rcpf(x); }
DI float silu_f(float x) { return x * fast_rcp(1.f + fast_exp(-x)); }
DI f32x16 mfma32(bf16x8 a, bf16x8 b, f32x16 c) { return __builtin_amdgcn_mfma_f32_32x32x16_bf16(a, b, c, 0, 0, 0); }
DI f32x4 mfma16(bf16x8 a, bf16x8 b, f32x4 c) { return __builtin_amdgcn_mfma_f32_16x16x32_bf16(a, b, c, 0, 0, 0); }
DI int crow(int reg, int h) { return (reg & 3) + 8 * (reg >> 2) + 4 * h; }
DI bf16x8 pack_step(const f32x16& x, int s) {
    u32x4 p; p.x = pk2(x[8 * s], x[8 * s + 1]); p.y = pk2(x[8 * s + 2], x[8 * s + 3]); p.z = pk2(x[8 * s + 4], x[8 * s + 5]); p.w = pk2(x[8 * s + 6], x[8 * s + 7]);
    return __builtin_bit_cast(bf16x8, p);
}
DI s16x4 tr_read(const LAS unsigned char* p) { return __builtin_amdgcn_ds_read_tr16_b64_v4i16((LAS s16x4*)p); }
DI bf16x8 cat4(s16x4 lo, s16x4 hi) { return __builtin_shufflevector(lo, hi, 0, 1, 2, 3, 4, 5, 6, 7); }

#define XB_TMO      128
#define XB_XCNT(j)  (256  + 64 * (j))
#define XB_XSUB(j)  (1280 + 64 * (j))
#define XB_XGEN(j)  (2304 + 64 * (j))
#define XB_TOP      3328
#define XB_TOPGEN   3392
#define XCD_BAR_WORDS 3456
#define XB_SPIN_CAP (1u << 22)
DI unsigned xb_ld(unsigned* p)              { return __hip_atomic_load(p, __ATOMIC_RELAXED, __HIP_MEMORY_SCOPE_AGENT); }
DI unsigned xb_add(unsigned* p, unsigned v) { return __hip_atomic_fetch_add(p, v, __ATOMIC_RELAXED, __HIP_MEMORY_SCOPE_AGENT); }
DI unsigned xb_xcc_id() { return (unsigned)__builtin_amdgcn_s_getreg((3 << 11) | 20) & 0xFu; }
#define XB_SPIN(cond, bar) do { unsigned _sp = 0; while (cond) { __builtin_amdgcn_s_sleep(1); \
    if ((++_sp & 255u) == 0u) { if (xb_ld(&(bar)[XB_TMO])) break; if (_sp > XB_SPIN_CAP) { atomicAdd(&(bar)[XB_TMO], 1u); break; } } } } while (0)
struct XcdBarrier { unsigned* bar; unsigned x; volatile LAS unsigned* st; };
DI XcdBarrier xcd_barrier_post(unsigned* bar, volatile LAS unsigned* st, bool t0) {
    XcdBarrier b; b.bar = bar; b.x = xb_xcc_id(); b.st = st;
    if (t0) (void)xb_add(&bar[XB_XCNT(b.x)], 1u);
    return b;
}
DI void xcd_barrier_complete(unsigned* bar, unsigned x, unsigned& nloc, unsigned& nx) {
    const unsigned G = gridDim.x * gridDim.y * gridDim.z;
    unsigned sum, cnt, mine, sp = 0u;
    for (;;) {
        sum = 0u; cnt = 0u; mine = 0u;
#pragma unroll
        for (unsigned j = 0; j < 16; ++j) { const unsigned c = xb_ld(&bar[XB_XCNT(j)]); sum += c; cnt += (c > 0u) ? 1u : 0u; mine = (j == x) ? c : mine; }
        if (sum == G) break;
        __builtin_amdgcn_s_sleep(1);
        if ((++sp & 255u) == 0u) { if (xb_ld(&bar[XB_TMO])) break; if (sp > XB_SPIN_CAP) { atomicAdd(&bar[XB_TMO], 1u); break; } }
    }
    nloc = mine > 0u ? mine : 1u; nx = cnt > 0u ? cnt : 1u;
}
DI void xcd_barrier(const XcdBarrier& b, bool t0) {
    asm volatile("s_waitcnt vmcnt(0)" ::: "memory");
    __syncthreads();
    if (t0) {
        unsigned* bar = b.bar;
        __builtin_amdgcn_s_waitcnt(0);
        unsigned nloc = b.st[0], nx = b.st[1];
        if (nloc == 0u) { xcd_barrier_complete(bar, b.x, nloc, nx); b.st[0] = nloc; b.st[1] = nx; }
        const unsigned old = xb_add(&bar[XB_XSUB(b.x)], 1u);
        const unsigned gen = old / nloc;
        if (old + 1u == (gen + 1u) * nloc) {
            __builtin_amdgcn_fence(__ATOMIC_RELEASE, "agent");
            asm volatile("s_waitcnt vmcnt(0)" ::: "memory");
            const unsigned og = xb_add(&bar[XB_TOP], 1u);
            const unsigned tg = og / nx;
            if (og + 1u == (tg + 1u) * nx) xb_add(&bar[XB_TOPGEN], 1u);
            else XB_SPIN(xb_ld(&bar[XB_TOPGEN]) == tg, bar);
            __builtin_amdgcn_fence(__ATOMIC_ACQUIRE, "agent");
        } else {
            XB_SPIN(xb_ld(&bar[XB_TOPGEN]) == gen, bar);
            __builtin_amdgcn_fence(__ATOMIC_ACQUIRE, "agent");
            asm volatile("s_waitcnt vmcnt(0)" ::: "memory");
        }
    }
    __syncthreads();
}

namespace pg8 {
constexpr int BM = 256, BK = 64, HALF = 128, HTB = HALF * BK * 2, STAGE_BYTES = 8 * HTB, NXCD = 8, WGM = 8;
DI int lds_byte(int r, int c) { const int st = (r >> 4) * 2 + (c >> 5), rr = r & 15, cc = c & 31, ob = rr * 64 + cc * 2; return st * 1024 + (ob ^ (((ob >> 9) & 1) << 5)); }
DI void stage_rc(int b, int& R, int& C) { const int st = b / 1024, sb = b % 1024, swz = sb ^ (((sb >> 9) & 1) << 5); R = (st >> 1) * 16 + swz / 64; C = (st & 1) * 32 + (swz % 64) / 2; }
DI int perm32(int rho) { const int n = rho >> 4, i = rho & 15; return 8 * (i >> 2) + 4 * n + (i & 3); }
struct Unit { int pm, pn; const char* a; const char* b; int e, r0, cnt; };

struct DenseOrder {
    int nM, nN, nwg, G, c; const char* A; const char* Bt; size_t tstep; int skipctx;
    DI void init(const bf16_t* A_, const bf16_t* Bt_, int M, int N, int K, int G_, int c_, int skipctx_ = 0) { skipctx = skipctx_; nM = skipctx ? (M / BM) / 17 * 16 : M / BM; nN = N / BM; nwg = nM * nN; G = G_; c = c_; A = (const char*)A_; Bt = (const char*)Bt_; tstep = (size_t)BM * K * 2; }
    DI bool next(int i, Unit& u) const {
        const long L = (long)i * G + c; if (L >= nwg) return false;
        int wgid = (int)L; { const int q = nwg / NXCD, r = nwg % NXCD, xcd = wgid % NXCD, off = wgid / NXCD; wgid = (xcd < r ? xcd * (q + 1) : r * (q + 1) + (xcd - r) * q) + off; }
        const int nig = WGM * nN, gid = wgid / nig, fm = gid * WGM, gsz = (nM - fm) < WGM ? (nM - fm) : WGM;
        u.pm = fm + ((wgid % nig) % gsz); if (skipctx) u.pm = (u.pm >> 4) * 17 + 1 + (u.pm & 15); u.pn = (wgid % nig) / gsz; u.a = A + (size_t)u.pm * tstep; u.b = Bt + (size_t)u.pn * tstep; u.e = 0; u.r0 = 0; u.cnt = 0; return true;
    }
    DI void aoff(const Unit&, int K, const int (&R)[2], const int (&C)[2], unsigned (&va)[2][2]) const {
#pragma unroll
        for (int h = 0; h < 2; ++h)
#pragma unroll
            for (int i = 0; i < 2; ++i) va[h][i] = (unsigned)((R[i] + HALF * h) * K + C[i]) * 2u;
    }
};

template <class Epi, class Sched, bool FP8 = false>
DI void gemm_phase(LAS unsigned char* lds, const int K, const Sched& S, const Epi& E, const int tid) {
    const int wid = __builtin_amdgcn_readfirstlane(tid >> 6), lane = tid & 63, wr = wid >> 2, wc = wid & 3, fr = lane & 15, fq = lane >> 4;
    const int nt = K / BK;
    int Rr[2], Cc[2]; unsigned vb[2][2];
#pragma unroll
    for (int i = 0; i < 2; ++i) { stage_rc(tid * 16 + i * 8192, Rr[i], Cc[i]); const int Rb = Epi::PERM ? ((Rr[i] & ~31) + perm32(Rr[i] & 31)) : Rr[i];
#pragma unroll
        for (int h = 0; h < 2; ++h) vb[h][i] = (unsigned)((Rb + HALF * h) * K + Cc[i]) * 2u; }
    const size_t kstep = (size_t)(BK * 2);
    const unsigned ldsw = (unsigned)wid * 1024u;
    const int aoff = lds_byte(wr * 64 + fr, fq * 8), boff = lds_byte(wc * 32 + fr, fq * 8);
#define PG8_SA(b, h) (((b) * 2 + (h)) * HTB)
#define PG8_SB(b, h) ((4 + (b) * 2 + (h)) * HTB)
#define PG8_STAGE(bufoff, gbase, voff) do { _Pragma("unroll") for (int _i = 0; _i < 2; ++_i) \
        __builtin_amdgcn_global_load_lds((const unsigned*)((const char*)(gbase) + (voff)[_i]), (LAS unsigned*)(lds + (bufoff) + ldsw + _i * 8192), 16, 0, 0); } while (0)
#define PG8_LDA(dst, b, h) do { _Pragma("unroll") for (int m = 0; m < 4; ++m) { const i32x4 l_ = *(const LAS i32x4*)(lds + PG8_SA(b, h) + aoff + m * 2048); const i32x4 h_ = *(const LAS i32x4*)(lds + PG8_SA(b, h) + aoff + m * 2048 + 1024); dst[m] = __builtin_shufflevector(l_, h_, 0, 1, 2, 3, 4, 5, 6, 7); } } while (0)
#define PG8_LDB(dst, b, h) do { _Pragma("unroll") for (int n = 0; n < 2; ++n) { const i32x4 l_ = *(const LAS i32x4*)(lds + PG8_SB(b, h) + boff + n * 2048); const i32x4 h_ = *(const LAS i32x4*)(lds + PG8_SB(b, h) + boff + n * 2048 + 1024); dst[n] = __builtin_shufflevector(l_, h_, 0, 1, 2, 3, 4, 5, 6, 7); } } while (0)
#define PG8_LO(v) __builtin_bit_cast(bf16x8, __builtin_shufflevector(v, v, 0, 1, 2, 3))
#define PG8_HI(v) __builtin_bit_cast(bf16x8, __builtin_shufflevector(v, v, 4, 5, 6, 7))
#define PG8_MMA(ai, bj, At, Bt) do { __builtin_amdgcn_s_setprio(1); _Pragma("unroll") for (int m = 0; m < 4; ++m) _Pragma("unroll") for (int n = 0; n < 2; ++n) { \
        if constexpr (FP8) asm volatile("v_mfma_scale_f32_16x16x128_f8f6f4 %0, %1, %2, %0, %3, %3 op_sel_hi:[0,0,0]" : "+v"(acc[ai][bj][m][n]) : "v"(Bt[n]), "v"(At[m]), "v"(fp8_unit_scale)); \
        else { acc[ai][bj][m][n] = __builtin_amdgcn_mfma_f32_16x16x32_bf16(PG8_LO(Bt[n]), PG8_LO(At[m]), acc[ai][bj][m][n], 0, 0, 0); \
               acc[ai][bj][m][n] = __builtin_amdgcn_mfma_f32_16x16x32_bf16(PG8_HI(Bt[n]), PG8_HI(At[m]), acc[ai][bj][m][n], 0, 0, 0); } } __builtin_amdgcn_s_setprio(0); } while (0)
#define PG8_WAIT_V(n) asm volatile("s_waitcnt vmcnt(" #n ")" ::: "memory")
#define PG8_WAIT_L(n) asm volatile("s_waitcnt lgkmcnt(" #n ")" ::: "memory")
#define PG8_BAR __builtin_amdgcn_s_barrier()
#define PG8_SCHED __builtin_amdgcn_sched_barrier(0)
    Unit cur, nxt; int ui = 0;
    if (!S.next(0, cur)) return;
    f32x4 acc[2][2][4][2];
#pragma unroll
    for (int a = 0; a < 2; ++a)
#pragma unroll
        for (int b = 0; b < 2; ++b)
#pragma unroll
            for (int m = 0; m < 4; ++m)
#pragma unroll
                for (int n = 0; n < 2; ++n) acc[a][b][m][n] = (f32x4){0.f, 0.f, 0.f, 0.f};
    i32x8 At[4], B0[2], B1[2];
    const int fp8_unit_scale = 0x7f7f7f7f;
    unsigned vac[2][2], van[2][2];
    S.aoff(cur, K, Rr, Cc, vac);
    const char* cA = cur.a; const char* cB = cur.b;
    PG8_STAGE(PG8_SB(0, 0), cB, vb[0]); PG8_STAGE(PG8_SB(0, 1), cB, vb[1]); PG8_STAGE(PG8_SA(0, 0), cA, vac[0]); PG8_STAGE(PG8_SA(0, 1), cA, vac[1]);
    if (wr == 1) PG8_BAR;
    PG8_WAIT_V(2); PG8_BAR;
    PG8_STAGE(PG8_SB(1, 0), cB + kstep, vb[0]); PG8_STAGE(PG8_SA(1, 0), cA + kstep, vac[0]); PG8_STAGE(PG8_SB(1, 1), cB + kstep, vb[1]);
    PG8_WAIT_V(6); PG8_BAR;
    for (;;) {
        const bool has_next = S.next(ui + 1, nxt);
        const char* nA = has_next ? nxt.a : cA; const char* nB = has_next ? nxt.b : cB;
        if (has_next) S.aoff(nxt, K, Rr, Cc, van);
        else {
#pragma unroll
            for (int h = 0; h < 2; ++h)
#pragma unroll
                for (int i = 0; i < 2; ++i) van[h][i] = vac[h][i]; }
#pragma nounroll
        for (int t = 0; t < nt; t += 2) {
            const bool last = (t == nt - 2);
            const char* a1 = cA + (size_t)(t + 1) * kstep;
            const char* a2 = last ? nA : cA + (size_t)(t + 2) * kstep; const char* b2 = last ? nB : cB + (size_t)(t + 2) * kstep;
            const char* a3 = a2 + kstep; const char* b3 = b2 + kstep;
            unsigned v2[2][2];
#pragma unroll
            for (int h = 0; h < 2; ++h)
#pragma unroll
                for (int i = 0; i < 2; ++i) v2[h][i] = last ? van[h][i] : vac[h][i];
            PG8_LDB(B0, 0, 0); PG8_LDB(B1, 0, 1); PG8_SCHED; PG8_LDA(At, 0, 0); PG8_STAGE(PG8_SA(1, 1), a1, vac[1]);
            PG8_WAIT_V(8); PG8_WAIT_L(0); PG8_BAR; PG8_MMA(0, 0, At, B0); PG8_MMA(0, 1, At, B1); PG8_BAR; PG8_SCHED;
            PG8_LDA(At, 0, 1); PG8_STAGE(PG8_SB(0, 0), b2, vb[0]); PG8_STAGE(PG8_SB(0, 1), b2, vb[1]); PG8_STAGE(PG8_SA(0, 0), a2, v2[0]);
            PG8_WAIT_V(8); PG8_WAIT_L(0); PG8_BAR; PG8_MMA(1, 0, At, B0); PG8_MMA(1, 1, At, B1); PG8_BAR; PG8_SCHED;
            PG8_LDB(B0, 1, 0); PG8_LDB(B1, 1, 1); PG8_SCHED; PG8_LDA(At, 1, 0); PG8_STAGE(PG8_SA(0, 1), a2, v2[1]);
            PG8_WAIT_V(8); PG8_WAIT_L(0); PG8_BAR; PG8_MMA(0, 0, At, B0); PG8_MMA(0, 1, At, B1); PG8_BAR; PG8_SCHED;
            PG8_LDA(At, 1, 1); PG8_STAGE(PG8_SB(1, 0), b3, vb[0]); PG8_STAGE(PG8_SB(1, 1), b3, vb[1]); PG8_STAGE(PG8_SA(1, 0), a3, v2[0]);
            PG8_WAIT_V(8); PG8_WAIT_L(0); PG8_BAR; PG8_MMA(1, 0, At, B0); PG8_MMA(1, 1, At, B1); PG8_BAR; PG8_SCHED;
        }
        if (wr == 0) PG8_BAR;
        if constexpr (FP8) asm volatile("s_nop 15\n\ts_nop 15\n\ts_nop 15" ::: "memory");
        E(acc, cur, wr, wc, fr, fq);
        if (!has_next) break;
#pragma unroll
        for (int a = 0; a < 2; ++a)
#pragma unroll
            for (int b = 0; b < 2; ++b)
#pragma unroll
                for (int m = 0; m < 4; ++m)
#pragma unroll
                    for (int n = 0; n < 2; ++n) acc[a][b][m][n] = (f32x4){0.f, 0.f, 0.f, 0.f};
        cur = nxt; cA = nA; cB = nB; ++ui;
#pragma unroll
        for (int h = 0; h < 2; ++h)
#pragma unroll
            for (int i = 0; i < 2; ++i) vac[h][i] = van[h][i];
        if (wr == 1) PG8_BAR;
    }
    PG8_WAIT_V(0);
    PG8_BAR;
#undef PG8_SA
#undef PG8_SB
#undef PG8_STAGE
#undef PG8_LDA
#undef PG8_LDB
#undef PG8_MMA
#undef PG8_WAIT_V
#undef PG8_WAIT_L
#undef PG8_BAR
#undef PG8_SCHED
}

struct EpiBf16 {
    static constexpr bool PERM = true;
    bf16_t* O; int ldc; int split_cols; size_t split_stride; int qtiles; float qs; float os;
    DI void operator()(const f32x4 (&acc)[2][2][4][2], const Unit& u, int wr, int wc, int fr, int fq) const {
        const int row0 = u.pm * BM + wr * 64 + fr; int colt = u.pn * BM; bf16_t* base = O;
        if (split_cols) { const int t = colt / split_cols; base += (size_t)t * split_stride; colt -= t * split_cols; }
        const int col0 = colt + wc * 32 + 8 * fq; const float sc = ((u.pn < qtiles) ? qs : 1.0f) * os;
#pragma unroll
        for (int ai = 0; ai < 2; ++ai)
#pragma unroll
            for (int m = 0; m < 4; ++m) { bf16_t* rowp = base + (size_t)(row0 + ai * HALF + m * 16) * ldc + col0;
#pragma unroll
                for (int bj = 0; bj < 2; ++bj) { const f32x4 v0 = acc[ai][bj][m][0] * sc, v1 = acc[ai][bj][m][1] * sc;
                    u32x4 w; w.x = pk2(v0[0], v0[1]); w.y = pk2(v0[2], v0[3]); w.z = pk2(v1[0], v1[1]); w.w = pk2(v1[2], v1[3]);
                    *(u32x4*)(rowp + bj * HALF) = w; } }
    }
};
struct EpiBf16Rope {
    static constexpr bool PERM = true;
    bf16_t* O; const float* rope; float os;
    DI void operator()(const f32x4 (&acc)[2][2][4][2], const Unit& u, int wr, int wc, int fr, int fq) const {
        const int row0 = u.pm * BM + wr * 64 + fr; const int col0 = u.pn * BM + wc * 32 + 8 * fq;
        const int jj = u.pm % 17; const bool dorope = (u.pn < 8) && (jj != 0);
        const float qs = ((u.pn < 4) ? 0.125f * 1.4426950408889634f : 1.0f) * os;
        const bool first = fq < 2; const int fbase = 8 * (fq & 1);
#pragma unroll
        for (int ai = 0; ai < 2; ++ai)
#pragma unroll
            for (int m = 0; m < 4; ++m) { bf16_t* rowp = O + (size_t)(row0 + ai * HALF + m * 16) * 3072 + col0;
                const int pos = (wc & 1) ? (16 * m + fr) : ((jj - 1) * 4 + 2 * ai + wr);
                const float* tb = rope + ((dorope ? pos : 0) * 16 + fbase) * 2;
                const f32x4 t0 = *(const f32x4*)(tb), t1 = *(const f32x4*)(tb + 4), t2 = *(const f32x4*)(tb + 8), t3 = *(const f32x4*)(tb + 12);
                const float cs[8] = {t0[0], t0[2], t1[0], t1[2], t2[0], t2[2], t3[0], t3[2]}, sn[8] = {t0[1], t0[3], t1[1], t1[3], t2[1], t2[3], t3[1], t3[3]};
#pragma unroll
                for (int bj = 0; bj < 2; ++bj) { f32x4 v0 = acc[ai][bj][m][0], v1 = acc[ai][bj][m][1];
                    if (dorope) {
                        float x[8] = {v0[0], v0[1], v0[2], v0[3], v1[0], v1[1], v1[2], v1[3]};
#pragma unroll
                        for (int e = 0; e < 8; ++e) { const float p = __shfl_xor(x[e], 32); x[e] = first ? (x[e] * cs[e] - p * sn[e]) : (x[e] * cs[e] + p * sn[e]); }
                        v0 = (f32x4){x[0], x[1], x[2], x[3]}; v1 = (f32x4){x[4], x[5], x[6], x[7]};
                    }
                    v0 = v0 * qs; v1 = v1 * qs;
                    u32x4 w; w.x = pk2(v0[0], v0[1]); w.y = pk2(v0[2], v0[3]); w.z = pk2(v1[0], v1[1]); w.w = pk2(v1[2], v1[3]);
                    *(u32x4*)(rowp + bj * HALF) = w; } }
    }
};
struct EpiMoE1 {
    static constexpr bool PERM = true;
    unsigned char* O;
    DI void operator()(const f32x4 (&acc)[2][2][4][2], const Unit& u, int wr, int wc, int fr, int fq) const {
        const int row0 = u.pm * BM + wr * 64 + fr; const int col0 = (u.pn * BM + wc * 32 + 8 * fq) >> 1;
        const float is = 1.0f / 32.0f;
#pragma unroll
        for (int ai = 0; ai < 2; ++ai)
#pragma unroll
            for (int m = 0; m < 4; ++m) { unsigned char* rowp = O + (size_t)(row0 + ai * HALF + m * 16) * MOE_H + col0;
#pragma unroll
                for (int bj = 0; bj < 2; ++bj) { const f32x4 a = acc[ai][bj][m][0] * is, b = acc[ai][bj][m][1] * (is * 8.0f);
                    *(unsigned*)(rowp + bj * (HALF / 2)) = pk4_fp8(silu_f(a[0]) * b[0], silu_f(a[1]) * b[1], silu_f(a[2]) * b[2], silu_f(a[3]) * b[3]); } }
    }
};
struct EpiMoE2 {
    static constexpr bool PERM = true;
    unsigned char* O;
    DI void operator()(const f32x4 (&acc)[2][2][4][2], const Unit& u, int wr, int wc, int fr, int fq) const {
        const int row0 = u.pm * BM + wr * 64 + fr; const int col0 = u.pn * BM + wc * 32 + 8 * fq;
        const float is = 16.0f / 256.0f;
#pragma unroll
        for (int ai = 0; ai < 2; ++ai)
#pragma unroll
            for (int m = 0; m < 4; ++m) { unsigned char* rowp = O + (size_t)(row0 + ai * HALF + m * 16) * D + col0;
#pragma unroll
                for (int bj = 0; bj < 2; ++bj) { const f32x4 v0 = acc[ai][bj][m][0] * is, v1 = acc[ai][bj][m][1] * is;
                    u32x2 w; w.x = pk4_fp8(v0[0], v0[1], v0[2], v0[3]); w.y = pk4_fp8(v1[0], v1[1], v1[2], v1[3]);
                    *(u32x2*)(rowp + bj * HALF) = w; } }
    }
};
struct EpiResid {
    static constexpr bool PERM = false;
    bf16_t* XS; const float* modv_gate; float os;
    DI void operator()(const f32x4 (&acc)[2][2][4][2], const Unit& u, int wr, int wc, int fr, int fq) const {
        const int row0 = u.pm * BM + wr * 64 + fr, col0 = u.pn * BM + wc * 32 + 4 * fq;
        const int bb = u.pm / 17, jj = u.pm - bb * 17; const int mr = (jj == 0) ? 8 : bb;
        const float* gp = modv_gate + (size_t)mr * 6144 + col0;
        f32x4 gv[2][2];
#pragma unroll
        for (int bj = 0; bj < 2; ++bj)
#pragma unroll
            for (int n = 0; n < 2; ++n) gv[bj][n] = *(const f32x4*)(gp + bj * HALF + n * 16) * os;
#pragma unroll
        for (int ai = 0; ai < 2; ++ai)
#pragma unroll
            for (int m = 0; m < 4; ++m) { bf16_t* rowp = XS + (size_t)(row0 + ai * HALF + m * 16) * D + col0;
#pragma unroll
                for (int bj = 0; bj < 2; ++bj)
#pragma unroll
                    for (int n = 0; n < 2; ++n) { u32x2* p = (u32x2*)(rowp + bj * HALF + n * 16); const u32x2 o = *p; const f32x4 a = acc[ai][bj][m][n], g = gv[bj][n];
                        u32x2 w; w.x = pk2(bflo(o.x) + g[0] * a[0], bfhi(o.x) + g[1] * a[1]); w.y = pk2(bflo(o.y) + g[2] * a[2], bfhi(o.y) + g[3] * a[3]); *p = w; } }
    }
};
}

struct Args { const float* in[33]; float* out; unsigned char* ws; int ph_lo, ph_hi; };
struct Frame {
    LAS unsigned char* lds;
    unsigned char* ws;
    const float* const* in;
    float* out;
    int tid, lane, wave, G, bid;
};
#define IN_X 0
#define IN_C 1
#define IN_CTX 2
#define IN_CCTX 3
#define IN_MODW 4
#define IN_MODB 5
#define IN_NORMG 6
#define IN_FINALG 7
#define IN_NAQKV 8
#define IN_NAO 9
#define IN_NARPB 10
#define IN_MLUP 11
#define IN_MLCONVW 12
#define IN_MLCONVB 13
#define IN_MLWQ 14
#define IN_MLWK 15
#define IN_MLWV 16
#define IN_MLWGATE 17
#define IN_MLBGATE 18
#define IN_MLGNW 19
#define IN_MLSKIP 20
#define IN_MLDOWN 21
#define IN_DAQKV 22
#define IN_DALAM 23
#define IN_DASUBLN 24
#define IN_DAO 25
#define IN_MOEWG 26
#define IN_MOEBG 27
#define IN_MOEWR 28
#define IN_MOEBR 29
#define IN_MOEW1 30
#define IN_MOEW3 31
#define IN_MOEW2 32

DI void transpose_item(const float* W, int ldw, int K, bf16_t* WT, int k0, int n0src, int n0dst, LAS float* scr, int lane) {
#pragma unroll
    for (int i = 0; i < 32; ++i) { const int kk = 2 * i + (lane >> 5); scr[kk * 33 + (lane & 31)] = W[(size_t)(k0 + kk) * ldw + n0src + (lane & 31)]; }
    asm volatile("s_waitcnt lgkmcnt(0)" ::: "memory");
    const int c = lane & 7;
#pragma unroll
    for (int j = 0; j < 4; ++j) { const int n = (lane >> 3) + 8 * j; const LAS float* s = scr + (8 * c) * 33 + n;
        u32x4 o; o.x = pk2(s[0 * 33], s[1 * 33]); o.y = pk2(s[2 * 33], s[3 * 33]); o.z = pk2(s[4 * 33], s[5 * 33]); o.w = pk2(s[6 * 33], s[7 * 33]);
        *(u32x4*)(WT + (size_t)(n0dst + n) * K + k0 + 8 * c) = o; }
    asm volatile("s_waitcnt lgkmcnt(0)" ::: "memory");
}
DI void convert_matrix(Frame& F, const float* W, int K, int N, bf16_t* WT, int gw0, int ngw, LAS float* scr) {
    const int nblk = N / 32, nitems = (K / 64) * nblk;
    for (int it = gw0; it < nitems; it += ngw) { const int kb = it / nblk, nb = it - kb * nblk; transpose_item(W, N, K, WT, kb * 64, nb * 32, nb * 32, scr, F.lane); }
}
template <class RowMap>
DI void transpose_item_fp8(const float* W, int ldw, int K, unsigned char* WT, int k0, int n0src, const RowMap& drow, LAS float* scr, int lane) {
#pragma unroll
    for (int i = 0; i < 32; ++i) { const int kk = 2 * i + (lane >> 5); scr[kk * 33 + (lane & 31)] = W[(size_t)(k0 + kk) * ldw + n0src + (lane & 31)] * 32.0f; }
    asm volatile("s_waitcnt lgkmcnt(0)" ::: "memory");
    const int n = lane >> 1, hf = lane & 1; const LAS float* sp = scr + (32 * hf) * 33 + n;
    u32x4 o0, o1;
    o0.x = pk4_fp8(sp[0 * 33], sp[1 * 33], sp[2 * 33], sp[3 * 33]); o0.y = pk4_fp8(sp[4 * 33], sp[5 * 33], sp[6 * 33], sp[7 * 33]);
    o0.z = pk4_fp8(sp[8 * 33], sp[9 * 33], sp[10 * 33], sp[11 * 33]); o0.w = pk4_fp8(sp[12 * 33], sp[13 * 33], sp[14 * 33], sp[15 * 33]);
    o1.x = pk4_fp8(sp[16 * 33], sp[17 * 33], sp[18 * 33], sp[19 * 33]); o1.y = pk4_fp8(sp[20 * 33], sp[21 * 33], sp[22 * 33], sp[23 * 33]);
    o1.z = pk4_fp8(sp[24 * 33], sp[25 * 33], sp[26 * 33], sp[27 * 33]); o1.w = pk4_fp8(sp[28 * 33], sp[29 * 33], sp[30 * 33], sp[31 * 33]);
    unsigned char* dp = WT + (size_t)drow(n0src + n) * K + k0 + 32 * hf;
    *(u32x4*)dp = o0; *(u32x4*)(dp + 16) = o1;
    asm volatile("s_waitcnt lgkmcnt(0)" ::: "memory");
}
DI void convert_matrix_fp8(Frame& F, const float* W, int K, int N, unsigned char* WT, int gw0, int ngw, LAS float* scr) {
    const int nblk = N / 32, nitems = (K / 64) * nblk;
    auto rm = [&](int col) -> int { return col; };
    for (int it = gw0; it < nitems; it += ngw) { const int kb = it / nblk, nb = it - kb * nblk; transpose_item_fp8(W, N, K, WT, kb * 64, nb * 32, rm, scr, F.lane); }
}
DI void convert_moe(Frame& F, int layer, int gw0, int ngw, LAS float* scr) {
    const float* w1 = F.in[IN_MOEW1] + (size_t)layer * NEXP * D * MOE_H;
    const float* w3 = F.in[IN_MOEW3] + (size_t)layer * NEXP * D * MOE_H;
    const float* w2 = F.in[IN_MOEW2] + (size_t)layer * NEXP * MOE_H * D;
    unsigned char* W13T = F.ws + WS_WMOE13; unsigned char* W2T = F.ws + WS_WMOE2;
    const int per_mat = 16 * 16, per_e13 = 2 * per_mat, per_e2 = 8 * 32, per_e = per_e13 + per_e2, nitems = NEXP * per_e;
    const int lane = F.lane;
    for (int it = gw0; it < nitems; it += ngw) {
        const int e = it / per_e; int r = it - e * per_e;
        if (r < per_e13) {
            const int which = r / per_mat; r -= which * per_mat; const int kb = r >> 4, nb = r & 15;
            const float* W = (which ? w3 : w1) + (size_t)e * D * MOE_H;
            auto rm = [&](int col) -> int { return 8 * (col >> 2) + (col & 3) + 4 * which; };
            transpose_item_fp8(W, MOE_H, D, W13T + (size_t)e * 1024 * D, kb * 64, nb * 32, rm, scr, lane);
        } else {
            r -= per_e13; const int kb = r >> 5, nb = r & 31;
            auto rm = [&](int col) -> int { return col; };
            transpose_item_fp8(w2 + (size_t)e * MOE_H * D, D, MOE_H, W2T + (size_t)e * D * MOE_H, kb * 64, nb * 32, rm, scr, lane);
        }
    }
}

DI void convert_moe_in_tail(Frame& F, int layer, int nwg) {
    const int rem = nwg % F.G;
    if (F.bid < rem) return;
    __syncthreads();
    LAS float* scr = (LAS float*)(F.lds + F.wave * 16384);
    convert_moe(F, layer, (F.bid - rem) * 8 + F.wave, (F.G - rem) * 8, scr);
}

template <class Fn>
DI void in_gemm_tail(Frame& F, int nwg, Fn fn) {
    const int rem = nwg % F.G;
    if (F.bid < rem) return;
    __syncthreads();
    fn((F.bid - rem) * 8 + F.wave, (F.G - rem) * 8, (LAS float*)(F.lds + F.wave * 16384));
}

DI void phase_prologue(Frame& F) {
#ifdef TLB_TOUCH
    {
        const int gt = F.bid * 512 + F.tid, NTT = F.G * 512; unsigned acc = 0u;
        const int idxs[9] = {IN_X, IN_MODW, IN_NAQKV, IN_MLUP, IN_MLDOWN, IN_DAQKV, IN_MOEW1, IN_MOEW3, IN_MOEW2};
        const size_t lens[9] = {(size_t)NB * SEQ * D, (size_t)4 * D * 6144, (size_t)2 * D * 3072, (size_t)D * 4096, (size_t)ML_INNER * D, (size_t)D * 3072, (size_t)4 * NEXP * D * MOE_H, (size_t)4 * NEXP * D * MOE_H, (size_t)4 * NEXP * MOE_H * D};
#pragma unroll
        for (int a = 0; a < 9; ++a) { const unsigned* p = (const unsigned*)F.in[idxs[a]]; const size_t npages = lens[a] / 1024;
            for (size_t pg = gt; pg < npages; pg += NTT) acc ^= __builtin_nontemporal_load(p + pg * 1024); }
        if (acc == 0x12345678u) ((unsigned*)(F.ws + WS_CTL))[3000] = acc;
    }
#endif
    LAS float* scr = (LAS float*)(F.lds + F.wave * 16384);
    const int gw = F.bid * 8 + F.wave, NGW = F.G * 8;
    convert_matrix_fp8(F, F.in[IN_NAQKV], D, 3072, F.ws + WS_WNAQKV, gw, NGW, scr);
    convert_matrix_fp8(F, F.in[IN_NAO], D, D, F.ws + WS_WNAO, gw, NGW, scr);
    {
        bf16_t* WrT = (bf16_t*)(F.ws + WS_MISC);
        const int gt = F.bid * 512 + F.tid, NT = F.G * 512;
        for (int i = gt; i < 4 * 48 * 1024; i += NT) {
            const int l = i / (48 * 1024), r = i - l * 48 * 1024, n = r >> 10, k = r & 1023; float v = 0.f;
            if (n < 4) v = F.in[IN_MOEWG][((size_t)l * D + k) * 4 + n]; else if (n < 36) v = F.in[IN_MOEWR][((size_t)l * D + k) * 32 + (n - 4)];
            WrT[i] = (bf16_t)(pk2(v, 0.f) & 0xffffu);
        }
        bf16_t* WGt = (bf16_t*)(F.ws + WS_MISC + 512 * 1024);
        const float* wq = F.in[IN_MLWQ]; const float* wk = F.in[IN_MLWK]; const float* wv = F.in[IN_MLWV]; const float* wg = F.in[IN_MLWGATE];
        for (int i = gt; i < 16 * 4096; i += NT) {
            const int n = i >> 12, k = i & 4095; float v = 0.f;
            if (k < 2048) { const int g = k >> 2, ii = k & 3;
                for (int o = 0; o < 4; ++o) v += wq[g * 16 + ii * 4 + o] * wg[(size_t)(4 * g + o) * 16 + n] + wk[g * 16 + ii * 4 + o] * wg[(size_t)(2048 + 4 * g + o) * 16 + n];
            } else { const int kk = k - 2048, g = kk >> 2, ii = kk & 3;
                for (int o = 0; o < 4; ++o) v += wv[g * 16 + ii * 4 + o] * wg[(size_t)(4096 + 4 * g + o) * 16 + n]; }
            WGt[i] = (bf16_t)(pk2(v, 0.f) & 0xffffu);
        }
        float* rope = (float*)(F.ws + WS_MISC + 768 * 1024);
        for (int i = gt; i < 64 * 16; i += NT) { const int pos = i >> 4, f = i & 15; const float fr = powf(10000.0f, -(float)(2 * f) / 32.0f); const float ang = (float)pos * fr;
            rope[2 * i] = cosf(ang); rope[2 * i + 1] = sinf(ang); }
    }
    {
        __syncthreads();
        LAS float* sc = (LAS float*)F.lds;
        LAS float* red = (LAS float*)(F.lds + 40960);
        for (int i = F.tid; i < 9 * 1024; i += 512) { const int r = i >> 10, k = i & 1023; const float v = (r < 8) ? F.in[IN_C][r * 1024 + k] : F.in[IN_CCTX][k]; sc[i] = silu_f(v); }
        __syncthreads();
        float* modv = (float*)(F.ws + WS_MODV);
        const int c4 = (F.tid & 31) * 4, ks = F.tid >> 5;
        for (int it = F.bid; it < 4 * 48; it += F.G) {
            const int l = it / 48, n0 = (it - l * 48) * 128;
            const float* W = F.in[IN_MODW] + (size_t)l * D * 6144 + n0 + c4;
            f32x4 a[9];
#pragma unroll
            for (int r = 0; r < 9; ++r) a[r] = f32x4{0.f, 0.f, 0.f, 0.f};
#pragma unroll 8
            for (int j = 0; j < 64; ++j) { const int k = j * 16 + ks; const f32x4 w = *(const f32x4*)(W + (size_t)k * 6144);
#pragma unroll
                for (int r = 0; r < 9; ++r) { const float sv = sc[r * 1024 + k]; a[r] += w * sv; } }
#pragma unroll
            for (int r = 0; r < 9; ++r) *(LAS f32x4*)(red + (ks * 9 + r) * 128 + c4) = a[r];
            __syncthreads();
            for (int i = F.tid; i < 9 * 128; i += 512) { const int r = i >> 7, c2 = i & 127; float sum = F.in[IN_MODB][l * 6144 + n0 + c2];
#pragma unroll
                for (int g = 0; g < 16; ++g) sum += red[(g * 9 + r) * 128 + c2];
                modv[((size_t)l * 9 + r) * 6144 + n0 + c2] = sum; }
            __syncthreads();
        }
    }
}

struct RouteRec { int e0, e1, r0, r1; float w0, w1; int p0, p1; };
#if SCAN_PROBE || PREP_PROBE || (PHASE_PROBE >= 0)
#define PROBE_SCALE (1.0f + sqrtf(((const float*)(F.ws + WS_CTL))[2048]))
#else
#define PROBE_SCALE 1.0f
#endif
template <int MODE>
DI void phase_modulate(Frame& F, int layer) {
    const int gw = F.bid * 8 + F.wave, NGW = F.G * 8, lane = F.lane;
    const int RPW = (T + NGW - 1) / NGW;
    const int r_begin = gw * RPW, r_end = (r_begin + RPW < T) ? r_begin + RPW : T;
    bf16_t* XS = (bf16_t*)(F.ws + WS_XS); bf16_t* HB = (bf16_t*)(F.ws + WS_HB);
    const float* modv = (const float*)(F.ws + WS_MODV);
    const RouteRec* route = (const RouteRec*)(F.ws + WS_ROUTE);
    const unsigned char* Y = F.ws + R_Y;
    const int sh_off = (MODE == 2) ? 3072 : 0, sc_off = sh_off + 1024;
    const float* ng = F.in[IN_NORMG] + (size_t)layer * 2 * D + ((MODE == 2) ? D : 0);
    constexpr bool COMB = (MODE == 1 || MODE == 3);
    constexpr int NR = COMB ? 4 : 4;
    int tb = 0;
    if (COMB) {
        const int pl = (MODE == 3) ? 3 : layer - 1;
        unsigned* cntp = (unsigned*)(F.ws + WS_CTL) + CW_CNT + pl * 32 * 64;
        int c = (lane < 32) ? (int)__hip_atomic_load(cntp + lane * 64, __ATOMIC_RELAXED, __HIP_MEMORY_SCOPE_AGENT) : 0;
        int ntl = (c + 255) >> 8, incl = ntl;
#pragma unroll
        for (int o = 1; o < 32; o <<= 1) { const int t = __shfl_up(incl, o); if ((lane & 31) >= o) incl += t; }
        tb = incl - ntl;
    }
    const float* gnp = (MODE == 3) ? F.in[IN_FINALG] : ng;
    f32x4 gnc[4], shc[4], scc[4]; int mr_c = -1;
#pragma unroll
    for (int j = 0; j < 4; ++j) { gnc[j] = *(const f32x4*)(gnp + 4 * lane + 256 * j); shc[j] = (f32x4){0.f, 0.f, 0.f, 0.f}; scc[j] = shc[j]; }
    for (int rb = r_begin; rb < r_end; rb += NR) {
        f32x4 v[NR][4]; int rr[NR]; bool ok[NR];
#pragma unroll
        for (int k = 0; k < NR; ++k) { ok[k] = rb + k < r_end; rr[k] = ok[k] ? rb + k : r_end - 1; if (MODE == 3 && rr[k] % TPB < NCTX) { ok[k] = false; rr[k] = (rr[k] / TPB) * TPB + NCTX; } }
#pragma unroll
        for (int k = 0; k < NR; ++k) {
            const int r = rr[k]; const int b = r / TPB, t = r - b * TPB; const bool isctx = t < NCTX;
            if (MODE == 0) { const float* src = isctx ? F.in[IN_CTX] + ((size_t)b * NCTX + t) * D : F.in[IN_X] + ((size_t)b * SEQ + (t - NCTX)) * D;
#pragma unroll
                for (int j = 0; j < 4; ++j) v[k][j] = *(const f32x4*)(src + 4 * lane + 256 * j);
            } else {
#pragma unroll
                for (int j = 0; j < 4; ++j) { const u32x2 u = *(const u32x2*)(XS + (size_t)r * D + 4 * lane + 256 * j); v[k][j] = (f32x4){bflo(u.x), bfhi(u.x), bflo(u.y), bfhi(u.y)}; }
            }
        }
        if (COMB) {
            const int pl = (MODE == 3) ? 3 : layer - 1;
            unsigned y0[NR][4], y1[NR][4]; float w0[NR], w1[NR];
#pragma unroll
            for (int k = 0; k < NR; ++k) {
                const RouteRec rec = route[rr[k]];
                const int s0 = __shfl(tb, rec.e0) * 256 + rec.r0, s1 = __shfl(tb, rec.e1) * 256 + rec.r1; w0[k] = rec.w0 * (1.0f / 16.0f); w1[k] = rec.w1 * (1.0f / 16.0f);
#pragma unroll
                for (int j = 0; j < 4; ++j) { y0[k][j] = *(const unsigned*)(Y + (size_t)s0 * D + 4 * lane + 256 * j); y1[k][j] = *(const unsigned*)(Y + (size_t)s1 * D + 4 * lane + 256 * j); }
            }
#pragma unroll
            for (int k = 0; k < NR; ++k) {
                const int r = rr[k]; const int b = r / TPB, t = r - b * TPB; const int mr = (t < NCTX) ? 8 : b;
                const float* g2 = modv + ((size_t)pl * 9 + mr) * 6144 + 5120;
#pragma unroll
                for (int j = 0; j < 4; ++j) {
                    const f32x4 gg = *(const f32x4*)(g2 + 4 * lane + 256 * j);
                    const f32x2 a01 = __builtin_amdgcn_cvt_pk_f32_fp8((int)y0[k][j], false), a23 = __builtin_amdgcn_cvt_pk_f32_fp8((int)y0[k][j], true);
                    const f32x2 b01 = __builtin_amdgcn_cvt_pk_f32_fp8((int)y1[k][j], false), b23 = __builtin_amdgcn_cvt_pk_f32_fp8((int)y1[k][j], true);
                    f32x4 yy; yy[0] = w0[k] * a01[0] + w1[k] * b01[0]; yy[1] = w0[k] * a01[1] + w1[k] * b01[1]; yy[2] = w0[k] * a23[0] + w1[k] * b23[0]; yy[3] = w0[k] * a23[1] + w1[k] * b23[1];
                    v[k][j] = v[k][j] + gg * yy;
                }
            }
        }
#pragma unroll
        for (int k = 0; k < NR; ++k) {
            if (!ok[k]) continue;
            const int r = rr[k]; const int b = r / TPB, t = r - b * TPB; const bool isctx = t < NCTX; const int mr = isctx ? 8 : b;
            if (MODE == 0 || MODE == 1) {
#pragma unroll
                for (int j = 0; j < 4; ++j) { u32x2 w; w.x = pk2(v[k][j][0], v[k][j][1]); w.y = pk2(v[k][j][2], v[k][j][3]); *(u32x2*)(XS + (size_t)r * D + 4 * lane + 256 * j) = w; }
            }
            float ss = 0.f;
#pragma unroll
            for (int j = 0; j < 4; ++j) ss += (v[k][j][0] * v[k][j][0] + v[k][j][1] * v[k][j][1]) + (v[k][j][2] * v[k][j][2] + v[k][j][3] * v[k][j][3]);
            const float rstd = 1.0f / sqrtf(wave_sum(ss) * (1.0f / D) + EPS);
            if (MODE == 3) {
                if (!isctx) { float* o = F.out + ((size_t)b * SEQ + (t - NCTX)) * D;
#pragma unroll
                    for (int j = 0; j < 4; ++j) *(f32x4*)(o + 4 * lane + 256 * j) = v[k][j] * rstd * gnc[j] * PROBE_SCALE; }
            } else {
                if (__builtin_amdgcn_readfirstlane(mr) != mr_c) { mr_c = __builtin_amdgcn_readfirstlane(mr); const float* mv = modv + ((size_t)layer * 9 + mr_c) * 6144;
#pragma unroll
                    for (int j = 0; j < 4; ++j) { shc[j] = *(const f32x4*)(mv + sh_off + 4 * lane + 256 * j); scc[j] = *(const f32x4*)(mv + sc_off + 4 * lane + 256 * j) + 1.0f; } }
#pragma unroll
                for (int j = 0; j < 4; ++j) {
                    const f32x4 o = v[k][j] * rstd * gnc[j] * scc[j] + shc[j];
                    if (MODE == 2 || (MODE == 1 && layer == 1)) { u32x2 w; w.x = pk2(o[0], o[1]); w.y = pk2(o[2], o[3]); *(u32x2*)(HB + (size_t)r * D + 4 * lane + 256 * j) = w; }
                    if (!(MODE == 1 && layer == 1)) *(unsigned*)(F.ws + WS_HB8 + (size_t)r * D + 4 * lane + 256 * j) = pk4_fp8(o[0], o[1], o[2], o[3]);
                }
            }
        }
    }
    if (MODE == 2) {
        asm volatile("s_waitcnt vmcnt(0)" ::: "memory");
        const bf16_t* WrT = (const bf16_t*)(F.ws + WS_MISC) + (size_t)layer * 48 * 1024;
        LAS float* lg = (LAS float*)(F.lds + F.wave * 3072);
        unsigned* cntp = (unsigned*)(F.ws + WS_CTL) + CW_CNT + layer * 32 * 64;
        RouteRec* routew = (RouteRec*)(F.ws + WS_ROUTE);
        int* idx = (int*)(F.ws + WS_ROUTE + 2 * MiB);
        const float* bg = F.in[IN_MOEBG] + layer * 4; const float* br = F.in[IN_MOEBR] + layer * 32;
        for (int t0 = r_begin; t0 < r_end; t0 += 16) {
            int ar = t0 + (lane & 15); if (ar >= r_end) ar = r_end - 1;
            const bf16_t* ap = HB + (size_t)ar * D + 8 * (lane >> 4);
            const bf16_t* bp = WrT + (size_t)(lane & 15) * D + 8 * (lane >> 4);
            f32x4 a0 = {0.f, 0.f, 0.f, 0.f}, a1 = a0, a2 = a0;
#pragma unroll 8
            for (int ks = 0; ks < 32; ++ks) {
                const bf16x8 af = *(const bf16x8*)(ap + 32 * ks);
                a0 = mfma16(af, *(const bf16x8*)(bp + 32 * ks), a0);
                a1 = mfma16(af, *(const bf16x8*)(bp + 16 * D + 32 * ks), a1);
                a2 = mfma16(af, *(const bf16x8*)(bp + 32 * D + 32 * ks), a2);
            }
#pragma unroll
            for (int i = 0; i < 4; ++i) { const int row = (lane >> 4) * 4 + i; lg[row * 48 + (lane & 15)] = a0[i]; lg[row * 48 + 16 + (lane & 15)] = a1[i]; lg[row * 48 + 32 + (lane & 15)] = a2[i]; }
            asm volatile("s_waitcnt lgkmcnt(0)" ::: "memory");
            const int row = t0 + lane;
            if (lane < 16 && row < r_end) {
                const LAS float* L = lg + lane * 48;
                float gl[4]; int gi = 0; float gm = -3.0e38f;
#pragma unroll
                for (int k = 0; k < 4; ++k) { gl[k] = L[k] + bg[k]; if (gl[k] > gm) { gm = gl[k]; gi = k; } }
                float gs = 0.f;
#pragma unroll
                for (int k = 0; k < 4; ++k) gs += fast_exp(gl[k] - gm);
                const float gval = 1.0f / gs;
                float el[8]; float em = -3.0e38f; int i0 = 0;
#pragma unroll
                for (int k = 0; k < 8; ++k) { el[k] = L[4 + 8 * gi + k] + br[8 * gi + k]; if (el[k] > em) { em = el[k]; i0 = k; } }
                float em2 = -3.0e38f; int i1 = 0;
#pragma unroll
                for (int k = 0; k < 8; ++k) if (k != i0 && el[k] > em2) { em2 = el[k]; i1 = k; }
                const float p0 = 1.0f, p1 = fast_exp(em2 - em);
                const float inv = 1.0f / (p0 + p1);
                RouteRec rec; rec.e0 = gi * 8 + i0; rec.e1 = gi * 8 + i1; rec.w0 = gval * p0 * inv; rec.w1 = gval * p1 * inv;
                rec.r0 = (int)__hip_atomic_fetch_add(cntp + rec.e0 * 64, 1u, __ATOMIC_RELAXED, __HIP_MEMORY_SCOPE_AGENT);
                rec.r1 = (int)__hip_atomic_fetch_add(cntp + rec.e1 * 64, 1u, __ATOMIC_RELAXED, __HIP_MEMORY_SCOPE_AGENT);
                rec.p0 = 0; rec.p1 = 0;
                routew[row] = rec;
                idx[(size_t)rec.e0 * T + rec.r0] = row; idx[(size_t)rec.e1 * T + rec.r1] = row;
            }
            asm volatile("s_waitcnt lgkmcnt(0)" ::: "memory");
        }
    }
}

DI void phase_norm2_router(Frame& F, int layer) {
    const int lane = F.lane, w = F.wave, tid = F.tid;
    const int RPB = (T + F.G - 1) / F.G;
    const int row_beg = F.bid * RPB, row_end = (row_beg + RPB < T) ? row_beg + RPB : T;
    const bf16_t* XS = (const bf16_t*)(F.ws + WS_XS);
    const float* modv = (const float*)(F.ws + WS_MODV);
    const float* ng = F.in[IN_NORMG] + (size_t)layer * 2 * D + D;
    LAS unsigned char* XT = F.lds;
    LAS float* part = (LAS float*)(F.lds + 32768);
    LAS float* lg = (LAS float*)(F.lds + 32768 + 24576);
    LAS u32x4* lrec = (LAS u32x4*)(F.lds + 61440);
    LAS unsigned* lcnt = (LAS unsigned*)(F.lds + 61440 + 32768);
    const bf16_t* WrT = (const bf16_t*)(F.ws + WS_MISC) + (size_t)layer * 48 * 1024;
    unsigned* cntp = (unsigned*)(F.ws + WS_CTL) + CW_CNT + layer * 32 * 64;
    RouteRec* routew = (RouteRec*)(F.ws + WS_ROUTE);
    int* idx = (int*)(F.ws + WS_ROUTE + 2 * MiB);
    const float* bg = F.in[IN_MOEBG] + layer * 4; const float* br = F.in[IN_MOEBR] + layer * 32;
    bf16x8 bwr[3][4];
#pragma unroll
    for (int nt = 0; nt < 3; ++nt)
#pragma unroll
        for (int ks = 0; ks < 4; ++ks) bwr[nt][ks] = *(const bf16x8*)(WrT + (size_t)(16 * nt + (lane & 15)) * D + 128 * w + 32 * ks + 8 * (lane >> 4));
    f32x4 gn[4];
#pragma unroll
    for (int j = 0; j < 4; ++j) gn[j] = *(const f32x4*)(ng + 4 * lane + 256 * j);
    f32x4 shc[4], scc[4]; int mr_c = -1;
#pragma unroll
    for (int j = 0; j < 4; ++j) { shc[j] = (f32x4){0.f, 0.f, 0.f, 0.f}; scc[j] = shc[j]; }
    u32x2 nx[2][4];
    auto load_rows = [&](int r0) {
#pragma unroll
        for (int k = 0; k < 2; ++k) { const int r = min(r0 + 2 * w + k, row_end - 1);
#pragma unroll
            for (int j = 0; j < 4; ++j) nx[k][j] = *(const u32x2*)(XS + (size_t)r * D + 4 * lane + 256 * j); }
    };
    load_rows(row_beg);
    if (tid < 64) lcnt[tid] = 0u;
    for (int r0 = row_beg; r0 < row_end; r0 += 16) {
        u32x2 cur[2][4];
#pragma unroll
        for (int k = 0; k < 2; ++k)
#pragma unroll
            for (int j = 0; j < 4; ++j) cur[k][j] = nx[k][j];
        if (r0 + 16 < row_end) load_rows(r0 + 16);
#pragma unroll
        for (int k = 0; k < 2; ++k) {
            const int rl = 2 * w + k, r = r0 + rl; const bool ok = r < row_end; const int rc = ok ? r : row_end - 1;
            const int b = rc / TPB, t = rc - b * TPB; const int mr = (t < NCTX) ? 8 : b;
            f32x4 v[4]; float ss = 0.f;
#pragma unroll
            for (int j = 0; j < 4; ++j) { v[j] = (f32x4){bflo(cur[k][j].x), bfhi(cur[k][j].x), bflo(cur[k][j].y), bfhi(cur[k][j].y)}; ss += (v[j][0] * v[j][0] + v[j][1] * v[j][1]) + (v[j][2] * v[j][2] + v[j][3] * v[j][3]); }
            const float rstd = 1.0f / sqrtf(wave_sum(ss) * (1.0f / D) + EPS);
            if (__builtin_amdgcn_readfirstlane(mr) != mr_c) { mr_c = __builtin_amdgcn_readfirstlane(mr); const float* mv = modv + ((size_t)layer * 9 + mr_c) * 6144;
#pragma unroll
                for (int j = 0; j < 4; ++j) { shc[j] = *(const f32x4*)(mv + 3072 + 4 * lane + 256 * j); scc[j] = *(const f32x4*)(mv + 4096 + 4 * lane + 256 * j) + 1.0f; } }
#pragma unroll
            for (int j = 0; j < 4; ++j) {
                const f32x4 o = v[j] * rstd * gn[j] * scc[j] + shc[j];
                if (ok) *(unsigned*)(F.ws + WS_HB8 + (size_t)r * D + 4 * lane + 256 * j) = pk4_fp8(o[0], o[1], o[2], o[3]);
                u32x2 pw; pw.x = pk2(o[0], o[1]); pw.y = pk2(o[2], o[3]);
                const int chunk = (lane >> 1) + 32 * j;
                *(LAS u32x2*)(XT + rl * 2048 + ((chunk ^ rl) << 4) + (lane & 1) * 8) = pw;
            }
        }
        __syncthreads();
        {
            const int rr = lane & 15; const LAS unsigned char* abase = XT + rr * 2048;
            f32x4 a0 = {0.f, 0.f, 0.f, 0.f}, a1 = a0, a2 = a0;
#pragma unroll
            for (int ks = 0; ks < 4; ++ks) { const int c = 16 * w + 4 * ks + (lane >> 4); const bf16x8 af = *(const LAS bf16x8*)(abase + ((c ^ rr) << 4));
                a0 = mfma16(af, bwr[0][ks], a0); a1 = mfma16(af, bwr[1][ks], a1); a2 = mfma16(af, bwr[2][ks], a2); }
            LAS float* pp = part + w * 768;
#pragma unroll
            for (int i = 0; i < 4; ++i) { const int row = (lane >> 4) * 4 + i; pp[row * 48 + (lane & 15)] = a0[i]; pp[row * 48 + 16 + (lane & 15)] = a1[i]; pp[row * 48 + 32 + (lane & 15)] = a2[i]; }
        }
        __syncthreads();
        for (int vI = tid; vI < 768; vI += 512) { float s = 0.f;
#pragma unroll
            for (int ww = 0; ww < 8; ++ww) s += part[ww * 768 + vI];
            lg[vI] = s; }
        __syncthreads();
        if (tid < 16 && r0 + tid < row_end && (layer == 3 && (r0 + tid) % TPB < NCTX)) lrec[2 * (r0 + tid - row_beg)] = (u32x4){0xffffffffu, 0u, 0u, 0u};
        else if (tid < 16 && r0 + tid < row_end) {
            const int row = r0 + tid;
            const LAS float* Lr = lg + tid * 48;
            float gl[4]; int gi = 0; float gm = -3.0e38f;
#pragma unroll
            for (int k = 0; k < 4; ++k) { gl[k] = Lr[k] + bg[k]; if (gl[k] > gm) { gm = gl[k]; gi = k; } }
            float gs = 0.f;
#pragma unroll
            for (int k = 0; k < 4; ++k) gs += fast_exp(gl[k] - gm);
            const float gval = 1.0f / gs;
            float el[8]; float em = -3.0e38f; int i0 = 0;
#pragma unroll
            for (int k = 0; k < 8; ++k) { el[k] = Lr[4 + 8 * gi + k] + br[8 * gi + k]; if (el[k] > em) { em = el[k]; i0 = k; } }
            float em2 = -3.0e38f; int i1 = 0;
#pragma unroll
            for (int k = 0; k < 8; ++k) if (k != i0 && el[k] > em2) { em2 = el[k]; i1 = k; }
            const float p1 = fast_exp(em2 - em);
            const float inv = 1.0f / (1.0f + p1);
            RouteRec rec; rec.e0 = gi * 8 + i0; rec.e1 = gi * 8 + i1; rec.w0 = gval * inv; rec.w1 = gval * p1 * inv;
            rec.r0 = (int)__hip_atomic_fetch_add(lcnt + rec.e0, 1u, __ATOMIC_RELAXED, __HIP_MEMORY_SCOPE_WORKGROUP);
            rec.r1 = (int)__hip_atomic_fetch_add(lcnt + rec.e1, 1u, __ATOMIC_RELAXED, __HIP_MEMORY_SCOPE_WORKGROUP);
            rec.p0 = 0; rec.p1 = 0;
            lrec[2 * (row - row_beg)] = (u32x4){(unsigned)rec.e0, (unsigned)rec.e1, (unsigned)rec.r0, (unsigned)rec.r1}; lrec[2 * (row - row_beg) + 1] = (u32x4){__float_as_uint(rec.w0), __float_as_uint(rec.w1), 0u, 0u};
        }
    }
    __syncthreads();
    if (tid < 32) { const unsigned c = lcnt[tid]; lcnt[32 + tid] = c ? __hip_atomic_fetch_add(cntp + tid * 64, c, __ATOMIC_RELAXED, __HIP_MEMORY_SCOPE_AGENT) : 0u; }
    __syncthreads();
    for (int i = tid; i < row_end - row_beg; i += 512) {
        const u32x4 ra = lrec[2 * i], rb = lrec[2 * i + 1];
        if ((int)ra.x < 0) continue;
        RouteRec rec; rec.e0 = (int)ra.x; rec.e1 = (int)ra.y; rec.r0 = (int)ra.z; rec.r1 = (int)ra.w; rec.w0 = __uint_as_float(rb.x); rec.w1 = __uint_as_float(rb.y); rec.p0 = 0; rec.p1 = 0;
        rec.r0 += (int)lcnt[32 + rec.e0]; rec.r1 += (int)lcnt[32 + rec.e1];
        const int row = row_beg + i;
        routew[row] = rec;
        idx[(size_t)rec.e0 * T + rec.r0] = row; idx[(size_t)rec.e1 * T + rec.r1] = row;
    }
}

struct MoeOrder {
    int G, c, ntiles, K; const char* A; const char* Bt; size_t bstride; const int* idx; bool gather; bool xcdmap;
    const LAS int* tbl;
    DI bool next(int i, pg8::Unit& u) const {
        int rt, pn, e = 0;
        if (xcdmap) {
            const int x = c & 7, j = c >> 3; const int U = j + 32 * i; int tt = U >> 2; pn = U & 3; bool found = false;
            for (int k = 0; k < 4; ++k) { const int ee = x + 8 * k; const int n = tbl[ee + 1] - tbl[ee]; if (!found) { if (tt < n) { e = ee; found = true; } else tt -= n; } }
            if (!found) return false;
            rt = tbl[e] + tt;
        } else {
        const long L = (long)i * G + c; if (L >= (long)ntiles * 4) return false;
        rt = (int)(L >> 2); pn = (int)(L & 3);
        for (int k = 1; k < 32; ++k) if (tbl[k] <= rt) e = k;
        }
        u.pm = rt; u.pn = pn; u.e = e; u.r0 = (rt - tbl[e]) * 256; u.cnt = tbl[64 + e];
        u.a = gather ? A : A + (size_t)rt * 256 * K * 2;
        u.b = Bt + (size_t)e * bstride + (size_t)pn * 256 * K * 2;
        return true;
    }
    DI void aoff(const pg8::Unit& u, int K_, const int (&R)[2], const int (&C)[2], unsigned (&va)[2][2]) const {
#pragma unroll
        for (int h = 0; h < 2; ++h)
#pragma unroll
            for (int i = 0; i < 2; ++i) {
                if (gather) { int rr = u.r0 + R[i] + 128 * h; if (rr >= u.cnt) rr = 0; const int tok = idx[(size_t)u.e * T + rr]; va[h][i] = (unsigned)(tok * K_ + C[i]) * 2u; }
                else va[h][i] = (unsigned)((R[i] + 128 * h) * K_ + C[i]) * 2u;
            }
    }
};
DI int moe_build_table(Frame& F, int layer, LAS int* tbl) {
    __syncthreads();
    if (F.tid < 64) {
        unsigned* cntp = (unsigned*)(F.ws + WS_CTL) + CW_CNT + layer * 32 * 64;
        const int lane = F.tid;
        int c = (lane < 32) ? (int)__hip_atomic_load(cntp + lane * 64, __ATOMIC_RELAXED, __HIP_MEMORY_SCOPE_AGENT) : 0;
        int ntl = (c + 255) >> 8, incl = ntl;
#pragma unroll
        for (int o = 1; o < 32; o <<= 1) { const int t = __shfl_up(incl, o); if ((lane & 31) >= o) incl += t; }
        if (lane < 32) { tbl[lane] = incl - ntl; tbl[64 + lane] = c; }
        if (lane == 31) tbl[32] = incl;
    }
    __syncthreads();
    return tbl[32];
}

DI bool moe_xcd_balanced(const Frame& F, const LAS int* tbl, int ntl) {
    if (F.G != 256) return false;
    int mx = 0;
    for (int x = 0; x < 8; ++x) { int sum = 0; for (int k = 0; k < 4; ++k) sum += tbl[x + 8 * k + 1] - tbl[x + 8 * k]; mx = sum > mx ? sum : mx; }
    return mx * 8 <= ntl + (ntl >> 2) + 8;
}

template <int DV> struct FlashSt { f32x16 o[DV / 32]; float m, l; };
template <int DV, int KSTR, int VSTR, bool MASK, class SF>
DI void flash_subtile(const LAS unsigned char* kb, const LAS unsigned char* vb, const bf16x8 (&qf)[4], FlashSt<DV>& st, const float scale_l2e, const int lane, const SF& sfun) {
    const int r = lane & 31, h = lane >> 5;
    f32x16 s;
#pragma unroll
    for (int i = 0; i < 16; ++i) s[i] = 0.f;
#pragma unroll
    for (int ks = 0; ks < 4; ++ks) { const bf16x8 a = *(const LAS bf16x8*)(kb + r * KSTR + (16 * ks + 8 * h) * 2); s = mfma32(a, qf[ks], s); }
    float mx = -INFINITY;
#pragma unroll
    for (int i = 0; i < 16; ++i) { s[i] = s[i] * scale_l2e; if (MASK) s[i] += sfun(i); mx = fmaxf(mx, s[i]); }
    mx = fmaxf(mx, __shfl_xor(mx, 32));
    const float mnew = fmaxf(st.m, mx);
    const float muse = (mnew == -INFINITY) ? 0.f : mnew;
    const float alpha = fast_exp2(st.m - muse);
    float rs = 0.f;
#pragma unroll
    for (int i = 0; i < 16; ++i) { s[i] = fast_exp2(s[i] - muse); rs += s[i]; }
    rs += __shfl_xor(rs, 32);
    st.l = st.l * alpha + rs; st.m = mnew;
#pragma unroll
    for (int d = 0; d < DV / 32; ++d)
#pragma unroll
        for (int i = 0; i < 16; ++i) st.o[d][i] *= alpha;
    const bf16x8 p0 = pack_step(s, 0), p1 = pack_step(s, 1);
    const int i16 = lane & 15, q = i16 >> 2, p = i16 & 3, blk = (lane >> 4) & 1;
    const LAS unsigned char* vl = vb + (4 * h + q) * VSTR + (16 * blk + 4 * p) * 2;
#pragma unroll
    for (int d = 0; d < DV / 32; ++d) {
        const s16x4 lo0 = tr_read(vl + d * 64), hi0 = tr_read(vl + 8 * VSTR + d * 64);
        const s16x4 lo1 = tr_read(vl + 16 * VSTR + d * 64), hi1 = tr_read(vl + 24 * VSTR + d * 64);
        st.o[d] = mfma32(cat4(lo0, hi0), p0, st.o[d]);
        st.o[d] = mfma32(cat4(lo1, hi1), p1, st.o[d]);
    }
}

DI int naf(int row) { return (((row >> 1) & 1) << 2) | ((row >> 2) & 3); }
DI void phase_na_attn(Frame& F, int j  , bool with_ctx) {
    const bf16_t* QKV = (const bf16_t*)(F.ws + R_QKV); unsigned char* AO = F.ws + R_AO;
    const float* rpb = F.in[IN_NARPB] + (size_t)j * 16 * 15 * 31;
    LAS unsigned char* L = F.lds;
    LAS float* biasp = (LAS float*)(L + 65536);
    LAS float* bias = biasp + 64;
    LAS float* ninf = biasp + 64 + 465 + 64;
    const int w = F.wave;
    const int n_lat = NB * 16 * 8, n_units = n_lat + (with_ctx ? NB * 16 : 0);
    const int ncb = w & 3, rq = w >> 2;
    const int kst = __builtin_amdgcn_readfirstlane((ncb == 0) ? 0 : (ncb == 1) ? 8 : (ncb == 2) ? 24 : 32);
    for (int unit0 = F.bid; unit0 < n_units; unit0 += F.G) {
        int unit = unit0;
        if (F.G == 256 && unit0 < n_lat) { const int k = unit0 >> 8, wv = unit0 & 255; unit = ((k * 32 + (wv & 7) * 4 + ((wv >> 3) >> 3)) << 3) | ((wv >> 3) & 7); }
    const int lane = hw_lane(), tid = w * 64 + lane, r32 = lane & 31, hh = lane >> 5;
    const int q4 = (lane & 15) >> 2, p4 = lane & 3, blk = (lane >> 4) & 1, LP = 2 * blk + (p4 >> 1);
    const int K0w = (kst + r32) * 128 + ((hh ^ naf(kst + r32)) << 4), K0c = r32 * 128 + ((hh ^ naf(r32)) << 4);
    const int xbw = (kst >> 2) & 3;
    const int V0w = (4 * hh + q4) * 128 + ((q4 >> 1) << 6) + ((LP ^ ((xbw + hh) & 3)) << 4) + (p4 & 1) * 8;
    const int V0c = (4 * hh + q4) * 128 + ((q4 >> 1) << 6) + ((LP ^ (hh & 3)) << 4) + (p4 & 1) * 8;
    const int drow0 = 16 * w + (lane >> 3), dpos = lane & 7;
    const int dsrc0 = (dpos ^ naf(drow0)) * 8, dsrc1 = (dpos ^ naf(drow0 + 8)) * 8;
    {
        const bool lat = unit < n_lat;
        int b, head, rg = 0;
        if (lat) { b = unit >> 7; head = (unit >> 3) & 15; rg = unit & 7; } else { const int u2 = unit - n_lat; b = u2 >> 4; head = u2 & 15; }
        const int r0 = 8 * rg;
        const int kr_lo = min(max(r0 - 4, 0), 56), kr_hi = min(max(r0 + 3, 0), 56) + 7;
        const int nwin = lat ? (kr_hi - kr_lo + 2) / 2 : 0, ntile = 2 + nwin;
        __syncthreads();
        for (int i = tid; i < 64 + 465 + 64 + 128; i += 512) { const int bi = i - 64; biasp[i] = (bi >= 0 && bi < 465) ? rpb[head * 465 + bi] * 1.4426950408889634f : (i >= 64 + 465 + 64 ? -INFINITY : 0.f); }
        const bf16_t* kvbase = QKV + (size_t)(b * TPB) * 3072 + 1024 + head * 64;
        auto issue = [&](int t) {
            LAS unsigned char* dst = L + (t & 1) * 32768 + w * 2048;
            int tok0, tok1;
            if (t < 2) { tok0 = 128 * t + drow0; tok1 = tok0 + 8; }
            else { const int kr0 = kr_lo + 2 * (t - 2); const int ra = drow0, rb = drow0 + 8;
                tok0 = NCTX + min(kr0 + (ra >> 6), 63) * 64 + (ra & 63); tok1 = NCTX + min(kr0 + (rb >> 6), 63) * 64 + (rb & 63); }
            const bf16_t* p0 = kvbase + (size_t)tok0 * 3072 + dsrc0; const bf16_t* p1 = kvbase + (size_t)tok1 * 3072 + dsrc1;
            dma16(p0, dst);
            dma16(p1, (dst + 1024));
            dma16((p0 + 1024), (dst + 16384));
            dma16((p1 + 1024), (dst + 16384 + 1024));
        };
        issue(0);
        int qtok[2], qr[2]; const int qc = 16 * ncb + (r32 & 15);
#pragma unroll
        for (int qi = 0; qi < 2; ++qi) {
            if (lat) { qr[qi] = r0 + 4 * rq + 2 * qi + (r32 >> 4); qtok[qi] = b * TPB + NCTX + qr[qi] * 64 + qc; }
            else { qr[qi] = 0; qtok[qi] = b * TPB + 32 * w + r32; }
        }
        bf16x8 qf[2][4];
#pragma unroll
        for (int qi = 0; qi < 2; ++qi)
#pragma unroll
            for (int ks = 0; ks < 4; ++ks) qf[qi][ks] = *(const bf16x8*)(QKV + (size_t)qtok[qi] * 3072 + head * 64 + 16 * ks + 8 * hh);
#pragma unroll
        for (int qi = 0; qi < 2; ++qi)
#pragma unroll
            for (int ks = 0; ks < 4; ++ks) asm volatile("" : "+v"(qf[qi][ks]));
        const int wst = min(max(qc - 8, 0), 48);
        unsigned colmask = 0u;
#pragma unroll
        for (int i = 0; i < 16; ++i) { const int kc = kst + crow(i, hh); if (kc >= wst && kc < wst + 16) colmask |= 1u << i; }
        const int wr0 = r0 + 4 * rq; const int wlo = min(max(wr0 - 4, 0), 56), whi = min(max(wr0 + 3 - 4, 0), 56) + 7;
        const int qlo0 = min(max(wr0 - 4, 0), 56), qhi0 = min(max(wr0 + 1 - 4, 0), 56) + 7, qlo1 = min(max(wr0 + 2 - 4, 0), 56), qhi1 = min(max(wr0 + 3 - 4, 0), 56) + 7;
        f32x16 O[2][2]; float mrun[2], lrun[2];
#pragma unroll
        for (int qi = 0; qi < 2; ++qi) { mrun[qi] = -INFINITY; lrun[qi] = 0.f;
#pragma unroll
            for (int d = 0; d < 2; ++d)
#pragma unroll
                for (int i = 0; i < 16; ++i) O[qi][d][i] = 0.f; }
        auto subtile = [&](const LAS unsigned char* kb, const LAS unsigned char* vb, const int K0x, const int V0x, const bool masked, const int kr) {
            const int K0t = opaque(K0x), V0t = opaque(V0x);
            bf16x8 P[2][2];
            const bool use0 = !masked || (kr >= qlo0 && kr <= qhi0), use1 = !masked || (kr >= qlo1 && kr <= qhi1);
#pragma unroll
            for (int qi = 0; qi < 2; ++qi) {
                if (!(qi ? use1 : use0)) continue;
                f32x16 s;
                if (masked) {
                    const int rs = min(max(qr[qi] - 4, 0), 56); const bool rowok = (kr >= rs) && (kr < rs + 8);
                    const int dyc = min(max(kr - qr[qi] + 7, 0), 14);
                    const int delta = -qc + kst + 4 * hh;
                    const LAS float* bp = rowok ? (bias + opaque(dyc * 31 + 15 + delta)) : (ninf + opaque(64 + delta));
#pragma unroll
                    for (int i = 0; i < 16; ++i) s[i] = ((colmask >> i) & 1u) ? bp[(i & 3) + 8 * (i >> 2)] : -INFINITY;
                } else {
#pragma unroll
                    for (int i = 0; i < 16; ++i) s[i] = 0.f;
                }
#pragma unroll
                for (int ks = 0; ks < 4; ++ks) { const bf16x8 kf = *(const LAS bf16x8*)(kb + (K0t ^ (ks << 5))); s = mfma32(kf, qf[qi][ks], s); }
                float mx = s[0];
#pragma unroll
                for (int i = 1; i < 16; ++i) mx = fmaxf(mx, s[i]);
                mx = xhalf_max(mx);
                if (__any(mx > mrun[qi] + 8.0f)) {
                    const float mnew = fmaxf(mrun[qi], mx); const float alpha = fast_exp2(mrun[qi] - mnew);
                    mrun[qi] = mnew; lrun[qi] *= alpha;
#pragma unroll
                    for (int d = 0; d < 2; ++d)
#pragma unroll
                        for (int i = 0; i < 16; ++i) O[qi][d][i] *= alpha;
                }
                const float mu = mrun[qi]; float rsum = 0.f;
#pragma unroll
                for (int i = 0; i < 16; ++i) { s[i] = fast_exp2(s[i] - mu); rsum += s[i]; }
                lrun[qi] += rsum;
                P[qi][0] = pack_step(s, 0); P[qi][1] = pack_step(s, 1);
            }
#pragma unroll
            for (int d = 0; d < 2; ++d)
#pragma unroll
                for (int s2 = 0; s2 < 2; ++s2) {
                    const int va = V0t ^ (d << 6); const s16x4 lo = tr_read(vb + s2 * 2048 + va), hi = tr_read(vb + s2 * 2048 + 1024 + (va ^ 32));
                    const bf16x8 vf = cat4(lo, hi);
                    if (use0) O[0][d] = mfma32(vf, P[0][s2], O[0][d]);
                    if (use1) O[1][d] = mfma32(vf, P[1][s2], O[1][d]);
                }
        };
        for (int t = 0; t < ntile; ++t) {
            asm volatile("s_waitcnt vmcnt(0)" ::: "memory"); __builtin_amdgcn_s_barrier(); asm volatile("" ::: "memory");
            if (t + 1 < ntile) issue(t + 1);
            const LAS unsigned char* Kb = L + (t & 1) * 32768; const LAS unsigned char* Vb = Kb + 16384;
            if (t < 2) {
#pragma nounroll
                for (int sb = 0; sb < 4; ++sb) subtile(Kb + sb * 4096, Vb + sb * 4096, K0c, V0c, false, 0);
            } else {
#pragma nounroll
                for (int jr = 0; jr < 2; ++jr) { const int kr = kr_lo + 2 * (t - 2) + jr;
                    if (kr >= wlo && kr <= whi) subtile(Kb + jr * 8192, Vb + jr * 8192 + kst * 128, K0w, V0w, true, kr); }
            }
        }
#pragma unroll
        for (int qi = 0; qi < 2; ++qi) {
            if (!lat && qi == 1) continue;
            const float inv = 1.0f / (lrun[qi] + __shfl_xor(lrun[qi], 32));
            const int l2 = hw_lane(), r2 = l2 & 31, h2 = l2 >> 5;
            const int qt2 = lat ? (b * TPB + NCTX + (r0 + 4 * rq + 2 * qi + (r2 >> 4)) * 64 + 16 * ncb + (r2 & 15)) : (b * TPB + 32 * w + r2);
            unsigned char* op = AO + (size_t)qt2 * D + head * 64 + 4 * h2;
#pragma unroll
            for (int d = 0; d < 2; ++d)
#pragma unroll
                for (int g = 0; g < 4; ++g) *(unsigned*)(op + 32 * d + 8 * g) = pk4_fp8(O[qi][d][4 * g] * inv, O[qi][d][4 * g + 1] * inv, O[qi][d][4 * g + 2] * inv, O[qi][d][4 * g + 3] * inv);
        }
    }
    }
}

DI int gsw(int p) { return ((p & 3) << 2) | ((p >> 2) & 3); }
DI void phase_da_attn(Frame& F, bool with_ctx) {
    const bf16_t* QKV = (const bf16_t*)(F.ws + R_QKV); unsigned char* AO = F.ws + R_AO;
    LAS unsigned char* L = F.lds;
    LAS float* xch = (LAS float*)L;
    LAS float* misc = (LAS float*)(L + 131072);
    const int w = F.wave;
    const float lambda_init = 0.8f - 0.6f * expf(-0.3f * 2.0f);
    __syncthreads();
    if (w == 0) { const int lane = F.lane; const float* lam = F.in[IN_DALAM]; const float a = wave_sum(lam[lane] * lam[64 + lane]), c2 = wave_sum(lam[128 + lane] * lam[192 + lane]);
        if (lane == 0) misc[0] = expf(a) - expf(c2) + lambda_init; }
    __syncthreads();
    const float lam_full = misc[0];
    const int n_lat = NB * 8 * 16, n_units = n_lat + (with_ctx ? NB * 8 : 0);
    const int map = w >> 2, qw = w & 3;
    for (int unit0 = F.bid; unit0 < n_units; unit0 += F.G) {
        int unit = unit0;
        if (F.G == 256 && unit0 < n_lat) { const int k = unit0 >> 8, wv = unit0 & 255; unit = ((k * 16 + (wv & 7) * 2 + ((wv >> 3) >> 4)) << 4) | ((wv >> 3) & 15); }
        const int lane = hw_lane(), r32 = lane & 31, hh = lane >> 5;
        const int K0 = r32 * 256 + ((((map * 8 + hh) ^ gsw(r32))) << 4);
        const int q4 = (lane & 15) >> 2, p4 = lane & 3, blk = (lane >> 4) & 1, LP = 2 * blk + (p4 >> 1);
        const int V0 = (4 * hh + q4) * 256 + (q4 << 6) + ((LP ^ (hh & 3)) << 4) + (p4 & 1) * 8;
        const int drow0 = 8 * w + (lane >> 4), dpos = lane & 15;
        const int dsrc0 = (dpos ^ gsw(drow0)) * 8, dsrc1 = (dpos ^ gsw(drow0 + 4)) * 8;
        const bool lat = unit < n_lat;
        int b, head, qb;
        if (lat) { b = unit >> 7; head = (unit >> 4) & 7; qb = unit & 15; } else { const int u2 = unit - n_lat; b = u2 >> 3; head = u2 & 7; qb = 0; }
        const int qtok0 = b * TPB + (lat ? NCTX : 0) + qb * 256 + qw * 64;
        __syncthreads();
        const bf16_t* kbase = QKV + (size_t)(b * TPB) * 3072 + 1024 + head * 128;
        auto issue = [&](int t) {
            LAS unsigned char* dst = L + (t & 1) * 32768 + w * 2048;
            const bf16_t* r0 = kbase + (size_t)(t * 64 + drow0) * 3072; const bf16_t* r1 = r0 + (size_t)4 * 3072;
            dma16((r0 + dsrc0), dst);
            dma16((r1 + dsrc1), (dst + 1024));
            dma16((r0 + 1024 + dsrc0), (dst + 16384));
            dma16((r1 + 1024 + dsrc1), (dst + 16384 + 1024));
        };
        issue(0);
        bf16x8 qf[2][4];
#pragma unroll
        for (int qi = 0; qi < 2; ++qi)
#pragma unroll
            for (int ks = 0; ks < 4; ++ks) qf[qi][ks] = *(const bf16x8*)(QKV + (size_t)(qtok0 + 32 * qi + r32) * 3072 + head * 128 + map * 64 + 16 * ks + 8 * hh);
#pragma unroll
        for (int qi = 0; qi < 2; ++qi)
#pragma unroll
            for (int ks = 0; ks < 4; ++ks) asm volatile("" : "+v"(qf[qi][ks]));
        f32x16 O[2][4]; float mrun[2], lrun[2];
#pragma unroll
        for (int qi = 0; qi < 2; ++qi) { mrun[qi] = 0.f; lrun[qi] = 0.f;
#pragma unroll
            for (int d = 0; d < 4; ++d)
#pragma unroll
                for (int i = 0; i < 16; ++i) O[qi][d][i] = 0.f; }
        const int ntile = lat ? 68 : 4;
        for (int t = 0; t < ntile; ++t) {
            asm volatile("s_waitcnt vmcnt(0)" ::: "memory"); __builtin_amdgcn_s_barrier(); asm volatile("" ::: "memory");
            if (t + 1 < ntile) issue(t + 1);
            const LAS unsigned char* Kb = L + (t & 1) * 32768; const LAS unsigned char* Vb = Kb + 16384;
#pragma unroll
            for (int kb = 0; kb < 2; ++kb) {
                const bool first = (t == 0) && (kb == 0);
                const int K0t = opaque(K0), V0t = opaque(V0);
                bf16x8 P[2][2];
#pragma unroll
                for (int qi = 0; qi < 2; ++qi) {
                    f32x16 s; { float ninit = -mrun[qi]; asm volatile("" : "+v"(ninit));
#pragma unroll
                        for (int i = 0; i < 16; ++i) s[i] = ninit; }
#pragma unroll
                    for (int ks = 0; ks < 4; ++ks) { const bf16x8 kf = *(const LAS bf16x8*)(Kb + kb * 8192 + (K0t ^ (ks << 5))); s = mfma32(kf, qf[qi][ks], s); }
                    if (first) {
                        float mx = s[0];
#pragma unroll
                        for (int i = 1; i < 16; ++i) mx = fmaxf(mx, s[i]);
                        mx = xhalf_max(mx); mrun[qi] += mx;
#pragma unroll
                        for (int i = 0; i < 16; ++i) s[i] -= mx;
                    }
                    float rs = 0.f;
#pragma unroll
                    for (int i = 0; i < 16; ++i) { s[i] = fast_exp2(s[i]); rs += s[i]; }
                    if (!first && __any(!(rs < 0x1p30f))) {
                        { float ninit = -mrun[qi]; asm volatile("" : "+v"(ninit));
#pragma unroll
                          for (int i = 0; i < 16; ++i) s[i] = ninit; }
#pragma unroll
                        for (int ks = 0; ks < 4; ++ks) { const bf16x8 kf = *(const LAS bf16x8*)(Kb + kb * 8192 + (K0t ^ (ks << 5))); s = mfma32(kf, qf[qi][ks], s); }
                        float mx = s[0];
#pragma unroll
                        for (int i = 1; i < 16; ++i) mx = fmaxf(mx, s[i]);
                        mx = xhalf_max(mx);
                        const float shift = fmaxf(mx, 0.f), alpha = fast_exp2(-shift);
                        mrun[qi] += shift; lrun[qi] *= alpha;
#pragma unroll
                        for (int d = 0; d < 4; ++d)
#pragma unroll
                            for (int i = 0; i < 16; ++i) O[qi][d][i] *= alpha;
                        rs = 0.f;
#pragma unroll
                        for (int i = 0; i < 16; ++i) { s[i] = fast_exp2(s[i] - shift); rs += s[i]; }
                    }
                    lrun[qi] += rs;
                    P[qi][0] = pack_step(s, 0); P[qi][1] = pack_step(s, 1);
                }
#pragma unroll
                for (int d = 0; d < 4; ++d)
#pragma unroll
                    for (int s2 = 0; s2 < 2; ++s2) {
                        const int va = V0t ^ (d << 6); const s16x4 lo = tr_read(Vb + (32 * kb + 16 * s2) * 256 + va), hi = tr_read(Vb + (32 * kb + 16 * s2) * 256 + 2048 + (va ^ 32));
                        const bf16x8 vf = cat4(lo, hi);
                        O[0][d] = mfma32(vf, P[0][s2], O[0][d]);
                        O[1][d] = mfma32(vf, P[1][s2], O[1][d]);
                    }
            }
        }
        lrun[0] += __shfl_xor(lrun[0], 32); lrun[1] += __shfl_xor(lrun[1], 32);
        __syncthreads();
        const int lane2 = hw_lane(), r32b = lane2 & 31, hhb = lane2 >> 5;
        if (map == 1) {
#pragma unroll
            for (int qi = 0; qi < 2; ++qi) { const float inv = 1.0f / lrun[qi];
#pragma unroll
                for (int d = 0; d < 4; ++d)
#pragma unroll
                    for (int i = 0; i < 16; ++i) xch[(qw * 128 + qi * 64 + d * 16 + i) * 64 + lane2] = O[qi][d][i] * inv; }
        }
        __syncthreads();
        if (map == 0) {
            const float* sg = F.in[IN_DASUBLN];
#pragma unroll
            for (int qi = 0; qi < 2; ++qi) {
                const float inv = 1.0f / lrun[qi]; float ss = 0.f;
#pragma unroll
                for (int d = 0; d < 4; ++d)
#pragma unroll
                    for (int i = 0; i < 16; ++i) { const float v = O[qi][d][i] * inv - lam_full * xch[(qw * 128 + qi * 64 + d * 16 + i) * 64 + lane2]; O[qi][d][i] = v; ss += v * v; }
                ss += __shfl_xor(ss, 32);
                const float rn = (1.0f - lambda_init) / sqrtf(ss * (1.0f / 128.0f) + EPS);
                unsigned char* op = AO + (size_t)(b * TPB + (lat ? NCTX : 0) + qb * 256 + qw * 64 + 32 * qi + r32b) * D + head * 128 + 4 * hhb;
#pragma unroll
                for (int d = 0; d < 4; ++d)
#pragma unroll
                    for (int g = 0; g < 4; ++g) { const f32x4 gg = *(const f32x4*)(sg + 32 * d + 8 * g + 4 * hhb);
                        *(unsigned*)(op + 32 * d + 8 * g) = pk4_fp8(O[qi][d][4 * g] * rn * gg[0], O[qi][d][4 * g + 1] * rn * gg[1], O[qi][d][4 * g + 2] * rn * gg[2], O[qi][d][4 * g + 3] * rn * gg[3]); }
            }
        }
    }
}

#if PREP_PROBE
#define PREP_STAMP(k) do { const unsigned long long t_ = __builtin_amdgcn_s_memtime(); pacc[k] += t_ - plast; plast = t_; } while (0)
#else
#define PREP_STAMP(k) do { } while (0)
#endif
DI void phase_ml_prep(Frame& F) {
#if PREP_PROBE
    unsigned long long pacc[4] = {0, 0, 0, 0}; unsigned long long plast = __builtin_amdgcn_s_memtime();
#endif
    const bf16_t* XM = (const bf16_t*)(F.ws + R_XM); bf16_t* XC = (bf16_t*)(F.ws + R_XC); bf16_t* V = (bf16_t*)(F.ws + R_V); float* GATES = (float*)(F.ws + R_GATES);
    const bf16_t* WGt = (const bf16_t*)(F.ws + WS_MISC + 512 * 1024);
    LAS unsigned char* XT = F.lds;
    LAS float* part = (LAS float*)(F.lds + 131072);
    const int tid = F.tid, lane = F.lane, w = F.wave;
    const int g = tid;
    f32x2 cw2[5][2], cb2[2], wv2[4][2];
#pragma unroll
    for (int jj = 0; jj < 5; ++jj) { const f32x4 a = *(const f32x4*)(F.in[IN_MLCONVW] + jj * ML_INNER + 4 * g); cw2[jj][0] = (f32x2){a[0], a[1]}; cw2[jj][1] = (f32x2){a[2], a[3]}; }
    { const f32x4 a = *(const f32x4*)(F.in[IN_MLCONVB] + 4 * g); cb2[0] = (f32x2){a[0], a[1]}; cb2[1] = (f32x2){a[2], a[3]}; }
#pragma unroll
    for (int i = 0; i < 4; ++i) { const f32x4 a = *(const f32x4*)(F.in[IN_MLWV] + g * 16 + 4 * i); wv2[i][0] = (f32x2){a[0], a[1]}; wv2[i][1] = (f32x2){a[2], a[3]}; }
    const float bgate = (tid < 256) ? F.in[IN_MLBGATE][tid & 15] : 0.f;
    auto load_rows = [&](int tile, u32x2 (&rw)[20], unsigned& mask) {
        const int t0 = tile * 16; const int b = t0 / TPB, tt = t0 - b * TPB; const int seg0 = b * TPB + (tt < NCTX ? 0 : NCTX), seg1 = b * TPB + (tt < NCTX ? NCTX : TPB);
        unsigned m = 0u;
#pragma unroll
        for (int i = 0; i < 20; ++i) { const int row = t0 - 2 + i; const bool in = (row >= seg0 && row < seg1); const int rc = in ? row : t0; m |= (in ? 1u : 0u) << i;
            rw[i] = *(const u32x2*)(XM + (size_t)rc * ML_INNER + 4 * g); }
        mask = m;
    };
    u32x2 nxt[20]; unsigned nmask = 0u;
    if (F.bid < T / 16) load_rows(F.bid, nxt, nmask);
    for (int tile = F.bid; tile < T / 16; tile += F.G) {
        const int t0 = tile * 16;
        bf16x8 bw[16];
#pragma unroll
        for (int ks = 0; ks < 16; ++ks) bw[ks] = *(const bf16x8*)(WGt + (size_t)(lane & 15) * 4096 + w * 512 + 32 * ks + 8 * (lane >> 4));
        u32x2 raw[20]; const unsigned cmask = nmask;
#pragma unroll
        for (int i = 0; i < 20; ++i) raw[i] = nxt[i];
        if (tile + F.G < T / 16) load_rows(tile + F.G, nxt, nmask);
#pragma unroll
        for (int i = 0; i < 20; ++i) if (!((cmask >> i) & 1u)) { raw[i].x = 0u; raw[i].y = 0u; }
#if PREP_PROBE
        asm volatile("s_waitcnt vmcnt(0)" ::: "memory"); PREP_STAMP(0);
#endif
#pragma unroll
        for (int i = 0; i < 16; ++i) {
            f32x2 a01 = cb2[0], a23 = cb2[1];
#pragma unroll
            for (int jj = 0; jj < 5; ++jj) { const u32x2 u = raw[i + jj]; a01 += cw2[jj][0] * (f32x2){bflo(u.x), bfhi(u.x)}; a23 += cw2[jj][1] * (f32x2){bflo(u.y), bfhi(u.y)}; }
            const float x0 = bflo(raw[i + 2].x), x1 = bfhi(raw[i + 2].x), x2 = bflo(raw[i + 2].y), x3 = bfhi(raw[i + 2].y);
            const f32x2 v01 = wv2[0][0] * x0 + wv2[1][0] * x1 + wv2[2][0] * x2 + wv2[3][0] * x3, v23 = wv2[0][1] * x0 + wv2[1][1] * x1 + wv2[2][1] * x2 + wv2[3][1] * x3;
            u32x2 xcp; xcp.x = pk2(silu_f(a01[0]), silu_f(a01[1])); xcp.y = pk2(silu_f(a23[0]), silu_f(a23[1]));
            u32x2 vp; vp.x = pk2(v01[0], v01[1]); vp.y = pk2(v23[0], v23[1]);
            *(u32x2*)(XC + (size_t)(t0 + i) * ML_INNER + 4 * g) = xcp;
            *(u32x2*)(V + (size_t)(t0 + i) * ML_INNER + 4 * g) = vp;
            const int lo = i * 4096 + (((g >> 1) ^ i) << 4) + (g & 1) * 8;
            *(LAS u32x2*)(XT + lo) = xcp; *(LAS u32x2*)(XT + 65536 + lo) = raw[i + 2];
        }
        PREP_STAMP(1);
        __syncthreads();
        PREP_STAMP(2);
        {
            const int tok = lane & 15; const LAS unsigned char* abase = XT + (w >> 2) * 65536 + tok * 4096;
            f32x4 acc = {0.f, 0.f, 0.f, 0.f};
#pragma unroll
            for (int ks = 0; ks < 16; ++ks) { const int c = (w & 3) * 64 + 4 * ks + (lane >> 4); acc = mfma16(*(const LAS bf16x8*)(abase + ((c ^ tok) << 4)), bw[ks], acc); }
#pragma unroll
            for (int i = 0; i < 4; ++i) part[w * 256 + ((lane >> 4) * 4 + i) * 16 + (lane & 15)] = acc[i];
        }
        __syncthreads();
        if (tid < 256) { const int row = tid >> 4, n = tid & 15; float s = bgate;
#pragma unroll
            for (int ww = 0; ww < 8; ++ww) s += part[ww * 256 + tid];
            if ((n >> 2) & 1) s = fminf(s, 0.f) - log1pf(expf(-fabsf(s)));
            GATES[(size_t)(t0 + row) * 16 + n] = s; }
        PREP_STAMP(3);
    }
#if PREP_PROBE
    if (F.bid == 0 && F.tid == 0) { unsigned long long tot = 0; for (int k = 0; k < 4; ++k) tot += pacc[k]; ((float*)(F.ws + WS_CTL))[2048] = floorf(8.0f * (float)pacc[PREP_PROBE - 1] / (float)tot + 0.5f) / 8.0f; }
#endif
}

constexpr int SC_Q = 0, SC_K = 65536, SC_V = 131072, SC_S = 147456  , SC_VEC = 156672  ;
constexpr int SC_STR = 144;
DI int qk_off(int p, int qd) { const int grp = qd >> 2, q4 = qd & 3; const int pq = (q4 == 1) ? 2 : (q4 == 2) ? 1 : q4; const int c = grp * 2 + (pq >> 1); return p * 1024 + ((c ^ gsw(p)) << 4) + ((pq & 1) << 3); }
DI int qk_chunk(int p, int c) { return p * 1024 + ((c ^ gsw(p)) << 4); }
DI int v_off(int s, int qd) { const int c = qd >> 1; return s * 256 + ((c ^ gsw(s)) << 4) + ((qd & 1) << 3); }

#ifndef SCAN_PROBE
#define SCAN_PROBE 0
#endif
#if SCAN_PROBE
#define SCAN_STAMP(k) do { const unsigned long long t_ = __builtin_amdgcn_s_memtime(); acc_t[((k) + 6) % 7] += t_ - last_t; last_t = t_; } while (0)
#else
#define SCAN_STAMP(k) do { } while (0)
#endif
DI void phase_ml_scan(Frame& F) {
#if SCAN_PROBE
    unsigned long long acc_t[7] = {0, 0, 0, 0, 0, 0, 0}; unsigned long long last_t = __builtin_amdgcn_s_memtime();
#endif
    const bf16_t* XC = (const bf16_t*)(F.ws + R_XC); const bf16_t* V = (const bf16_t*)(F.ws + R_V); const float* GATES = (const float*)(F.ws + R_GATES);
    bf16_t* HF = (bf16_t*)(F.ws + R_XM); bf16_t* HBk = (bf16_t*)(F.ws + R_HBW);
    LAS unsigned char* L = F.lds;
    LAS float* vecA = (LAS float*)(L + SC_VEC);
    LAS float* vecM = vecA + 64;
    LAS float* vecI = vecA + 128;
    LAS float* vecW = vecA + 192;
    LAS float* vecRS = vecA + 256;
    LAS float* vecQN = vecA + 512;
    LAS float* vecN = vecA + 576;
    LAS float* vecS = vecA + 1088;
    LAS float* vecFL = vecA + 1152;
    LAS float* red = (LAS float*)(L + SC_Q);
    LAS float* nsum = (LAS float*)(L + SC_VEC + 4864);
    const int w = F.wave;
    const int etile = w & 3, dhalf = w >> 2;
    for (int unit = F.bid; unit < 256; unit += F.G) {
        const int chain = unit >> 2, es = unit & 3; const int b = chain >> 3, dir = (chain >> 2) & 1, head = chain & 3;
        bf16_t* HO = dir ? HBk : HF;
        f32x16 C[8];
#pragma unroll
        for (int t = 0; t < 8; ++t)
#pragma unroll
            for (int i = 0; i < 16; ++i) C[t][i] = 0.f;
        __syncthreads();
        vecN[F.tid] = 0.f; float nreg = 0.f;
        if (F.tid == 0) { vecS[1] = -INFINITY; }
        { const int j = F.tid >> 4, c4 = F.tid & 15; *(LAS unsigned*)(L + SC_S + j * SC_STR + 64 + 4 * c4) = 0u; if (F.tid < 32) vecRS[64 + F.tid] = 0.f; }
        u32x2 xr[16]; u32x4 vr[2]; float g_i = 0.f, g_f = 0.f;
        auto rowof = [&](int c, int p) -> int { const bool cx = c < 4; const int cc = cx ? c : c - 4; const int seglen = cx ? NCTX : SEQ; const int st = 64 * cc + p; const int segtok = dir ? (seglen - 1 - st) : st; return b * TPB + (cx ? 0 : NCTX) + segtok; };
        auto issue = [&](int c) {
            const bool cx = c < 4; const int cc = cx ? c : c - 4; const int seglen = cx ? NCTX : SEQ;
            const int R0 = b * TPB + (cx ? 0 : NCTX) + (dir ? (seglen - 1 - 64 * cc) : 64 * cc); const int sgn = dir ? -1 : 1;
            const int tid = opaque(F.tid);
            { const int l = tid & 63; const bf16_t* xp = XC + (ptrdiff_t)(R0 + sgn * (l & 15)) * ML_INNER + head * 512 + 64 * w + 4 * (l >> 4); const ptrdiff_t xstep = (ptrdiff_t)sgn * 16 * ML_INNER;
#pragma unroll
              for (int gi = 0; gi < 4; ++gi)
#pragma unroll
                for (int rb = 0; rb < 4; ++rb) xr[gi * 4 + rb] = *(const u32x2*)(xp + gi * 16 + rb * xstep); }
            const bf16_t* vp = V + (ptrdiff_t)(R0 + sgn * (tid >> 4)) * ML_INNER + head * 512 + es * 128 + 8 * (tid & 15); const ptrdiff_t vstep = (ptrdiff_t)sgn * 32 * ML_INNER;
            vr[0] = *(const u32x4*)vp; vr[1] = *(const u32x4*)(vp + vstep);
            if (w == 0) { const int row = R0 + sgn * tid; g_i = GATES[(size_t)row * 16 + dir * 8 + head]; g_f = GATES[(size_t)row * 16 + dir * 8 + 4 + head]; }
        };
        { const int l = hw_lane(); const int n = l & 15, kq = l >> 4; const bool nz = kq == (n >> 2);
          u32x4* frec = (u32x4*)(F.ws + WS_HB) + (size_t)(F.bid * 512 + w * 64 + l) * 4;
          u32x2 uq[4], uk[4];
#pragma unroll
          for (int gi = 0; gi < 4; ++gi) { const int wofs = (head * 128 + 4 * (4 * w + gi) + kq) * 16 + (n & 3);
              const float* pq = F.in[IN_MLWQ] + wofs; const float* pk = F.in[IN_MLWK] + wofs; const float qs = nz ? 0.044194173824159216f : 0.f, ks = nz ? 1.f : 0.f;
              uq[gi].x = pk2(pq[0] * qs, pq[4] * qs); uq[gi].y = pk2(pq[8] * qs, pq[12] * qs); uk[gi].x = pk2(pk[0] * ks, pk[4] * ks); uk[gi].y = pk2(pk[8] * ks, pk[12] * ks); }
          frec[0] = (u32x4){uq[0].x, uq[0].y, uq[1].x, uq[1].y}; frec[1] = (u32x4){uq[2].x, uq[2].y, uq[3].x, uq[3].y};
          frec[2] = (u32x4){uk[0].x, uk[0].y, uk[1].x, uk[1].y}; frec[3] = (u32x4){uk[2].x, uk[2].y, uk[3].x, uk[3].y};
          asm volatile("s_waitcnt vmcnt(0)" ::: "memory"); }
        issue(0);
        for (int c = 0; c < 68; ++c) {
            s16x4 aq[4], ak[4];
            { const int l = opaque(F.lane); const u32x4* frec = (const u32x4*)(F.ws + WS_HB) + (size_t)(F.bid * 512 + w * 64 + l) * 4;
              const u32x4 f0 = frec[0], f1 = frec[1], f2 = frec[2], f3 = frec[3];
              aq[0] = __builtin_bit_cast(s16x4, (u32x2){f0.x, f0.y}); aq[1] = __builtin_bit_cast(s16x4, (u32x2){f0.z, f0.w}); aq[2] = __builtin_bit_cast(s16x4, (u32x2){f1.x, f1.y}); aq[3] = __builtin_bit_cast(s16x4, (u32x2){f1.z, f1.w});
              ak[0] = __builtin_bit_cast(s16x4, (u32x2){f2.x, f2.y}); ak[1] = __builtin_bit_cast(s16x4, (u32x2){f2.z, f2.w}); ak[2] = __builtin_bit_cast(s16x4, (u32x2){f3.x, f3.y}); ak[3] = __builtin_bit_cast(s16x4, (u32x2){f3.z, f3.w}); }
            __syncthreads();
            for (int rp_ = 0; rp_ < ((SCAN_DUP & 1) ? 2 : 1); ++rp_) {
                const int tid = opaque(F.tid);
                { const int l = tid & 63; const int row = l & 15, nq = l >> 4; const int pq_ = (nq == 1) ? 2 : (nq == 2) ? 1 : nq;
                  const int base = row * 1024 + ((((8 * w) | (pq_ >> 1)) ^ gsw(row)) << 4) + ((pq_ & 1) << 3);
#pragma unroll
                  for (int gi = 0; gi < 4; ++gi)
#pragma unroll
                    for (int rb = 0; rb < 4; ++rb) {
                        const s16x4 xb = __builtin_bit_cast(s16x4, xr[gi * 4 + rb]);
                        const f32x4 dq = __builtin_amdgcn_mfma_f32_16x16x16bf16_1k(aq[gi], xb, (f32x4){0.f, 0.f, 0.f, 0.f}, 0, 0, 0);
                        const f32x4 dk = __builtin_amdgcn_mfma_f32_16x16x16bf16_1k(ak[gi], xb, (f32x4){0.f, 0.f, 0.f, 0.f}, 0, 0, 0);
                        u32x2 qq; qq.x = pk2(dq[0], dq[1]); qq.y = pk2(dq[2], dq[3]); u32x2 kk; kk.x = pk2(dk[0], dk[1]); kk.y = pk2(dk[2], dk[3]);
                        const int off = (base ^ ((2 * gi) << 4)) + rb * 16384; *(LAS u32x2*)(L + SC_Q + off) = qq; *(LAS u32x2*)(L + SC_K + off) = kk; } }
#pragma unroll
                for (int i = 0; i < 2; ++i) { const int id = tid + 512 * i; const int p = id >> 4, ch = id & 15; *(LAS u32x4*)(L + SC_V + p * 256 + ((ch ^ gsw(p)) << 4)) = vr[i]; }
            }
            if (w == 0) {
                const int lane = opaque(F.lane);
                const float ig = g_i, lf = g_f;
                float bc = lf;
#pragma unroll
                for (int o = 1; o < 64; o <<= 1) { const float t = __shfl_up(bc, o); if (lane >= o) bc += t; }
                const float a = ig - bc; float pm = a;
#pragma unroll
                for (int o = 1; o < 64; o <<= 1) { const float t = __shfl_up(pm, o); if (lane >= o) pm = fmaxf(pm, t); }
                const float mprev = vecS[1];
                const float M = fmaxf(mprev, pm);
                const float M63 = __shfl(M, 63), blast = __shfl(bc, 63);
                vecA[lane] = a; vecM[lane] = M; vecI[lane] = fast_exp(mprev - M); vecW[lane] = fast_exp(a - M63);
                vecFL[lane] = fast_exp(-(bc + M));
                if (lane == 0) { vecS[0] = fast_exp(mprev - M63); vecS[2] = blast + M63; }
            }
            __syncthreads();
            __builtin_amdgcn_sched_barrier(0);
            for (int rp_ = 0; rp_ < ((SCAN_DUP & 2) ? 2 : 1); ++rp_) {
            {
                const int tid = opaque(F.tid);
                const int j = tid >> 3, part = tid & 7; float s = 0.f;
#pragma unroll
                for (int cc = 0; cc < 8; ++cc) { const int chunk = cc * 8 + part;
                    const u32x4 u = *(const LAS u32x4*)(L + SC_Q + qk_chunk(j, chunk));
                    const int grp = chunk >> 1, hq = chunk & 1; const int d0 = grp * 16 + (hq ? 4 : 0), d1 = grp * 16 + (hq ? 12 : 8);
                    const f32x4 n0 = *(const LAS f32x4*)(vecN + d0), n1 = *(const LAS f32x4*)(vecN + d1);
                    s += bflo(u.x) * n0[0] + bfhi(u.x) * n0[1] + bflo(u.y) * n0[2] + bfhi(u.y) * n0[3];
                    s += bflo(u.z) * n1[0] + bfhi(u.z) * n1[1] + bflo(u.w) * n1[2] + bfhi(u.w) * n1[3]; }
                s += __shfl_xor(s, 1); s += __shfl_xor(s, 2); s += __shfl_xor(s, 4);
                if (part == 0) vecQN[j] = s;
            }
            __builtin_amdgcn_sched_barrier(0);
            if (w >= 4) {
                const int t2 = opaque(F.tid) - 256; const int qd = t2 >> 1, par = t2 & 1; f32x4 acc = {0.f, 0.f, 0.f, 0.f};
#pragma unroll 8
                for (int i = 0; i < 32; ++i) { const int s_ = 2 * i + par; const u32x2 kv = *(const LAS u32x2*)(L + SC_K + qk_off(s_, qd)); const float ws_ = vecW[s_];
                    acc[0] += ws_ * bflo(kv.x); acc[1] += ws_ * bfhi(kv.x); acc[2] += ws_ * bflo(kv.y); acc[3] += ws_ * bfhi(kv.y); }
#pragma unroll
                for (int i = 0; i < 4; ++i) acc[i] += __shfl_xor(acc[i], 1);
                if (par == 0) *(LAS f32x4*)(nsum + 4 * qd) = acc;
            }
            if (w < 3) {
                const int lane = opaque(F.lane); const int r32 = lane & 31, hh = lane >> 5;
                const int jb = (w == 0) ? 0 : 1, sb = (w == 2) ? 1 : 0;
                const int srow = 32 * sb + r32, jrow = 32 * jb + r32;
                f32x16 g0, g1;
#pragma unroll
                for (int i = 0; i < 16; ++i) { g0[i] = 0.f; g1[i] = 0.f; }
                const int kbase = SC_K + srow * 1024, qbase = SC_Q + jrow * 1024; const int gk = gsw(srow), gq = gsw(jrow);
                bf16x8 ca0 = *(const LAS bf16x8*)(L + kbase + (((0 + hh) ^ gk) << 4)), cb0 = *(const LAS bf16x8*)(L + qbase + (((0 + hh) ^ gq) << 4));
                bf16x8 ca1 = *(const LAS bf16x8*)(L + kbase + (((2 + hh) ^ gk) << 4)), cb1 = *(const LAS bf16x8*)(L + qbase + (((2 + hh) ^ gq) << 4));
#pragma unroll
                for (int it = 0; it < 16; ++it) {
                    bf16x8 na0 = ca0, nb0 = cb0, na1 = ca1, nb1 = cb1;
                    if (it + 1 < 16) { const int c0 = 4 * (it + 1) + hh;
                        na0 = *(const LAS bf16x8*)(L + kbase + ((c0 ^ gk) << 4)); nb0 = *(const LAS bf16x8*)(L + qbase + ((c0 ^ gq) << 4));
                        na1 = *(const LAS bf16x8*)(L + kbase + (((c0 + 2) ^ gk) << 4)); nb1 = *(const LAS bf16x8*)(L + qbase + (((c0 + 2) ^ gq) << 4)); }
                    g0 = mfma32(ca0, cb0, g0); g1 = mfma32(ca1, cb1, g1);
                    ca0 = na0; cb0 = nb0; ca1 = na1; cb1 = nb1;
                }
                const float Mj = vecM[jrow]; float rs = 0.f;
#pragma unroll
                for (int g = 0; g < 4; ++g) {
                    const int s0 = 32 * sb + 8 * g + 4 * hh; const f32x4 av = *(const LAS f32x4*)(vecA + s0); float sc[4];
#pragma unroll
                    for (int i = 0; i < 4; ++i) { const float dm = (s0 + i <= jrow) ? fast_exp(av[i] - Mj) : 0.f; sc[i] = (g0[4 * g + i] + g1[4 * g + i]) * dm; rs += sc[i]; }
                    u32x2 pkv; pkv.x = pk2(sc[0], sc[1]); pkv.y = pk2(sc[2], sc[3]);
                    *(LAS u32x2*)(L + SC_S + jrow * SC_STR + s0 * 2) = pkv;
                }
                rs = xhalf_sum(rs);
                if (hh == 0) vecRS[sb * 64 + jrow] = rs;
            }
            }
            __syncthreads();
            __builtin_amdgcn_sched_barrier(0);
            f32x16 O[2];
            for (int rp_ = 0; rp_ < ((SCAN_DUP & 4) ? 2 : 1); ++rp_) {
#pragma unroll
            for (int jb = 0; jb < 2; ++jb)
#pragma unroll
                for (int i = 0; i < 16; ++i) O[jb][i] = 0.f;
                const int lane = opaque(F.lane); const int r32 = lane & 31, hh = lane >> 5;
#pragma unroll
                for (int t = 0; t < 8; ++t) {
#pragma unroll
                    for (int s2 = 0; s2 < 2; ++s2) {
                        const bf16x8 xs = pack_step(C[t], s2);
                        const int chunk = (dhalf * 256 + 32 * t + 16 * s2) / 8 + hh;
#pragma unroll
                        for (int jb = 0; jb < 2; ++jb) { const bf16x8 qb = *(const LAS bf16x8*)(L + SC_Q + qk_chunk(32 * jb + r32, chunk)); O[jb] = mfma32(xs, qb, O[jb]); }
                    }
                    if (t & 1) __builtin_amdgcn_sched_barrier(0);
                }
#pragma unroll
                for (int jb = 0; jb < 2; ++jb) { const float it = vecI[32 * jb + r32];
#pragma unroll
                    for (int i = 0; i < 16; ++i) O[jb][i] *= it; }
                const int i16 = lane & 15, tq = i16 >> 2, tp = i16 & 3, blk = (lane >> 4) & 1;
#pragma unroll
                for (int ks = 0; ks < 2; ++ks) {
                    const int s0 = 32 * dhalf + 16 * ks + 8 * hh;
                    const int qd = (32 * etile + 16 * blk + 4 * tp) >> 2;
                    const s16x4 lo = tr_read(L + SC_V + v_off(s0 + tq, qd)), hi = tr_read(L + SC_V + v_off(s0 + 4 + tq, qd));
                    const bf16x8 af = cat4(lo, hi);
#pragma unroll
                    for (int jb = 0; jb < 2; ++jb) { const bf16x8 sb = *(const LAS bf16x8*)(L + SC_S + (32 * jb + r32) * SC_STR + (32 * dhalf + 16 * ks + 8 * hh) * 2); O[jb] = mfma32(af, sb, O[jb]); }
                }
            }
            __syncthreads();
            __builtin_amdgcn_sched_barrier(0);
            {
                const int lane = opaque(F.lane);
#pragma unroll
                for (int i = 0; i < 16; ++i) red[((etile * 2 + dhalf) * 16 + i) * 64 + lane] = dhalf ? O[0][i] : O[1][i];
            }
            __syncthreads();
            __builtin_amdgcn_sched_barrier(0);
            {
                const int lane = opaque(F.lane); const int r32 = lane & 31, hh = lane >> 5;
                const int j = 32 * dhalf + r32;
                const float den = vecI[j] * vecQN[j] + (vecRS[j] + vecRS[64 + j]);
                const float dinv = 1.0f / fmaxf(fabsf(den), vecFL[j]);
                bf16_t* op = HO + (size_t)rowof(c, j) * ML_INNER + head * 512 + es * 128 + etile * 32 + 4 * hh;
#pragma unroll
                for (int g = 0; g < 4; ++g) { float v[4];
#pragma unroll
                    for (int i = 0; i < 4; ++i) v[i] = ((dhalf ? O[1][4 * g + i] : O[0][4 * g + i]) + red[((etile * 2 + (1 - dhalf)) * 16 + 4 * g + i) * 64 + lane]) * dinv;
                    u32x2 wv; wv.x = pk2(v[0], v[1]); wv.y = pk2(v[2], v[3]); *(u32x2*)(op + 8 * g) = wv; }
            }
            __builtin_amdgcn_sched_barrier(0);
            SCAN_STAMP(0);
            if (c + 1 < 68) issue(c + 1);
            __builtin_amdgcn_sched_barrier(0);
            SCAN_STAMP(1);
            float decay_keep;
            {
                const float decay = vecS[0]; decay_keep = decay;
                const float ndep = decay;
            __builtin_amdgcn_sched_barrier(0);
                int lane = opaque_dep(F.lane, ndep);
#pragma unroll
                for (int t = 0; t < 8; ++t)
#pragma unroll
                    for (int i = 0; i < 16; ++i) C[t][i] *= decay;
                bf16x8 vf[4];
                {
                    const int hh = lane >> 5, i16 = lane & 15, tq = i16 >> 2, tp = i16 & 3, blk = (lane >> 4) & 1;
#pragma unroll
                    for (int ks = 0; ks < 4; ++ks) {
                        const int s0 = 16 * ks + 8 * hh; const int qd = (32 * etile + 16 * blk + 4 * tp) >> 2;
                        const s16x4 lo = tr_read(L + SC_V + v_off(s0 + tq, qd)), hi = tr_read(L + SC_V + v_off(s0 + 4 + tq, qd));
                        const f32x4 w0 = *(const LAS f32x4*)(vecW + s0), w1 = *(const LAS f32x4*)(vecW + s0 + 4);
                        u32x4 pkv;
                        pkv.x = pk2(bf2f((bf16_t)lo[0]) * w0[0], bf2f((bf16_t)lo[1]) * w0[1]); pkv.y = pk2(bf2f((bf16_t)lo[2]) * w0[2], bf2f((bf16_t)lo[3]) * w0[3]);
                        pkv.z = pk2(bf2f((bf16_t)hi[0]) * w1[0], bf2f((bf16_t)hi[1]) * w1[1]); pkv.w = pk2(bf2f((bf16_t)hi[2]) * w1[2], bf2f((bf16_t)hi[3]) * w1[3]);
                        vf[ks] = __builtin_bit_cast(bf16x8, pkv);
                    }
                }
                __builtin_amdgcn_sched_barrier(0);
            SCAN_STAMP(3);
#pragma unroll
                for (int t = 0; t < 8; ++t) {
                    if (t >= 3) lane = opaque_dep(lane, C[t - 3][0]);
                    const int hh = lane >> 5, i16 = lane & 15, tq = i16 >> 2, tp = i16 & 3, blk = (lane >> 4) & 1;
                    const int qd = (dhalf * 256 + 32 * t + 16 * blk + 4 * tp) >> 2;
#pragma unroll
                    for (int ks = 0; ks < 4; ++ks) {
                        const int s0 = 16 * ks + 8 * hh;
                        const s16x4 lo = tr_read(L + SC_K + qk_off(s0 + tq, qd)), hi = tr_read(L + SC_K + qk_off(s0 + 4 + tq, qd));
                        C[t] = mfma32(cat4(lo, hi), vf[ks], C[t]);
                    }
                }
            }
            SCAN_STAMP(4);
            __syncthreads();
            SCAN_STAMP(5);
            nreg = nreg * decay_keep + nsum[F.tid];
            vecN[F.tid] = nreg;
            if (F.tid == 0) vecS[1] = vecS[2];
        }
    }
#if SCAN_PROBE
    if (F.bid == 0 && F.tid == 0) { unsigned long long tot = 0; for (int k = 0; k < 7; ++k) tot += acc_t[k]; ((float*)(F.ws + WS_CTL))[2048] = floorf(16.0f * (float)acc_t[SCAN_PROBE - 1] / (float)tot + 0.5f) / 16.0f; }
#endif
}

DI void phase_ml_finish(Frame& F) {
    const bf16_t* HF = (const bf16_t*)(F.ws + R_XM); const bf16_t* HBk = (const bf16_t*)(F.ws + R_HBW); const bf16_t* Z = (const bf16_t*)(F.ws + R_Z); bf16_t* XC = (bf16_t*)(F.ws + R_XC);
    const int gw = F.bid * 8 + F.wave, NGW = F.G * 8, lane = F.lane;
    f32x4 gwc[4][2], skc[4][2];
#pragma unroll
    for (int hd = 0; hd < 4; ++hd)
#pragma unroll
        for (int q = 0; q < 2; ++q) { gwc[hd][q] = *(const f32x4*)(F.in[IN_MLGNW] + hd * 512 + 8 * lane + 4 * q); skc[hd][q] = *(const f32x4*)(F.in[IN_MLSKIP] + hd * 512 + 8 * lane + 4 * q); }
    u32x4 nx[4][4];
    auto load_row = [&](int r) {
#pragma unroll
        for (int hd = 0; hd < 4; ++hd) { const size_t off = (size_t)r * ML_INNER + hd * 512 + 8 * lane;
            nx[hd][0] = *(const u32x4*)(HF + off); nx[hd][1] = *(const u32x4*)(HBk + off); nx[hd][2] = *(const u32x4*)(Z + off); nx[hd][3] = *(const u32x4*)(XC + off); }
    };
    if (gw < T) load_row(gw);
    for (int r = gw; r < T; r += NGW) {
        u32x4 cur[4][4];
#pragma unroll
        for (int hd = 0; hd < 4; ++hd)
#pragma unroll
            for (int q = 0; q < 4; ++q) cur[hd][q] = nx[hd][q];
        if (r + NGW < T) load_row(r + NGW);
#pragma unroll
        for (int hd = 0; hd < 4; ++hd) {
            const size_t off = (size_t)r * ML_INNER + hd * 512 + 8 * lane;
            const u32x4 a = cur[hd][0], bq = cur[hd][1], zc = cur[hd][2], xq = cur[hd][3];
            float h[8];
            h[0] = bflo(a.x) + bflo(bq.x); h[1] = bfhi(a.x) + bfhi(bq.x); h[2] = bflo(a.y) + bflo(bq.y); h[3] = bfhi(a.y) + bfhi(bq.y);
            h[4] = bflo(a.z) + bflo(bq.z); h[5] = bfhi(a.z) + bfhi(bq.z); h[6] = bflo(a.w) + bflo(bq.w); h[7] = bfhi(a.w) + bfhi(bq.w);
            float s = 0.f;
#pragma unroll
            for (int i = 0; i < 8; ++i) s += h[i];
            const float mu = wave_sum(s) * (1.0f / 512.0f); float q = 0.f;
#pragma unroll
            for (int i = 0; i < 8; ++i) { h[i] -= mu; q += h[i] * h[i]; }
            const float rstd = 1.0f / sqrtf(wave_sum(q) * (1.0f / 512.0f) + EPS);
            float zf[8], xf[8];
            zf[0] = bflo(zc.x); zf[1] = bfhi(zc.x); zf[2] = bflo(zc.y); zf[3] = bfhi(zc.y); zf[4] = bflo(zc.z); zf[5] = bfhi(zc.z); zf[6] = bflo(zc.w); zf[7] = bfhi(zc.w);
            xf[0] = bflo(xq.x); xf[1] = bfhi(xq.x); xf[2] = bflo(xq.y); xf[3] = bfhi(xq.y); xf[4] = bflo(xq.z); xf[5] = bfhi(xq.z); xf[6] = bflo(xq.w); xf[7] = bfhi(xq.w);
            float o[8];
#pragma unroll
            for (int i = 0; i < 8; ++i) o[i] = (h[i] * rstd * gwc[hd][i >> 2][i & 3] + skc[hd][i >> 2][i & 3] * xf[i]) * silu_f(zf[i]);
            u32x2 wv; wv.x = pk4_fp8(o[0], o[1], o[2], o[3]); wv.y = pk4_fp8(o[4], o[5], o[6], o[7]);
            *(u32x2*)(F.ws + R_V + off) = wv;
        }
    }
}

__global__ void __launch_bounds__(512, 2) mk_fwd(Args args) {
    extern __shared__ __attribute__((aligned(16))) unsigned char lds_raw[];
    Frame F;
    F.lds = (LAS unsigned char*)lds_raw; F.ws = args.ws; F.in = args.in; F.out = args.out;
    F.wave = __builtin_amdgcn_readfirstlane((int)threadIdx.x >> 6); F.lane = hw_lane(); F.tid = F.wave * 64 + F.lane; F.G = gridDim.x; F.bid = blockIdx.x;
    volatile LAS unsigned* lctl = (volatile LAS unsigned*)(F.lds + LDS_CTL);
    if (F.tid < 64) lctl[F.tid] = 0u;
    __syncthreads();
    unsigned* ctl = (unsigned*)(F.ws + WS_CTL);
    XcdBarrier bar; bar.bar = ctl + CW_BAR; bar.x = 0; bar.st = nullptr;
    if (!MK_PER_PHASE) bar = xcd_barrier_post(ctl + CW_BAR, lctl, F.tid == 0);
    const int lo = args.ph_lo, hi = args.ph_hi;
    int ph = 0;
    if (PHASE_PROBE >= 0) lctl[10] = (unsigned)__builtin_amdgcn_s_memrealtime();
#define NREP_(p) ((((unsigned long long)(MK_DUP) >> (p)) & 1ull) ? 2 : 1)
#define PHASE_BEGIN if (lo <= ph && ph < hi && ph <= MK_LAST_PHASE && (MK_ONLY < 0 || ph == MK_ONLY)) { if (PHASE_PROBE == ph) lctl[8] = (unsigned)__builtin_amdgcn_s_memrealtime(); for (int rep_ = 0; rep_ < NREP_(ph); ++rep_) { F.lane = hw_lane(); F.tid = F.wave * 64 + F.lane;
#define PHASE_END   if (!MK_PER_PHASE && (ph + 1 < hi || rep_ + 1 < NREP_(ph))) { const int l0 = hw_lane(); xcd_barrier(bar, F.wave == 0 && l0 == 0); } } if (PHASE_PROBE == ph) lctl[9] = (unsigned)__builtin_amdgcn_s_memrealtime() - lctl[8]; } ++ph;

    bf16_t* HB = (bf16_t*)(F.ws + WS_HB);
    bf16_t* XS = (bf16_t*)(F.ws + WS_XS);
    const float* modv = (const float*)(F.ws + WS_MODV);
    LAS int* tbl = (LAS int*)(F.lds + pg8::STAGE_BYTES);

    PHASE_BEGIN phase_prologue(F); PHASE_END

#define MOE_BLOCK(layer) \
    PHASE_BEGIN phase_norm2_router(F, layer); PHASE_END \
    PHASE_BEGIN { const int ntl = moe_build_table(F, layer, tbl); \
        MoeOrder S; S.G = F.G; S.c = F.bid; S.ntiles = ntl; S.K = D / 2; S.A = (const char*)(F.ws + WS_HB8); S.Bt = (const char*)(F.ws + WS_WMOE13); S.bstride = (size_t)1024 * D; \
        S.idx = (const int*)(F.ws + WS_ROUTE + 2 * MiB); S.gather = true; S.tbl = tbl; S.xcdmap = moe_xcd_balanced(F, tbl, ntl); \
        pg8::EpiMoE1 E{F.ws + R_HMID}; pg8::gemm_phase<pg8::EpiMoE1, MoeOrder, true>(F.lds, D / 2, S, E, F.tid); } PHASE_END \
    PHASE_BEGIN { const int ntl = moe_build_table(F, layer, tbl); \
        MoeOrder S; S.G = F.G; S.c = F.bid; S.ntiles = ntl; S.K = MOE_H / 2; S.A = (const char*)(F.ws + R_HMID); S.Bt = (const char*)(F.ws + WS_WMOE2); S.bstride = (size_t)1024 * MOE_H; \
        S.idx = nullptr; S.gather = false; S.tbl = tbl; S.xcdmap = moe_xcd_balanced(F, tbl, ntl); \
        pg8::EpiMoE2 E{F.ws + R_Y}; pg8::gemm_phase<pg8::EpiMoE2, MoeOrder, true>(F.lds, MOE_H / 2, S, E, F.tid); } PHASE_END

#define GEMM_DENSE8X(SKIP, Aptr, Wptr, N_, K_, EPI_T, ...) { pg8::DenseOrder S; S.init((const bf16_t*)(Aptr), (const bf16_t*)(Wptr), T, N_, (K_) / 2, F.G, F.bid, SKIP); EPI_T E{__VA_ARGS__}; pg8::gemm_phase<EPI_T, pg8::DenseOrder, true>(F.lds, (K_) / 2, S, E, F.tid); }
#define GEMM_DENSE8(...) GEMM_DENSE8X(0, __VA_ARGS__)
#define GEMM_DENSE(Aptr, Wptr, N_, K_, EPI_T, ...) { pg8::DenseOrder S; S.init((const bf16_t*)(Aptr), (const bf16_t*)(Wptr), T, N_, K_, F.G, F.bid); EPI_T E{__VA_ARGS__}; pg8::gemm_phase<EPI_T, pg8::DenseOrder>(F.lds, K_, S, E, F.tid); }

    PHASE_BEGIN phase_modulate<0>(F, 0); PHASE_END
    PHASE_BEGIN GEMM_DENSE8(F.ws + WS_HB8, F.ws + WS_WNAQKV, 3072, D, pg8::EpiBf16, (bf16_t*)(F.ws + R_QKV), 3072, 0, 0, 4, 0.125f * 1.4426950408889634f, 1.0f / 32.0f)
        in_gemm_tail(F, (T / 256) * 12, [&](int g0, int ng, LAS float* scr) { convert_matrix(F, F.in[IN_MLUP], D, 4096, (bf16_t*)(F.ws + WS_WMLUP), g0, ng, scr); }); PHASE_END
    PHASE_BEGIN phase_na_attn(F, 0, true); PHASE_END
    PHASE_BEGIN GEMM_DENSE8(F.ws + R_AO, F.ws + WS_WNAO, D, D, pg8::EpiResid, XS, modv + (size_t)0 * 9 * 6144 + 2048, 1.0f / 32.0f) convert_moe_in_tail(F, 0, (T / 256) * (D / 256)); PHASE_END
    MOE_BLOCK(0)
    PHASE_BEGIN phase_modulate<1>(F, 1); PHASE_END
    PHASE_BEGIN GEMM_DENSE(HB, F.ws + WS_WMLUP, 4096, D, pg8::EpiBf16, (bf16_t*)(F.ws + R_XM), ML_INNER, ML_INNER, (size_t)(R_Z - R_XM) / 2, 0, 1.0f, 1.0f)
        in_gemm_tail(F, (T / 256) * 16, [&](int g0, int ng, LAS float* scr) { convert_matrix_fp8(F, F.in[IN_MLDOWN], ML_INNER, D, F.ws + WS_WMLDN, g0, ng, scr); convert_matrix_fp8(F, F.in[IN_DAQKV], D, 3072, F.ws + WS_WDAQKV, g0, ng, scr); }); PHASE_END
    PHASE_BEGIN phase_ml_prep(F); PHASE_END
    PHASE_BEGIN phase_ml_scan(F); PHASE_END
    PHASE_BEGIN phase_ml_finish(F); PHASE_END
    PHASE_BEGIN GEMM_DENSE8(F.ws + R_V, F.ws + WS_WMLDN, D, ML_INNER, pg8::EpiResid, XS, modv + (size_t)1 * 9 * 6144 + 2048, 1.0f / 32.0f) convert_moe_in_tail(F, 1, (T / 256) * (D / 256));
        in_gemm_tail(F, (T / 256) * (D / 256), [&](int g0, int ng, LAS float* scr) { convert_matrix_fp8(F, F.in[IN_DAO], D, D, F.ws + WS_WDAO, g0, ng, scr);
            convert_matrix_fp8(F, F.in[IN_NAQKV] + (size_t)D * 3072, D, 3072, F.ws + WS_WNAQKV + (size_t)3072 * D, g0, ng, scr); convert_matrix_fp8(F, F.in[IN_NAO] + (size_t)D * D, D, D, F.ws + WS_WNAO + (size_t)D * D, g0, ng, scr); }); PHASE_END
    MOE_BLOCK(1)
    PHASE_BEGIN phase_modulate<1>(F, 2); PHASE_END
    PHASE_BEGIN GEMM_DENSE8(F.ws + WS_HB8, F.ws + WS_WDAQKV, 3072, D, pg8::EpiBf16Rope, (bf16_t*)(F.ws + R_QKV), (const float*)(F.ws + WS_MISC + 768 * 1024), 1.0f / 32.0f) PHASE_END
    PHASE_BEGIN phase_da_attn(F, true); PHASE_END
    PHASE_BEGIN GEMM_DENSE8(F.ws + R_AO, F.ws + WS_WDAO, D, D, pg8::EpiResid, XS, modv + (size_t)2 * 9 * 6144 + 2048, 1.0f / 32.0f) convert_moe_in_tail(F, 2, (T / 256) * (D / 256)); PHASE_END
    MOE_BLOCK(2)
    PHASE_BEGIN phase_modulate<1>(F, 3); { LAS float* scr = (LAS float*)(F.lds + F.wave * 16384); __syncthreads(); convert_moe(F, 3, F.bid * 8 + F.wave, F.G * 8, scr); } PHASE_END
    PHASE_BEGIN GEMM_DENSE8(F.ws + WS_HB8, F.ws + WS_WNAQKV + (size_t)3072 * D, 3072, D, pg8::EpiBf16, (bf16_t*)(F.ws + R_QKV), 3072, 0, 0, 4, 0.125f * 1.4426950408889634f, 1.0f / 32.0f) PHASE_END
    PHASE_BEGIN phase_na_attn(F, 1, false); PHASE_END
    PHASE_BEGIN GEMM_DENSE8X(1, F.ws + R_AO, F.ws + WS_WNAO + (size_t)D * D, D, D, pg8::EpiResid, XS, modv + (size_t)3 * 9 * 6144 + 2048, 1.0f / 32.0f) PHASE_END
    MOE_BLOCK(3)
    if (PHASE_PROBE >= 0 && F.bid == 0) { const float fr = (float)lctl[9] / (float)((unsigned)__builtin_amdgcn_s_memrealtime() - lctl[10]); ((float*)(F.ws + WS_CTL))[2048] = 0.04f * fr; }
    if (PHASE_PROBE >= 0) __syncthreads();
    if (lo <= ph && ph < hi) { F.lane = hw_lane(); F.tid = F.wave * 64 + F.lane; phase_modulate<3>(F, 3); } ++ph;
}
constexpr int N_PHASES = 1 + 7 + 9 + 7 + 7 + 1;

extern "C" void kernel_launch(void* const* d_in, const int* in_sizes, int n_in, void* d_out, int out_size, void* d_ws, size_t ws_size, hipStream_t stream) {
    static int grid = 0;
    if (grid == 0) {
        if (n_in != 33 || ws_size < WS_END) { fprintf(stderr, "kernel_launch: unexpected n_in %d or ws_size %zu (< %zu)\n", n_in, ws_size, (size_t)WS_END); grid = -1; return; }
        int dev = 0, cus = 0;
        if (hipGetDevice(&dev) != hipSuccess || hipDeviceGetAttribute(&cus, hipDeviceAttributeMultiprocessorCount, dev) != hipSuccess) { grid = -1; return; }
        if (hipFuncSetAttribute((const void*)mk_fwd, hipFuncAttributeMaxDynamicSharedMemorySize, LDS_BYTES) != hipSuccess) { fprintf(stderr, "kernel_launch: hipFuncSetAttribute failed\n"); grid = -1; return; }
        int per_cu = 0;
        if (hipOccupancyMaxActiveBlocksPerMultiprocessor(&per_cu, (const void*)mk_fwd, 512, LDS_BYTES) != hipSuccess || per_cu < 1) fprintf(stderr, "kernel_launch: occupancy query says %d\n", per_cu);
        (void)hipGetLastError();
        grid = cus;
    }
    if (grid < 0) return;
    (void)hipMemsetAsync((char*)d_ws + WS_CTL, 0, CTL_BYTES, stream);
    Args a{};
    for (int i = 0; i < 33; ++i) a.in[i] = (const float*)d_in[i];
    a.out = (float*)d_out; a.ws = (unsigned char*)d_ws;
#if MK_PER_PHASE
    for (int p = 0; p < N_PHASES; ++p) { a.ph_lo = p; a.ph_hi = p + 1; hipLaunchKernelGGL(mk_fwd, dim3(grid), dim3(512), LDS_BYTES, stream, a); }
#else
    a.ph_lo = 0; a.ph_hi = N_PHASES;
    hipLaunchKernelGGL(mk_fwd, dim3(grid), dim3(512), LDS_BYTES, stream, a);
#endif
}
```

```cpp
#include <hip/hip_runtime.h>
#include <cstdio>
#include <cstdint>

#define DI __device__ __forceinline__
#define LAS __attribute__((address_space(3)))
typedef unsigned short bf16_t;
typedef short bf16x8 __attribute__((ext_vector_type(8)));
typedef short s16x4 __attribute__((ext_vector_type(4)));
typedef float f32x2 __attribute__((ext_vector_type(2)));
typedef float f32x4 __attribute__((ext_vector_type(4)));
typedef float f32x16 __attribute__((ext_vector_type(16)));
typedef unsigned u32x2 __attribute__((ext_vector_type(2)));
typedef unsigned u32x4 __attribute__((ext_vector_type(4)));
typedef __bf16 nbf2 __attribute__((ext_vector_type(2)));
typedef int i32x4 __attribute__((ext_vector_type(4)));
typedef int i32x8 __attribute__((ext_vector_type(8)));

#ifndef MK_PER_PHASE
#define MK_PER_PHASE 0
#endif
#ifndef MK_DUP
#define MK_DUP 0ull
#endif
#ifndef SCAN_PROBE
#define SCAN_PROBE 0
#endif
#ifndef PREP_PROBE
#define PREP_PROBE 0
#endif
#ifndef PHASE_PROBE
#define PHASE_PROBE (-1)
#endif
#ifndef SCAN_DUP
#define SCAN_DUP 0
#endif
#ifndef MK_ONLY
#define MK_ONLY (-1)
#endif
#ifndef MK_LAST_PHASE
#define MK_LAST_PHASE 1000
#endif

constexpr int D = 1024, NB = 8, SEQ = 4096, NCTX = 256, TPB = SEQ + NCTX  , T = NB * TPB  ;
constexpr int NRT = T / 256;
constexpr float EPS = 1e-6f;
constexpr int ML_INNER = 2048;
constexpr int MOE_H = 512, NEXP = 32;
constexpr int MAXTILES = 304;

constexpr size_t MiB = 1u << 20;
constexpr size_t WS_CTL = 0, CTL_BYTES = 1 * MiB;
constexpr size_t WS_MODV = 1 * MiB;
constexpr size_t WS_MISC = 2 * MiB;
constexpr size_t WS_WNAQKV = 3 * MiB;
constexpr size_t WS_WNAO = 15 * MiB;
constexpr size_t WS_WMLUP = 19 * MiB;
constexpr size_t WS_WMLDN = 27 * MiB;
constexpr size_t WS_WDAQKV = 31 * MiB;
constexpr size_t WS_WDAO = 37 * MiB;
constexpr size_t WS_WMOE13 = 39 * MiB;
constexpr size_t WS_WMOE2 = 71 * MiB;
constexpr size_t WS_HB8 = 88 * MiB;
constexpr size_t WS_XS = 135 * MiB;
constexpr size_t WS_HB = 271 * MiB;
constexpr size_t WS_ROUTE = 339 * MiB;
constexpr size_t WS_R = 346 * MiB;
constexpr size_t R_QKV = WS_R;
constexpr size_t R_AO = WS_R + 204 * MiB;
constexpr size_t R_XM = WS_R;
constexpr size_t R_Z = WS_R + 136 * MiB;
constexpr size_t R_XC = WS_R + 272 * MiB;
constexpr size_t R_V = WS_R + 408 * MiB;
constexpr size_t R_HBW = WS_R + 544 * MiB;
constexpr size_t R_GATES = WS_R + 680 * MiB;
constexpr size_t R_HMID = WS_R;
constexpr size_t R_Y = WS_R + 76 * MiB;
constexpr size_t WS_END = WS_R + 683 * MiB;
constexpr int CW_BAR = 4096;
constexpr int CW_CNT = 16384;

constexpr int LDS_BYTES = 163840;
constexpr int LDS_CTL = LDS_BYTES - 256;

DI unsigned pk2(float lo, float hi) { f32x2 v = {lo, hi}; nbf2 r = __builtin_convertvector(v, nbf2); return __builtin_bit_cast(unsigned, r); }
DI unsigned pk4_fp8(float a, float b, float c, float d) { int r = 0; r = __builtin_amdgcn_cvt_pk_fp8_f32(a, b, r, false); r = __builtin_amdgcn_cvt_pk_fp8_f32(c, d, r, true); return (unsigned)r; }
DI float bflo(unsigned u) { return __builtin_bit_cast(float, u << 16); }
DI float bfhi(unsigned u) { return __builtin_bit_cast(float, u & 0xffff0000u); }
DI float bf2f(bf16_t b) { return __builtin_bit_cast(float, ((unsigned)b) << 16); }
DI int hw_lane() { int l; asm volatile("v_mbcnt_lo_u32_b32 %0, -1, 0\n\tv_mbcnt_hi_u32_b32 %0, -1, %0" : "=v"(l)); return l; }
DI int opaque(int v) { asm volatile("" : "+v"(v)); return v; }
DI int opaque_dep(int v, float dep) { asm volatile("" : "+v"(v) : "v"(dep)); return v; }
DI void dma16(const void* g, LAS unsigned char* dst) {
    unsigned keep;
    asm volatile("s_mov_b32 %0, m0\n\ts_mov_b32 m0, %2\n\ts_nop 0\n\tglobal_load_lds_dwordx4 %1, off\n\ts_mov_b32 m0, %0" : "=&s"(keep) : "v"(g), "s"((unsigned)(__UINTPTR_TYPE__)dst) : "memory");
}
DI float xhalf_max(float x) { unsigned a = __builtin_bit_cast(unsigned, x), c = a; asm volatile("" : "+v"(c)); const auto r = __builtin_amdgcn_permlane32_swap(a, c, false, false); return fmaxf(__builtin_bit_cast(float, r[0]), __builtin_bit_cast(float, r[1])); }
DI float xhalf_sum(float x) { return x + __shfl_xor(x, 32); }
DI float xhalf_sum_pl(float x) { unsigned a = __builtin_bit_cast(unsigned, x), c = a; asm volatile("" : "+v"(c)); const auto r = __builtin_amdgcn_permlane32_swap(a, c, false, false); return __builtin_bit_cast(float, r[0]) + __builtin_bit_cast(float, r[1]); }
DI float wave_sum(float v) {
#pragma unroll
    for (int o = 1; o < 64; o <<= 1) v += __shfl_xor(v, o);
    return v;
}
DI float fast_exp2(float x) { return __builtin_amdgcn_exp2f(x); }
DI float fast_exp(float x) { return __builtin_amdgcn_exp2f(x * 1.4426950408889634f); }
DI float fast_rcp(float x) { return __builtin_amdgcn_rcpf(x); }
DI float silu_f(float x) { return x * fast_rcp(1.f + fast_exp(-x)); }
DI f32x16 mfma32(bf16x8 a, bf16x8 b, f32x16 c) { return __builtin_amdgcn_mfma_f32_32x32x16_bf16(a, b, c, 0, 0, 0); }
DI f32x4 mfma16(bf16x8 a, bf16x8 b, f32x4 c) { return __builtin_amdgcn_mfma_f32_16x16x32_bf16(a, b, c, 0, 0, 0); }
DI int crow(int reg, int h) { return (reg & 3) + 8 * (reg >> 2) + 4 * h; }
DI bf16x8 pack_step(const f32x16& x, int s) {
    u32x4 p; p.x = pk2(x[8 * s], x[8 * s + 1]); p.y = pk2(x[8 * s + 2], x[8 * s + 3]); p.z = pk2(x[8 * s + 4], x[8 * s + 5]); p.w = pk2(x[8 * s + 6], x[8 * s + 7]);
    return __builtin_bit_cast(bf16x8, p);
}
DI s16x4 tr_read(const LAS unsigned char* p) { return __builtin_amdgcn_ds_read_tr16_b64_v4i16((LAS s16x4*)p); }
DI bf16x8 cat4(s16x4 lo, s16x4 hi) { return __builtin_shufflevector(lo, hi, 0, 1, 2, 3, 4, 5, 6, 7); }

#define XB_TMO      128
#define XB_XCNT(j)  (256  + 64 * (j))
#define XB_XSUB(j)  (1280 + 64 * (j))
#define XB_XGEN(j)  (2304 + 64 * (j))
#define XB_TOP      3328
#define XB_TOPGEN   3392
#define XCD_BAR_WORDS 3456
#define XB_SPIN_CAP (1u << 22)
DI unsigned xb_ld(unsigned* p)              { return __hip_atomic_load(p, __ATOMIC_RELAXED, __HIP_MEMORY_SCOPE_AGENT); }
DI unsigned xb_add(unsigned* p, unsigned v) { return __hip_atomic_fetch_add(p, v, __ATOMIC_RELAXED, __HIP_MEMORY_SCOPE_AGENT); }
DI unsigned xb_xcc_id() { return (unsigned)__builtin_amdgcn_s_getreg((3 << 11) | 20) & 0xFu; }
#define XB_SPIN(cond, bar) do { unsigned _sp = 0; while (cond) { __builtin_amdgcn_s_sleep(1); \
    if ((++_sp & 255u) == 0u) { if (xb_ld(&(bar)[XB_TMO])) break; if (_sp > XB_SPIN_CAP) { atomicAdd(&(bar)[XB_TMO], 1u); break; } } } } while (0)
struct XcdBarrier { unsigned* bar; unsigned x; volatile LAS unsigned* st; };
DI XcdBarrier xcd_barrier_post(unsigned* bar, volatile LAS unsigned* st, bool t0) {
    XcdBarrier b; b.bar = bar; b.x = xb_xcc_id(); b.st = st;
    if (t0) (void)xb_add(&bar[XB_XCNT(b.x)], 1u);
    return b;
}
DI void xcd_barrier_complete(unsigned* bar, unsigned x, unsigned& nloc, unsigned& nx) {
    const unsigned G = gridDim.x * gridDim.y * gridDim.z;
    unsigned sum, cnt, mine, sp = 0u;
    for (;;) {
        sum = 0u; cnt = 0u; mine = 0u;
#pragma unroll
        for (unsigned j = 0; j < 16; ++j) { const unsigned c = xb_ld(&bar[XB_XCNT(j)]); sum += c; cnt += (c > 0u) ? 1u : 0u; mine = (j == x) ? c : mine; }
        if (sum == G) break;
        __builtin_amdgcn_s_sleep(1);
        if ((++sp & 255u) == 0u) { if (xb_ld(&bar[XB_TMO])) break; if (sp > XB_SPIN_CAP) { atomicAdd(&bar[XB_TMO], 1u); break; } }
    }
    nloc = mine > 0u ? mine : 1u; nx = cnt > 0u ? cnt : 1u;
}
DI void xcd_barrier(const XcdBarrier& b, bool t0) {
    asm volatile("s_waitcnt vmcnt(0)" ::: "memory");
    __syncthreads();
    if (t0) {
        unsigned* bar = b.bar;
        __builtin_amdgcn_s_waitcnt(0);
        unsigned nloc = b.st[0], nx = b.st[1];
        if (nloc == 0u) { xcd_barrier_complete(bar, b.x, nloc, nx); b.st[0] = nloc; b.st[1] = nx; }
        const unsigned old = xb_add(&bar[XB_XSUB(b.x)], 1u);
        const unsigned gen = old / nloc;
        if (old + 1u == (gen + 1u) * nloc) {
            __builtin_amdgcn_fence(__ATOMIC_RELEASE, "agent");
            asm volatile("s_waitcnt vmcnt(0)" ::: "memory");
            const unsigned og = xb_add(&bar[XB_TOP], 1u);
            const unsigned tg = og / nx;
            if (og + 1u == (tg + 1u) * nx) xb_add(&bar[XB_TOPGEN], 1u);
            else XB_SPIN(xb_ld(&bar[XB_TOPGEN]) == tg, bar);
            __builtin_amdgcn_fence(__ATOMIC_ACQUIRE, "agent");
            xb_add(&bar[XB_XGEN(b.x)], 1u);
            asm volatile("s_waitcnt vmcnt(0)" ::: "memory");
        } else {
            XB_SPIN(xb_ld(&bar[XB_XGEN(b.x)]) == gen, bar);
            __builtin_amdgcn_fence(__ATOMIC_ACQUIRE, "agent");
            asm volatile("s_waitcnt vmcnt(0)" ::: "memory");
        }
    }
    __syncthreads();
}

namespace pg8 {
constexpr int BM = 256, BK = 64, HALF = 128, HTB = HALF * BK * 2, STAGE_BYTES = 8 * HTB, NXCD = 8, WGM = 8;
DI int lds_byte(int r, int c) { const int st = (r >> 4) * 2 + (c >> 5), rr = r & 15, cc = c & 31, ob = rr * 64 + cc * 2; return st * 1024 + (ob ^ (((ob >> 9) & 1) << 5)); }
DI void stage_rc(int b, int& R, int& C) { const int st = b / 1024, sb = b % 1024, swz = sb ^ (((sb >> 9) & 1) << 5); R = (st >> 1) * 16 + swz / 64; C = (st & 1) * 32 + (swz % 64) / 2; }
DI int perm32(int rho) { const int n = rho >> 4, i = rho & 15; return 8 * (i >> 2) + 4 * n + (i & 3); }
struct Unit { int pm, pn; const char* a; const char* b; int e, r0, cnt; };

struct DenseOrder {
    int nM, nN, nwg, G, c; const char* A; const char* Bt; size_t tstep; int skipctx;
    DI void init(const bf16_t* A_, const bf16_t* Bt_, int M, int N, int K, int G_, int c_, int skipctx_ = 0) { skipctx = skipctx_; nM = skipctx ? (M / BM) / 17 * 16 : M / BM; nN = N / BM; nwg = nM * nN; G = G_; c = c_; A = (const char*)A_; Bt = (const char*)Bt_; tstep = (size_t)BM * K * 2; }
    DI bool next(int i, Unit& u) const {
        const long L = (long)i * G + c; if (L >= nwg) return false;
        int wgid = (int)L; { const int q = nwg / NXCD, r = nwg % NXCD, xcd = wgid % NXCD, off = wgid / NXCD; wgid = (xcd < r ? xcd * (q + 1) : r * (q + 1) + (xcd - r) * q) + off; }
        const int nig = WGM * nN, gid = wgid / nig, fm = gid * WGM, gsz = (nM - fm) < WGM ? (nM - fm) : WGM;
        u.pm = fm + ((wgid % nig) % gsz); if (skipctx) u.pm = (u.pm >> 4) * 17 + 1 + (u.pm & 15); u.pn = (wgid % nig) / gsz; u.a = A + (size_t)u.pm * tstep; u.b = Bt + (size_t)u.pn * tstep; u.e = 0; u.r0 = 0; u.cnt = 0; return true;
    }
    DI void aoff(const Unit&, int K, const int (&R)[2], const int (&C)[2], unsigned (&va)[2][2]) const {
#pragma unroll
        for (int h = 0; h < 2; ++h)
#pragma unroll
            for (int i = 0; i < 2; ++i) va[h][i] = (unsigned)((R[i] + HALF * h) * K + C[i]) * 2u;
    }
};

template <class Epi, class Sched, bool FP8 = false>
DI void gemm_phase(LAS unsigned char* lds, const int K, const Sched& S, const Epi& E, const int tid) {
    const int wid = __builtin_amdgcn_readfirstlane(tid >> 6), lane = tid & 63, wr = wid >> 2, wc = wid & 3, fr = lane & 15, fq = lane >> 4;
    const int nt = K / BK;
    int Rr[2], Cc[2]; unsigned vb[2][2];
#pragma unroll
    for (int i = 0; i < 2; ++i) { stage_rc(tid * 16 + i * 8192, Rr[i], Cc[i]); const int Rb = Epi::PERM ? ((Rr[i] & ~31) + perm32(Rr[i] & 31)) : Rr[i];
#pragma unroll
        for (int h = 0; h < 2; ++h) vb[h][i] = (unsigned)((Rb + HALF * h) * K + Cc[i]) * 2u; }
    const size_t kstep = (size_t)(BK * 2);
    const unsigned ldsw = (unsigned)wid * 1024u;
    const int aoff = lds_byte(wr * 64 + fr, fq * 8), boff = lds_byte(wc * 32 + fr, fq * 8);
#define PG8_SA(b, h) (((b) * 2 + (h)) * HTB)
#define PG8_SB(b, h) ((4 + (b) * 2 + (h)) * HTB)
#define PG8_STAGE(bufoff, gbase, voff) do { _Pragma("unroll") for (int _i = 0; _i < 2; ++_i) \
        __builtin_amdgcn_global_load_lds((const unsigned*)((const char*)(gbase) + (voff)[_i]), (LAS unsigned*)(lds + (bufoff) + ldsw + _i * 8192), 16, 0, 0); } while (0)
#define PG8_LDA(dst, b, h) do { _Pragma("unroll") for (int m = 0; m < 4; ++m) { const i32x4 l_ = *(const LAS i32x4*)(lds + PG8_SA(b, h) + aoff + m * 2048); const i32x4 h_ = *(const LAS i32x4*)(lds + PG8_SA(b, h) + aoff + m * 2048 + 1024); dst[m] = __builtin_shufflevector(l_, h_, 0, 1, 2, 3, 4, 5, 6, 7); } } while (0)
#define PG8_LDB(dst, b, h) do { _Pragma("unroll") for (int n = 0; n < 2; ++n) { const i32x4 l_ = *(const LAS i32x4*)(lds + PG8_SB(b, h) + boff + n * 2048); const i32x4 h_ = *(const LAS i32x4*)(lds + PG8_SB(b, h) + boff + n * 2048 + 1024); dst[n] = __builtin_shufflevector(l_, h_, 0, 1, 2, 3, 4, 5, 6, 7); } } while (0)
#define PG8_LO(v) __builtin_bit_cast(bf16x8, __builtin_shufflevector(v, v, 0, 1, 2, 3))
#define PG8_HI(v) __builtin_bit_cast(bf16x8, __builtin_shufflevector(v, v, 4, 5, 6, 7))
#define PG8_MMA(ai, bj, At, Bt) do { __builtin_amdgcn_s_setprio(1); _Pragma("unroll") for (int m = 0; m < 4; ++m) _Pragma("unroll") for (int n = 0; n < 2; ++n) { \
        if constexpr (FP8) asm volatile("v_mfma_scale_f32_16x16x128_f8f6f4 %0, %1, %2, %0, %3, %3 op_sel_hi:[0,0,0]" : "+v"(acc[ai][bj][m][n]) : "v"(Bt[n]), "v"(At[m]), "v"(fp8_unit_scale)); \
        else { acc[ai][bj][m][n] = __builtin_amdgcn_mfma_f32_16x16x32_bf16(PG8_LO(Bt[n]), PG8_LO(At[m]), acc[ai][bj][m][n], 0, 0, 0); \
               acc[ai][bj][m][n] = __builtin_amdgcn_mfma_f32_16x16x32_bf16(PG8_HI(Bt[n]), PG8_HI(At[m]), acc[ai][bj][m][n], 0, 0, 0); } } __builtin_amdgcn_s_setprio(0); } while (0)
#define PG8_WAIT_V(n) asm volatile("s_waitcnt vmcnt(" #n ")" ::: "memory")
#define PG8_WAIT_L(n) asm volatile("s_waitcnt lgkmcnt(" #n ")" ::: "memory")
#define PG8_BAR __builtin_amdgcn_s_barrier()
#define PG8_SCHED __builtin_amdgcn_sched_barrier(0)
    Unit cur, nxt; int ui = 0;
    if (!S.next(0, cur)) return;
    f32x4 acc[2][2][4][2];
#pragma unroll
    for (int a = 0; a < 2; ++a)
#pragma unroll
        for (int b = 0; b < 2; ++b)
#pragma unroll
            for (int m = 0; m < 4; ++m)
#pragma unroll
                for (int n = 0; n < 2; ++n) acc[a][b][m][n] = (f32x4){0.f, 0.f, 0.f, 0.f};
    i32x8 At[4], B0[2], B1[2];
    const int fp8_unit_scale = 0x7f7f7f7f;
    unsigned vac[2][2], van[2][2];
    S.aoff(cur, K, Rr, Cc, vac);
    const char* cA = cur.a; const char* cB = cur.b;
    PG8_STAGE(PG8_SB(0, 0), cB, vb[0]); PG8_STAGE(PG8_SB(0, 1), cB, vb[1]); PG8_STAGE(PG8_SA(0, 0), cA, vac[0]); PG8_STAGE(PG8_SA(0, 1), cA, vac[1]);
    if (wr == 1) PG8_BAR;
    PG8_WAIT_V(2); PG8_BAR;
    PG8_STAGE(PG8_SB(1, 0), cB + kstep, vb[0]); PG8_STAGE(PG8_SA(1, 0), cA + kstep, vac[0]); PG8_STAGE(PG8_SB(1, 1), cB + kstep, vb[1]);
    PG8_WAIT_V(6); PG8_BAR;
    for (;;) {
        const bool has_next = S.next(ui + 1, nxt);
        const char* nA = has_next ? nxt.a : cA; const char* nB = has_next ? nxt.b : cB;
        if (has_next) S.aoff(nxt, K, Rr, Cc, van);
        else {
#pragma unroll
            for (int h = 0; h < 2; ++h)
#pragma unroll
                for (int i = 0; i < 2; ++i) van[h][i] = vac[h][i]; }
#pragma nounroll
        for (int t = 0; t < nt; t += 2) {
            const bool last = (t == nt - 2);
            const char* a1 = cA + (size_t)(t + 1) * kstep;
            const char* a2 = last ? nA : cA + (size_t)(t + 2) * kstep; const char* b2 = last ? nB : cB + (size_t)(t + 2) * kstep;
            const char* a3 = a2 + kstep; const char* b3 = b2 + kstep;
            unsigned v2[2][2];
#pragma unroll
            for (int h = 0; h < 2; ++h)
#pragma unroll
                for (int i = 0; i < 2; ++i) v2[h][i] = last ? van[h][i] : vac[h][i];
            PG8_LDB(B0, 0, 0); PG8_LDB(B1, 0, 1); PG8_SCHED; PG8_LDA(At, 0, 0); PG8_STAGE(PG8_SA(1, 1), a1, vac[1]);
            PG8_WAIT_V(8); PG8_WAIT_L(0); PG8_BAR; PG8_MMA(0, 0, At, B0); PG8_MMA(0, 1, At, B1); PG8_BAR; PG8_SCHED;
            PG8_LDA(At, 0, 1); PG8_STAGE(PG8_SB(0, 0), b2, vb[0]); PG8_STAGE(PG8_SB(0, 1), b2, vb[1]); PG8_STAGE(PG8_SA(0, 0), a2, v2[0]);
            PG8_WAIT_V(8); PG8_WAIT_L(0); PG8_BAR; PG8_MMA(1, 0, At, B0); PG8_MMA(1, 1, At, B1); PG8_BAR; PG8_SCHED;
            PG8_LDB(B0, 1, 0); PG8_LDB(B1, 1, 1); PG8_SCHED; PG8_LDA(At, 1, 0); PG8_STAGE(PG8_SA(0, 1), a2, v2[1]);
            PG8_WAIT_V(8); PG8_WAIT_L(0); PG8_BAR; PG8_MMA(0, 0, At, B0); PG8_MMA(0, 1, At, B1); PG8_BAR; PG8_SCHED;
            PG8_LDA(At, 1, 1); PG8_STAGE(PG8_SB(1, 0), b3, vb[0]); PG8_STAGE(PG8_SB(1, 1), b3, vb[1]); PG8_STAGE(PG8_SA(1, 0), a3, v2[0]);
            PG8_WAIT_V(8); PG8_WAIT_L(0); PG8_BAR; PG8_MMA(1, 0, At, B0); PG8_MMA(1, 1, At, B1); PG8_BAR; PG8_SCHED;
        }
        if (wr == 0) PG8_BAR;
        if constexpr (FP8) asm volatile("s_nop 15\n\ts_nop 15\n\ts_nop 15" ::: "memory");
        E(acc, cur, wr, wc, fr, fq);
        if (!has_next) break;
#pragma unroll
        for (int a = 0; a < 2; ++a)
#pragma unroll
            for (int b = 0; b < 2; ++b)
#pragma unroll
                for (int m = 0; m < 4; ++m)
#pragma unroll
                    for (int n = 0; n < 2; ++n) acc[a][b][m][n] = (f32x4){0.f, 0.f, 0.f, 0.f};
        cur = nxt; cA = nA; cB = nB; ++ui;
#pragma unroll
        for (int h = 0; h < 2; ++h)
#pragma unroll
            for (int i = 0; i < 2; ++i) vac[h][i] = van[h][i];
        if (wr == 1) PG8_BAR;
    }
    PG8_WAIT_V(0);
    PG8_BAR;
#undef PG8_SA
#undef PG8_SB
#undef PG8_STAGE
#undef PG8_LDA
#undef PG8_LDB
#undef PG8_MMA
#undef PG8_WAIT_V
#undef PG8_WAIT_L
#undef PG8_BAR
#undef PG8_SCHED
}

struct EpiBf16 {
    static constexpr bool PERM = true;
    bf16_t* O; int ldc; int split_cols; size_t split_stride; int qtiles; float qs; float os;
    DI void operator()(const f32x4 (&acc)[2][2][4][2], const Unit& u, int wr, int wc, int fr, int fq) const {
        const int row0 = u.pm * BM + wr * 64 + fr; int colt = u.pn * BM; bf16_t* base = O;
        if (split_cols) { const int t = colt / split_cols; base += (size_t)t * split_stride; colt -= t * split_cols; }
        const int col0 = colt + wc * 32 + 8 * fq; const float sc = ((u.pn < qtiles) ? qs : 1.0f) * os;
#pragma unroll
        for (int ai = 0; ai < 2; ++ai)
#pragma unroll
            for (int m = 0; m < 4; ++m) { bf16_t* rowp = base + (size_t)(row0 + ai * HALF + m * 16) * ldc + col0;
#pragma unroll
                for (int bj = 0; bj < 2; ++bj) { const f32x4 v0 = acc[ai][bj][m][0] * sc, v1 = acc[ai][bj][m][1] * sc;
                    u32x4 w; w.x = pk2(v0[0], v0[1]); w.y = pk2(v0[2], v0[3]); w.z = pk2(v1[0], v1[1]); w.w = pk2(v1[2], v1[3]);
                    *(u32x4*)(rowp + bj * HALF) = w; } }
    }
};
struct EpiBf16Rope {
    static constexpr bool PERM = true;
    bf16_t* O; const float* rope; float os;
    DI void operator()(const f32x4 (&acc)[2][2][4][2], const Unit& u, int wr, int wc, int fr, int fq) const {
        const int row0 = u.pm * BM + wr * 64 + fr; const int col0 = u.pn * BM + wc * 32 + 8 * fq;
        const int jj = u.pm % 17; const bool dorope = (u.pn < 8) && (jj != 0);
        const float qs = ((u.pn < 4) ? 0.125f * 1.4426950408889634f : 1.0f) * os;
        const bool first = fq < 2; const int fbase = 8 * (fq & 1);
#pragma unroll
        for (int ai = 0; ai < 2; ++ai)
#pragma unroll
            for (int m = 0; m < 4; ++m) { bf16_t* rowp = O + (size_t)(row0 + ai * HALF + m * 16) * 3072 + col0;
                const int pos = (wc & 1) ? (16 * m + fr) : ((jj - 1) * 4 + 2 * ai + wr);
                const float* tb = rope + ((dorope ? pos : 0) * 16 + fbase) * 2;
                const f32x4 t0 = *(const f32x4*)(tb), t1 = *(const f32x4*)(tb + 4), t2 = *(const f32x4*)(tb + 8), t3 = *(const f32x4*)(tb + 12);
                const float cs[8] = {t0[0], t0[2], t1[0], t1[2], t2[0], t2[2], t3[0], t3[2]}, sn[8] = {t0[1], t0[3], t1[1], t1[3], t2[1], t2[3], t3[1], t3[3]};
#pragma unroll
                for (int bj = 0; bj < 2; ++bj) { f32x4 v0 = acc[ai][bj][m][0], v1 = acc[ai][bj][m][1];
                    if (dorope) {
                        float x[8] = {v0[0], v0[1], v0[2], v0[3], v1[0], v1[1], v1[2], v1[3]};
#pragma unroll
                        for (int e = 0; e < 8; ++e) { const float p = __shfl_xor(x[e], 32); x[e] = first ? (x[e] * cs[e] - p * sn[e]) : (x[e] * cs[e] + p * sn[e]); }
                        v0 = (f32x4){x[0], x[1], x[2], x[3]}; v1 = (f32x4){x[4], x[5], x[6], x[7]};
                    }
                    v0 = v0 * qs; v1 = v1 * qs;
                    u32x4 w; w.x = pk2(v0[0], v0[1]); w.y = pk2(v0[2], v0[3]); w.z = pk2(v1[0], v1[1]); w.w = pk2(v1[2], v1[3]);
                    *(u32x4*)(rowp + bj * HALF) = w; } }
    }
};
struct EpiMoE1 {
    static constexpr bool PERM = true;
    unsigned char* O;
    DI void operator()(const f32x4 (&acc)[2][2][4][2], const Unit& u, int wr, int wc, int fr, int fq) const {
        const int row0 = u.pm * BM + wr * 64 + fr; const int col0 = (u.pn * BM + wc * 32 + 8 * fq) >> 1;
        const float is = 1.0f / 32.0f;
#pragma unroll
        for (int ai = 0; ai < 2; ++ai)
#pragma unroll
            for (int m = 0; m < 4; ++m) { unsigned char* rowp = O + (size_t)(row0 + ai * HALF + m * 16) * MOE_H + col0;
#pragma unroll
                for (int bj = 0; bj < 2; ++bj) { const f32x4 a = acc[ai][bj][m][0] * is, b = acc[ai][bj][m][1] * (is * 8.0f);
                    *(unsigned*)(rowp + bj * (HALF / 2)) = pk4_fp8(silu_f(a[0]) * b[0], silu_f(a[1]) * b[1], silu_f(a[2]) * b[2], silu_f(a[3]) * b[3]); } }
    }
};
struct EpiMoE2 {
    static constexpr bool PERM = true;
    unsigned char* O;
    DI void operator()(const f32x4 (&acc)[2][2][4][2], const Unit& u, int wr, int wc, int fr, int fq) const {
        const int row0 = u.pm * BM + wr * 64 + fr; const int col0 = u.pn * BM + wc * 32 + 8 * fq;
        const float is = 16.0f / 256.0f;
#pragma unroll
        for (int ai = 0; ai < 2; ++ai)
#pragma unroll
            for (int m = 0; m < 4; ++m) { unsigned char* rowp = O + (size_t)(row0 + ai * HALF + m * 16) * D + col0;
#pragma unroll
                for (int bj = 0; bj < 2; ++bj) { const f32x4 v0 = acc[ai][bj][m][0] * is, v1 = acc[ai][bj][m][1] * is;
                    u32x2 w; w.x = pk4_fp8(v0[0], v0[1], v0[2], v0[3]); w.y = pk4_fp8(v1[0], v1[1], v1[2], v1[3]);
                    *(u32x2*)(rowp + bj * HALF) = w; } }
    }
};
struct EpiResid {
    static constexpr bool PERM = false;
    bf16_t* XS; const float* modv_gate; float os;
    DI void operator()(const f32x4 (&acc)[2][2][4][2], const Unit& u, int wr, int wc, int fr, int fq) const {
        const int row0 = u.pm * BM + wr * 64 + fr, col0 = u.pn * BM + wc * 32 + 4 * fq;
        const int bb = u.pm / 17, jj = u.pm - bb * 17; const int mr = (jj == 0) ? 8 : bb;
        const float* gp = modv_gate + (size_t)mr * 6144 + col0;
        f32x4 gv[2][2];
#pragma unroll
        for (int bj = 0; bj < 2; ++bj)
#pragma unroll
            for (int n = 0; n < 2; ++n) gv[bj][n] = *(const f32x4*)(gp + bj * HALF + n * 16) * os;
#pragma unroll
        for (int ai = 0; ai < 2; ++ai)
#pragma unroll
            for (int m = 0; m < 4; ++m) { bf16_t* rowp = XS + (size_t)(row0 + ai * HALF + m * 16) * D + col0;
#pragma unroll
                for (int bj = 0; bj < 2; ++bj)
#pragma unroll
                    for (int n = 0; n < 2; ++n) { u32x2* p = (u32x2*)(rowp + bj * HALF + n * 16); const u32x2 o = *p; const f32x4 a = acc[ai][bj][m][n], g = gv[bj][n];
                        u32x2 w; w.x = pk2(bflo(o.x) + g[0] * a[0], bfhi(o.x) + g[1] * a[1]); w.y = pk2(bflo(o.y) + g[2] * a[2], bfhi(o.y) + g[3] * a[3]); *p = w; } }
    }
};
}

struct Args { const float* in[33]; float* out; unsigned char* ws; int ph_lo, ph_hi; };
struct Frame {
    LAS unsigned char* lds;
    unsigned char* ws;
    const float* const* in;
    float* out;
    int tid, lane, wave, G, bid;
};
#define IN_X 0
#define IN_C 1
#define IN_CTX 2
#define IN_CCTX 3
#define IN_MODW 4
#define IN_MODB 5
#define IN_NORMG 6
#define IN_FINALG 7
#define IN_NAQKV 8
#define IN_NAO 9
#define IN_NARPB 10
#define IN_MLUP 11
#define IN_MLCONVW 12
#define IN_MLCONVB 13
#define IN_MLWQ 14
#define IN_MLWK 15
#define IN_MLWV 16
#define IN_MLWGATE 17
#define IN_MLBGATE 18
#define IN_MLGNW 19
#define IN_MLSKIP 20
#define IN_MLDOWN 21
#define IN_DAQKV 22
#define IN_DALAM 23
#define IN_DASUBLN 24
#define IN_DAO 25
#define IN_MOEWG 26
#define IN_MOEBG 27
#define IN_MOEWR 28
#define IN_MOEBR 29
#define IN_MOEW1 30
#define IN_MOEW3 31
#define IN_MOEW2 32

DI void transpose_item(const float* W, int ldw, int K, bf16_t* WT, int k0, int n0src, int n0dst, LAS float* scr, int lane) {
#pragma unroll
    for (int i = 0; i < 32; ++i) { const int kk = 2 * i + (lane >> 5); scr[kk * 33 + (lane & 31)] = W[(size_t)(k0 + kk) * ldw + n0src + (lane & 31)]; }
    asm volatile("s_waitcnt lgkmcnt(0)" ::: "memory");
    const int c = lane & 7;
#pragma unroll
    for (int j = 0; j < 4; ++j) { const int n = (lane >> 3) + 8 * j; const LAS float* s = scr + (8 * c) * 33 + n;
        u32x4 o; o.x = pk2(s[0 * 33], s[1 * 33]); o.y = pk2(s[2 * 33], s[3 * 33]); o.z = pk2(s[4 * 33], s[5 * 33]); o.w = pk2(s[6 * 33], s[7 * 33]);
        *(u32x4*)(WT + (size_t)(n0dst + n) * K + k0 + 8 * c) = o; }
    asm volatile("s_waitcnt lgkmcnt(0)" ::: "memory");
}
DI void convert_matrix(Frame& F, const float* W, int K, int N, bf16_t* WT, int gw0, int ngw, LAS float* scr) {
    const int nblk = N / 32, nitems = (K / 64) * nblk;
    for (int it = gw0; it < nitems; it += ngw) { const int kb = it / nblk, nb = it - kb * nblk; transpose_item(W, N, K, WT, kb * 64, nb * 32, nb * 32, scr, F.lane); }
}
template <class RowMap>
DI void transpose_item_fp8(const float* W, int ldw, int K, unsigned char* WT, int k0, int n0src, const RowMap& drow, LAS float* scr, int lane) {
#pragma unroll
    for (int i = 0; i < 32; ++i) { const int kk = 2 * i + (lane >> 5); scr[kk * 33 + (lane & 31)] = W[(size_t)(k0 + kk) * ldw + n0src + (lane & 31)] * 32.0f; }
    asm volatile("s_waitcnt lgkmcnt(0)" ::: "memory");
    const int n = lane >> 1, hf = lane & 1; const LAS float* sp = scr + (32 * hf) * 33 + n;
    u32x4 o0, o1;
    o0.x = pk4_fp8(sp[0 * 33], sp[1 * 33], sp[2 * 33], sp[3 * 33]); o0.y = pk4_fp8(sp[4 * 33], sp[5 * 33], sp[6 * 33], sp[7 * 33]);
    o0.z = pk4_fp8(sp[8 * 33], sp[9 * 33], sp[10 * 33], sp[11 * 33]); o0.w = pk4_fp8(sp[12 * 33], sp[13 * 33], sp[14 * 33], sp[15 * 33]);
    o1.x = pk4_fp8(sp[16 * 33], sp[17 * 33], sp[18 * 33], sp[19 * 33]); o1.y = pk4_fp8(sp[20 * 33], sp[21 * 33], sp[22 * 33], sp[23 * 33]);
    o1.z = pk4_fp8(sp[24 * 33], sp[25 * 33], sp[26 * 33], sp[27 * 33]); o1.w = pk4_fp8(sp[28 * 33], sp[29 * 33], sp[30 * 33], sp[31 * 33]);
    unsigned char* dp = WT + (size_t)drow(n0src + n) * K + k0 + 32 * hf;
    *(u32x4*)dp = o0; *(u32x4*)(dp + 16) = o1;
    asm volatile("s_waitcnt lgkmcnt(0)" ::: "memory");
}
DI void convert_matrix_fp8(Frame& F, const float* W, int K, int N, unsigned char* WT, int gw0, int ngw, LAS float* scr) {
    const int nblk = N / 32, nitems = (K / 64) * nblk;
    auto rm = [&](int col) -> int { return col; };
    for (int it = gw0; it < nitems; it += ngw) { const int kb = it / nblk, nb = it - kb * nblk; transpose_item_fp8(W, N, K, WT, kb * 64, nb * 32, rm, scr, F.lane); }
}
DI void convert_moe(Frame& F, int layer, int gw0, int ngw, LAS float* scr) {
    const float* w1 = F.in[IN_MOEW1] + (size_t)layer * NEXP * D * MOE_H;
    const float* w3 = F.in[IN_MOEW3] + (size_t)layer * NEXP * D * MOE_H;
    const float* w2 = F.in[IN_MOEW2] + (size_t)layer * NEXP * MOE_H * D;
    unsigned char* W13T = F.ws + WS_WMOE13; unsigned char* W2T = F.ws + WS_WMOE2;
    const int per_mat = 16 * 16, per_e13 = 2 * per_mat, per_e2 = 8 * 32, per_e = per_e13 + per_e2, nitems = NEXP * per_e;
    const int lane = F.lane;
    for (int it = gw0; it < nitems; it += ngw) {
        const int e = it / per_e; int r = it - e * per_e;
        if (r < per_e13) {
            const int which = r / per_mat; r -= which * per_mat; const int kb = r >> 4, nb = r & 15;
            const float* W = (which ? w3 : w1) + (size_t)e * D * MOE_H;
            auto rm = [&](int col) -> int { return 8 * (col >> 2) + (col & 3) + 4 * which; };
            transpose_item_fp8(W, MOE_H, D, W13T + (size_t)e * 1024 * D, kb * 64, nb * 32, rm, scr, lane);
        } else {
            r -= per_e13; const int kb = r >> 5, nb = r & 31;
            auto rm = [&](int col) -> int { return col; };
            transpose_item_fp8(w2 + (size_t)e * MOE_H * D, D, MOE_H, W2T + (size_t)e * D * MOE_H, kb * 64, nb * 32, rm, scr, lane);
        }
    }
}

DI void convert_moe_in_tail(Frame& F, int layer, int nwg) {
    const int rem = nwg % F.G;
    if (F.bid < rem) return;
    __syncthreads();
    LAS float* scr = (LAS float*)(F.lds + F.wave * 16384);
    convert_moe(F, layer, (F.bid - rem) * 8 + F.wave, (F.G - rem) * 8, scr);
}

template <class Fn>
DI void in_gemm_tail(Frame& F, int nwg, Fn fn) {
    const int rem = nwg % F.G;
    if (F.bid < rem) return;
    __syncthreads();
    fn((F.bid - rem) * 8 + F.wave, (F.G - rem) * 8, (LAS float*)(F.lds + F.wave * 16384));
}

DI void phase_prologue(Frame& F) {
#ifdef TLB_TOUCH
    {
        const int gt = F.bid * 512 + F.tid, NTT = F.G * 512; unsigned acc = 0u;
        const int idxs[9] = {IN_X, IN_MODW, IN_NAQKV, IN_MLUP, IN_MLDOWN, IN_DAQKV, IN_MOEW1, IN_MOEW3, IN_MOEW2};
        const size_t lens[9] = {(size_t)NB * SEQ * D, (size_t)4 * D * 6144, (size_t)2 * D * 3072, (size_t)D * 4096, (size_t)ML_INNER * D, (size_t)D * 3072, (size_t)4 * NEXP * D * MOE_H, (size_t)4 * NEXP * D * MOE_H, (size_t)4 * NEXP * MOE_H * D};
#pragma unroll
        for (int a = 0; a < 9; ++a) { const unsigned* p = (const unsigned*)F.in[idxs[a]]; const size_t npages = lens[a] / 1024;
            for (size_t pg = gt; pg < npages; pg += NTT) acc ^= __builtin_nontemporal_load(p + pg * 1024); }
        if (acc == 0x12345678u) ((unsigned*)(F.ws + WS_CTL))[3000] = acc;
    }
#endif
    LAS float* scr = (LAS float*)(F.lds + F.wave * 16384);
    const int gw = F.bid * 8 + F.wave, NGW = F.G * 8;
    convert_matrix_fp8(F, F.in[IN_NAQKV], D, 3072, F.ws + WS_WNAQKV, gw, NGW, scr);
    convert_matrix_fp8(F, F.in[IN_NAO], D, D, F.ws + WS_WNAO, gw, NGW, scr);
    {
        bf16_t* WrT = (bf16_t*)(F.ws + WS_MISC);
        const int gt = F.bid * 512 + F.tid, NT = F.G * 512;
        for (int i = gt; i < 4 * 48 * 1024; i += NT) {
            const int l = i / (48 * 1024), r = i - l * 48 * 1024, n = r >> 10, k = r & 1023; float v = 0.f;
            if (n < 4) v = F.in[IN_MOEWG][((size_t)l * D + k) * 4 + n]; else if (n < 36) v = F.in[IN_MOEWR][((size_t)l * D + k) * 32 + (n - 4)];
            WrT[i] = (bf16_t)(pk2(v, 0.f) & 0xffffu);
        }
        bf16_t* WGt = (bf16_t*)(F.ws + WS_MISC + 512 * 1024);
        const float* wq = F.in[IN_MLWQ]; const float* wk = F.in[IN_MLWK]; const float* wv = F.in[IN_MLWV]; const float* wg = F.in[IN_MLWGATE];
        for (int i = gt; i < 16 * 4096; i += NT) {
            const int n = i >> 12, k = i & 4095; float v = 0.f;
            if (k < 2048) { const int g = k >> 2, ii = k & 3;
                for (int o = 0; o < 4; ++o) v += wq[g * 16 + ii * 4 + o] * wg[(size_t)(4 * g + o) * 16 + n] + wk[g * 16 + ii * 4 + o] * wg[(size_t)(2048 + 4 * g + o) * 16 + n];
            } else { const int kk = k - 2048, g = kk >> 2, ii = kk & 3;
                for (int o = 0; o < 4; ++o) v += wv[g * 16 + ii * 4 + o] * wg[(size_t)(4096 + 4 * g + o) * 16 + n]; }
            WGt[i] = (bf16_t)(pk2(v, 0.f) & 0xffffu);
        }
        float* rope = (float*)(F.ws + WS_MISC + 768 * 1024);
        for (int i = gt; i < 64 * 16; i += NT) { const int pos = i >> 4, f = i & 15; const float fr = powf(10000.0f, -(float)(2 * f) / 32.0f); const float ang = (float)pos * fr;
            rope[2 * i] = cosf(ang); rope[2 * i + 1] = sinf(ang); }
    }
    {
        __syncthreads();
        LAS float* sc = (LAS float*)F.lds;
        LAS float* red = (LAS float*)(F.lds + 40960);
        for (int i = F.tid; i < 9 * 1024; i += 512) { const int r = i >> 10, k = i & 1023; const float v = (r < 8) ? F.in[IN_C][r * 1024 + k] : F.in[IN_CCTX][k]; sc[i] = silu_f(v); }
        __syncthreads();
        float* modv = (float*)(F.ws + WS_MODV);
        const int c4 = (F.tid & 31) * 4, ks = F.tid >> 5;
        for (int it = F.bid; it < 4 * 48; it += F.G) {
            const int l = it / 48, n0 = (it - l * 48) * 128;
            const float* W = F.in[IN_MODW] + (size_t)l * D * 6144 + n0 + c4;
            f32x4 a[9];
#pragma unroll
            for (int r = 0; r < 9; ++r) a[r] = f32x4{0.f, 0.f, 0.f, 0.f};
#pragma unroll 8
            for (int j = 0; j < 64; ++j) { const int k = j * 16 + ks; const f32x4 w = *(const f32x4*)(W + (size_t)k * 6144);
#pragma unroll
                for (int r = 0; r < 9; ++r) { const float sv = sc[r * 1024 + k]; a[r] += w * sv; } }
#pragma unroll
            for (int r = 0; r < 9; ++r) *(LAS f32x4*)(red + (ks * 9 + r) * 128 + c4) = a[r];
            __syncthreads();
            for (int i = F.tid; i < 9 * 128; i += 512) { const int r = i >> 7, c2 = i & 127; float sum = F.in[IN_MODB][l * 6144 + n0 + c2];
#pragma unroll
                for (int g = 0; g < 16; ++g) sum += red[(g * 9 + r) * 128 + c2];
                modv[((size_t)l * 9 + r) * 6144 + n0 + c2] = sum; }
            __syncthreads();
        }
    }
}

struct RouteRec { int e0, e1, r0, r1; float w0, w1; int p0, p1; };
#if SCAN_PROBE || PREP_PROBE || (PHASE_PROBE >= 0)
#define PROBE_SCALE (1.0f + sqrtf(((const float*)(F.ws + WS_CTL))[2048]))
#else
#define PROBE_SCALE 1.0f
#endif
template <int MODE>
DI void phase_modulate(Frame& F, int layer) {
    const int gw = F.bid * 8 + F.wave, NGW = F.G * 8, lane = F.lane;
    const int RPW = (T + NGW - 1) / NGW;
    const int r_begin = gw * RPW, r_end = (r_begin + RPW < T) ? r_begin + RPW : T;
    bf16_t* XS = (bf16_t*)(F.ws + WS_XS); bf16_t* HB = (bf16_t*)(F.ws + WS_HB);
    const float* modv = (const float*)(F.ws + WS_MODV);
    const RouteRec* route = (const RouteRec*)(F.ws + WS_ROUTE);
    const unsigned char* Y = F.ws + R_Y;
    const int sh_off = (MODE == 2) ? 3072 : 0, sc_off = sh_off + 1024;
    const float* ng = F.in[IN_NORMG] + (size_t)layer * 2 * D + ((MODE == 2) ? D : 0);
    constexpr bool COMB = (MODE == 1 || MODE == 3);
    constexpr int NR = COMB ? 4 : 8;
    int tb = 0;
    if (COMB) {
        const int pl = (MODE == 3) ? 3 : layer - 1;
        unsigned* cntp = (unsigned*)(F.ws + WS_CTL) + CW_CNT + pl * 32 * 64;
        int c = (lane < 32) ? (int)__hip_atomic_load(cntp + lane * 64, __ATOMIC_RELAXED, __HIP_MEMORY_SCOPE_AGENT) : 0;
        int ntl = (c + 255) >> 8, incl = ntl;
#pragma unroll
        for (int o = 1; o < 32; o <<= 1) { const int t = __shfl_up(incl, o); if ((lane & 31) >= o) incl += t; }
        tb = incl - ntl;
    }
    const float* gnp = (MODE == 3) ? F.in[IN_FINALG] : ng;
    f32x4 gnc[4], shc[4], scc[4]; int mr_c = -1;
#pragma unroll
    for (int j = 0; j < 4; ++j) { gnc[j] = *(const f32x4*)(gnp + 4 * lane + 256 * j); shc[j] = (f32x4){0.f, 0.f, 0.f, 0.f}; scc[j] = shc[j]; }
    for (int rb = r_begin; rb < r_end; rb += NR) {
        f32x4 v[NR][4]; int rr[NR]; bool ok[NR];
#pragma unroll
        for (int k = 0; k < NR; ++k) { ok[k] = rb + k < r_end; rr[k] = ok[k] ? rb + k : r_end - 1; if (MODE == 3 && rr[k] % TPB < NCTX) { ok[k] = false; rr[k] = (rr[k] / TPB) * TPB + NCTX; } }
#pragma unroll
        for (int k = 0; k < NR; ++k) {
            const int r = rr[k]; const int b = r / TPB, t = r - b * TPB; const bool isctx = t < NCTX;
            if (MODE == 0) { const float* src = isctx ? F.in[IN_CTX] + ((size_t)b * NCTX + t) * D : F.in[IN_X] + ((size_t)b * SEQ + (t - NCTX)) * D;
#pragma unroll
                for (int j = 0; j < 4; ++j) v[k][j] = *(const f32x4*)(src + 4 * lane + 256 * j);
            } else {
#pragma unroll
                for (int j = 0; j < 4; ++j) { const u32x2 u = *(const u32x2*)(XS + (size_t)r * D + 4 * lane + 256 * j); v[k][j] = (f32x4){bflo(u.x), bfhi(u.x), bflo(u.y), bfhi(u.y)}; }
            }
        }
        if (COMB) {
            const int pl = (MODE == 3) ? 3 : layer - 1;
            unsigned y0[NR][4], y1[NR][4]; float w0[NR], w1[NR];
#pragma unroll
            for (int k = 0; k < NR; ++k) {
                const RouteRec rec = route[rr[k]];
                const int s0 = __shfl(tb, rec.e0) * 256 + rec.r0, s1 = __shfl(tb, rec.e1) * 256 + rec.r1; w0[k] = rec.w0 * (1.0f / 16.0f); w1[k] = rec.w1 * (1.0f / 16.0f);
#pragma unroll
                for (int j = 0; j < 4; ++j) { y0[k][j] = *(const unsigned*)(Y + (size_t)s0 * D + 4 * lane + 256 * j); y1[k][j] = *(const unsigned*)(Y + (size_t)s1 * D + 4 * lane + 256 * j); }
            }
#pragma unroll
            for (int k = 0; k < NR; ++k) {
                const int r = rr[k]; const int b = r / TPB, t = r - b * TPB; const int mr = (t < NCTX) ? 8 : b;
                const float* g2 = modv + ((size_t)pl * 9 + mr) * 6144 + 5120;
#pragma unroll
                for (int j = 0; j < 4; ++j) {
                    const f32x4 gg = *(const f32x4*)(g2 + 4 * lane + 256 * j);
                    const f32x2 a01 = __builtin_amdgcn_cvt_pk_f32_fp8((int)y0[k][j], false), a23 = __builtin_amdgcn_cvt_pk_f32_fp8((int)y0[k][j], true);
                    const f32x2 b01 = __builtin_amdgcn_cvt_pk_f32_fp8((int)y1[k][j], false), b23 = __builtin_amdgcn_cvt_pk_f32_fp8((int)y1[k][j], true);
                    f32x4 yy; yy[0] = w0[k] * a01[0] + w1[k] * b01[0]; yy[1] = w0[k] * a01[1] + w1[k] * b01[1]; yy[2] = w0[k] * a23[0] + w1[k] * b23[0]; yy[3] = w0[k] * a23[1] + w1[k] * b23[1];
                    v[k][j] = v[k][j] + gg * yy;
                }
            }
        }
#pragma unroll
        for (int k = 0; k < NR; ++k) {
            if (!ok[k]) continue;
            const int r = rr[k]; const int b = r / TPB, t = r - b * TPB; const bool isctx = t < NCTX; const int mr = isctx ? 8 : b;
            if (MODE == 0 || MODE == 1) {
#pragma unroll
                for (int j = 0; j < 4; ++j) { u32x2 w; w.x = pk2(v[k][j][0], v[k][j][1]); w.y = pk2(v[k][j][2], v[k][j][3]); *(u32x2*)(XS + (size_t)r * D + 4 * lane + 256 * j) = w; }
            }
            float ss = 0.f;
#pragma unroll
            for (int j = 0; j < 4; ++j) ss += (v[k][j][0] * v[k][j][0] + v[k][j][1] * v[k][j][1]) + (v[k][j][2] * v[k][j][2] + v[k][j][3] * v[k][j][3]);
            const float rstd = 1.0f / sqrtf(wave_sum(ss) * (1.0f / D) + EPS);
            if (MODE == 3) {
                if (!isctx) { float* o = F.out + ((size_t)b * SEQ + (t - NCTX)) * D;
#pragma unroll
                    for (int j = 0; j < 4; ++j) *(f32x4*)(o + 4 * lane + 256 * j) = v[k][j] * rstd * gnc[j] * PROBE_SCALE; }
            } else {
                if (__builtin_amdgcn_readfirstlane(mr) != mr_c) { mr_c = __builtin_amdgcn_readfirstlane(mr); const float* mv = modv + ((size_t)layer * 9 + mr_c) * 6144;
#pragma unroll
                    for (int j = 0; j < 4; ++j) { shc[j] = *(const f32x4*)(mv + sh_off + 4 * lane + 256 * j); scc[j] = *(const f32x4*)(mv + sc_off + 4 * lane + 256 * j) + 1.0f; } }
#pragma unroll
                for (int j = 0; j < 4; ++j) {
                    const f32x4 o = v[k][j] * rstd * gnc[j] * scc[j] + shc[j];
                    if (MODE == 2 || (MODE == 1 && layer == 1)) { u32x2 w; w.x = pk2(o[0], o[1]); w.y = pk2(o[2], o[3]); *(u32x2*)(HB + (size_t)r * D + 4 * lane + 256 * j) = w; }
                    if (!(MODE == 1 && layer == 1)) *(unsigned*)(F.ws + WS_HB8 + (size_t)r * D + 4 * lane + 256 * j) = pk4_fp8(o[0], o[1], o[2], o[3]);
                }
            }
        }
    }
    if (MODE == 2) {
        asm volatile("s_waitcnt vmcnt(0)" ::: "memory");
        const bf16_t* WrT = (const bf16_t*)(F.ws + WS_MISC) + (size_t)layer * 48 * 1024;
        LAS float* lg = (LAS float*)(F.lds + F.wave * 3072);
        unsigned* cntp = (unsigned*)(F.ws + WS_CTL) + CW_CNT + layer * 32 * 64;
        RouteRec* routew = (RouteRec*)(F.ws + WS_ROUTE);
        int* idx = (int*)(F.ws + WS_ROUTE + 2 * MiB);
        const float* bg = F.in[IN_MOEBG] + layer * 4; const float* br = F.in[IN_MOEBR] + layer * 32;
        for (int t0 = r_begin; t0 < r_end; t0 += 16) {
            int ar = t0 + (lane & 15); if (ar >= r_end) ar = r_end - 1;
            const bf16_t* ap = HB + (size_t)ar * D + 8 * (lane >> 4);
            const bf16_t* bp = WrT + (size_t)(lane & 15) * D + 8 * (lane >> 4);
            f32x4 a0 = {0.f, 0.f, 0.f, 0.f}, a1 = a0, a2 = a0;
#pragma unroll 8
            for (int ks = 0; ks < 32; ++ks) {
                const bf16x8 af = *(const bf16x8*)(ap + 32 * ks);
                a0 = mfma16(af, *(const bf16x8*)(bp + 32 * ks), a0);
                a1 = mfma16(af, *(const bf16x8*)(bp + 16 * D + 32 * ks), a1);
                a2 = mfma16(af, *(const bf16x8*)(bp + 32 * D + 32 * ks), a2);
            }
#pragma unroll
            for (int i = 0; i < 4; ++i) { const int row = (lane >> 4) * 4 + i; lg[row * 48 + (lane & 15)] = a0[i]; lg[row * 48 + 16 + (lane & 15)] = a1[i]; lg[row * 48 + 32 + (lane & 15)] = a2[i]; }
            asm volatile("s_waitcnt lgkmcnt(0)" ::: "memory");
            const int row = t0 + lane;
            if (lane < 16 && row < r_end) {
                const LAS float* L = lg + lane * 48;
                float gl[4]; int gi = 0; float gm = -3.0e38f;
#pragma unroll
                for (int k = 0; k < 4; ++k) { gl[k] = L[k] + bg[k]; if (gl[k] > gm) { gm = gl[k]; gi = k; } }
                float gs = 0.f;
#pragma unroll
                for (int k = 0; k < 4; ++k) gs += fast_exp(gl[k] - gm);
                const float gval = 1.0f / gs;
                float el[8]; float em = -3.0e38f; int i0 = 0;
#pragma unroll
                for (int k = 0; k < 8; ++k) { el[k] = L[4 + 8 * gi + k] + br[8 * gi + k]; if (el[k] > em) { em = el[k]; i0 = k; } }
                float em2 = -3.0e38f; int i1 = 0;
#pragma unroll
                for (int k = 0; k < 8; ++k) if (k != i0 && el[k] > em2) { em2 = el[k]; i1 = k; }
                const float p0 = 1.0f, p1 = fast_exp(em2 - em);
                const float inv = 1.0f / (p0 + p1);
                RouteRec rec; rec.e0 = gi * 8 + i0; rec.e1 = gi * 8 + i1; rec.w0 = gval * p0 * inv; rec.w1 = gval * p1 * inv;
                rec.r0 = (int)__hip_atomic_fetch_add(cntp + rec.e0 * 64, 1u, __ATOMIC_RELAXED, __HIP_MEMORY_SCOPE_AGENT);
                rec.r1 = (int)__hip_atomic_fetch_add(cntp + rec.e1 * 64, 1u, __ATOMIC_RELAXED, __HIP_MEMORY_SCOPE_AGENT);
                rec.p0 = 0; rec.p1 = 0;
                routew[row] = rec;
                idx[(size_t)rec.e0 * T + rec.r0] = row; idx[(size_t)rec.e1 * T + rec.r1] = row;
            }
            asm volatile("s_waitcnt lgkmcnt(0)" ::: "memory");
        }
    }
}

DI void phase_norm2_router(Frame& F, int layer) {
    const int lane = F.lane, w = F.wave, tid = F.tid;
    const int RPB = (T + F.G - 1) / F.G;
    const int row_beg = F.bid * RPB, row_end = (row_beg + RPB < T) ? row_beg + RPB : T;
    const bf16_t* XS = (const bf16_t*)(F.ws + WS_XS);
    const float* modv = (const float*)(F.ws + WS_MODV);
    const float* ng = F.in[IN_NORMG] + (size_t)layer * 2 * D + D;
    LAS unsigned char* XT = F.lds;
    LAS float* part = (LAS float*)(F.lds + 32768);
    LAS float* lg = (LAS float*)(F.lds + 32768 + 24576);
    LAS u32x4* lrec = (LAS u32x4*)(F.lds + 61440);
    LAS unsigned* lcnt = (LAS unsigned*)(F.lds + 61440 + 32768);
    const bf16_t* WrT = (const bf16_t*)(F.ws + WS_MISC) + (size_t)layer * 48 * 1024;
    unsigned* cntp = (unsigned*)(F.ws + WS_CTL) + CW_CNT + layer * 32 * 64;
    RouteRec* routew = (RouteRec*)(F.ws + WS_ROUTE);
    int* idx = (int*)(F.ws + WS_ROUTE + 2 * MiB);
    const float* bg = F.in[IN_MOEBG] + layer * 4; const float* br = F.in[IN_MOEBR] + layer * 32;
    bf16x8 bwr[3][4];
#pragma unroll
    for (int nt = 0; nt < 3; ++nt)
#pragma unroll
        for (int ks = 0; ks < 4; ++ks) bwr[nt][ks] = *(const bf16x8*)(WrT + (size_t)(16 * nt + (lane & 15)) * D + 128 * w + 32 * ks + 8 * (lane >> 4));
    f32x4 gn[4];
#pragma unroll
    for (int j = 0; j < 4; ++j) gn[j] = *(const f32x4*)(ng + 4 * lane + 256 * j);
    f32x4 shc[4], scc[4]; int mr_c = -1;
#pragma unroll
    for (int j = 0; j < 4; ++j) { shc[j] = (f32x4){0.f, 0.f, 0.f, 0.f}; scc[j] = shc[j]; }
    u32x2 nx[2][4];
    auto load_rows = [&](int r0) {
#pragma unroll
        for (int k = 0; k < 2; ++k) { const int r = min(r0 + 2 * w + k, row_end - 1);
#pragma unroll
            for (int j = 0; j < 4; ++j) nx[k][j] = *(const u32x2*)(XS + (size_t)r * D + 4 * lane + 256 * j); }
    };
    load_rows(row_beg);
    if (tid < 64) lcnt[tid] = 0u;
    for (int r0 = row_beg; r0 < row_end; r0 += 16) {
        u32x2 cur[2][4];
#pragma unroll
        for (int k = 0; k < 2; ++k)
#pragma unroll
            for (int j = 0; j < 4; ++j) cur[k][j] = nx[k][j];
        if (r0 + 16 < row_end) load_rows(r0 + 16);
#pragma unroll
        for (int k = 0; k < 2; ++k) {
            const int rl = 2 * w + k, r = r0 + rl; const bool ok = r < row_end; const int rc = ok ? r : row_end - 1;
            const int b = rc / TPB, t = rc - b * TPB; const int mr = (t < NCTX) ? 8 : b;
            f32x4 v[4]; float ss = 0.f;
#pragma unroll
            for (int j = 0; j < 4; ++j) { v[j] = (f32x4){bflo(cur[k][j].x), bfhi(cur[k][j].x), bflo(cur[k][j].y), bfhi(cur[k][j].y)}; ss += (v[j][0] * v[j][0] + v[j][1] * v[j][1]) + (v[j][2] * v[j][2] + v[j][3] * v[j][3]); }
            const float rstd = 1.0f / sqrtf(wave_sum(ss) * (1.0f / D) + EPS);
            if (__builtin_amdgcn_readfirstlane(mr) != mr_c) { mr_c = __builtin_amdgcn_readfirstlane(mr); const float* mv = modv + ((size_t)layer * 9 + mr_c) * 6144;
#pragma unroll
                for (int j = 0; j < 4; ++j) { shc[j] = *(const f32x4*)(mv + 3072 + 4 * lane + 256 * j); scc[j] = *(const f32x4*)(mv + 4096 + 4 * lane + 256 * j) + 1.0f; } }
#pragma unroll
            for (int j = 0; j < 4; ++j) {
                const f32x4 o = v[j] * rstd * gn[j] * scc[j] + shc[j];
                if (ok) *(unsigned*)(F.ws + WS_HB8 + (size_t)r * D + 4 * lane + 256 * j) = pk4_fp8(o[0], o[1], o[2], o[3]);
                u32x2 pw; pw.x = pk2(o[0], o[1]); pw.y = pk2(o[2], o[3]);
                const int chunk = (lane >> 1) + 32 * j;
                *(LAS u32x2*)(XT + rl * 2048 + ((chunk ^ rl) << 4) + (lane & 1) * 8) = pw;
            }
        }
        __syncthreads();
        {
            const int rr = lane & 15; const LAS unsigned char* abase = XT + rr * 2048;
            f32x4 a0 = {0.f, 0.f, 0.f, 0.f}, a1 = a0, a2 = a0;
#pragma unroll
            for (int ks = 0; ks < 4; ++ks) { const int c = 16 * w + 4 * ks + (lane >> 4); const bf16x8 af = *(const LAS bf16x8*)(abase + ((c ^ rr) << 4));
                a0 = mfma16(af, bwr[0][ks], a0); a1 = mfma16(af, bwr[1][ks], a1); a2 = mfma16(af, bwr[2][ks], a2); }
            LAS float* pp = part + w * 768;
#pragma unroll
            for (int i = 0; i < 4; ++i) { const int row = (lane >> 4) * 4 + i; pp[row * 48 + (lane & 15)] = a0[i]; pp[row * 48 + 16 + (lane & 15)] = a1[i]; pp[row * 48 + 32 + (lane & 15)] = a2[i]; }
        }
        __syncthreads();
        for (int vI = tid; vI < 768; vI += 512) { float s = 0.f;
#pragma unroll
            for (int ww = 0; ww < 8; ++ww) s += part[ww * 768 + vI];
            lg[vI] = s; }
        __syncthreads();
        if (tid < 16 && r0 + tid < row_end && (layer == 3 && (r0 + tid) % TPB < NCTX)) lrec[2 * (r0 + tid - row_beg)] = (u32x4){0xffffffffu, 0u, 0u, 0u};
        else if (tid < 16 && r0 + tid < row_end) {
            const int row = r0 + tid;
            const LAS float* Lr = lg + tid * 48;
            float gl[4]; int gi = 0; float gm = -3.0e38f;
#pragma unroll
            for (int k = 0; k < 4; ++k) { gl[k] = Lr[k] + bg[k]; if (gl[k] > gm) { gm = gl[k]; gi = k; } }
            float gs = 0.f;
#pragma unroll
            for (int k = 0; k < 4; ++k) gs += fast_exp(gl[k] - gm);
            const float gval = 1.0f / gs;
            float el[8]; float em = -3.0e38f; int i0 = 0;
#pragma unroll
            for (int k = 0; k < 8; ++k) { el[k] = Lr[4 + 8 * gi + k] + br[8 * gi + k]; if (el[k] > em) { em = el[k]; i0 = k; } }
            float em2 = -3.0e38f; int i1 = 0;
#pragma unroll
            for (int k = 0; k < 8; ++k) if (k != i0 && el[k] > em2) { em2 = el[k]; i1 = k; }
            const float p1 = fast_exp(em2 - em);
            const float inv = 1.0f / (1.0f + p1);
            RouteRec rec; rec.e0 = gi * 8 + i0; rec.e1 = gi * 8 + i1; rec.w0 = gval * inv; rec.w1 = gval * p1 * inv;
            rec.r0 = (int)__hip_atomic_fetch_add(lcnt + rec.e0, 1u, __ATOMIC_RELAXED, __HIP_MEMORY_SCOPE_WORKGROUP);
            rec.r1 = (int)__hip_atomic_fetch_add(lcnt + rec.e1, 1u, __ATOMIC_RELAXED, __HIP_MEMORY_SCOPE_WORKGROUP);
            rec.p0 = 0; rec.p1 = 0;
            lrec[2 * (row - row_beg)] = (u32x4){(unsigned)rec.e0, (unsigned)rec.e1, (unsigned)rec.r0, (unsigned)rec.r1}; lrec[2 * (row - row_beg) + 1] = (u32x4){__float_as_uint(rec.w0), __float_as_uint(rec.w1), 0u, 0u};
        }
    }
    __syncthreads();
    if (tid < 32) { const unsigned c = lcnt[tid]; lcnt[32 + tid] = c ? __hip_atomic_fetch_add(cntp + tid * 64, c, __ATOMIC_RELAXED, __HIP_MEMORY_SCOPE_AGENT) : 0u; }
    __syncthreads();
    for (int i = tid; i < row_end - row_beg; i += 512) {
        const u32x4 ra = lrec[2 * i], rb = lrec[2 * i + 1];
        if ((int)ra.x < 0) continue;
        RouteRec rec; rec.e0 = (int)ra.x; rec.e1 = (int)ra.y; rec.r0 = (int)ra.z; rec.r1 = (int)ra.w; rec.w0 = __uint_as_float(rb.x); rec.w1 = __uint_as_float(rb.y); rec.p0 = 0; rec.p1 = 0;
        rec.r0 += (int)lcnt[32 + rec.e0]; rec.r1 += (int)lcnt[32 + rec.e1];
        const int row = row_beg + i;
        routew[row] = rec;
        idx[(size_t)rec.e0 * T + rec.r0] = row; idx[(size_t)rec.e1 * T + rec.r1] = row;
    }
}

struct MoeOrder {
    int G, c, ntiles, K; const char* A; const char* Bt; size_t bstride; const int* idx; bool gather; bool xcdmap;
    const LAS int* tbl;
    DI bool next(int i, pg8::Unit& u) const {
        int rt, pn, e = 0;
        if (xcdmap) {
            const int x = c & 7, j = c >> 3; const int U = j + 32 * i; int tt = U >> 2; pn = U & 3; bool found = false;
            for (int k = 0; k < 4; ++k) { const int ee = x + 8 * k; const int n = tbl[ee + 1] - tbl[ee]; if (!found) { if (tt < n) { e = ee; found = true; } else tt -= n; } }
            if (!found) return false;
            rt = tbl[e] + tt;
        } else {
        const long L = (long)i * G + c; if (L >= (long)ntiles * 4) return false;
        rt = (int)(L >> 2); pn = (int)(L & 3);
        for (int k = 1; k < 32; ++k) if (tbl[k] <= rt) e = k;
        }
        u.pm = rt; u.pn = pn; u.e = e; u.r0 = (rt - tbl[e]) * 256; u.cnt = tbl[64 + e];
        u.a = gather ? A : A + (size_t)rt * 256 * K * 2;
        u.b = Bt + (size_t)e * bstride + (size_t)pn * 256 * K * 2;
        return true;
    }
    DI void aoff(const pg8::Unit& u, int K_, const int (&R)[2], const int (&C)[2], unsigned (&va)[2][2]) const {
#pragma unroll
        for (int h = 0; h < 2; ++h)
#pragma unroll
            for (int i = 0; i < 2; ++i) {
                if (gather) { int rr = u.r0 + R[i] + 128 * h; if (rr >= u.cnt) rr = 0; const int tok = idx[(size_t)u.e * T + rr]; va[h][i] = (unsigned)(tok * K_ + C[i]) * 2u; }
                else va[h][i] = (unsigned)((R[i] + 128 * h) * K_ + C[i]) * 2u;
            }
    }
};
DI int moe_build_table(Frame& F, int layer, LAS int* tbl) {
    __syncthreads();
    if (F.tid < 64) {
        unsigned* cntp = (unsigned*)(F.ws + WS_CTL) + CW_CNT + layer * 32 * 64;
        const int lane = F.tid;
        int c = (lane < 32) ? (int)__hip_atomic_load(cntp + lane * 64, __ATOMIC_RELAXED, __HIP_MEMORY_SCOPE_AGENT) : 0;
        int ntl = (c + 255) >> 8, incl = ntl;
#pragma unroll
        for (int o = 1; o < 32; o <<= 1) { const int t = __shfl_up(incl, o); if ((lane & 31) >= o) incl += t; }
        if (lane < 32) { tbl[lane] = incl - ntl; tbl[64 + lane] = c; }
        if (lane == 31) tbl[32] = incl;
    }
    __syncthreads();
    return tbl[32];
}

DI bool moe_xcd_balanced(const Frame& F, const LAS int* tbl, int ntl) {
    if (F.G != 256) return false;
    int mx = 0;
    for (int x = 0; x < 8; ++x) { int sum = 0; for (int k = 0; k < 4; ++k) sum += tbl[x + 8 * k + 1] - tbl[x + 8 * k]; mx = sum > mx ? sum : mx; }
    return mx * 8 <= ntl + (ntl >> 2) + 8;
}

template <int DV> struct FlashSt { f32x16 o[DV / 32]; float m, l; };
template <int DV, int KSTR, int VSTR, bool MASK, class SF>
DI void flash_subtile(const LAS unsigned char* kb, const LAS unsigned char* vb, const bf16x8 (&qf)[4], FlashSt<DV>& st, const float scale_l2e, const int lane, const SF& sfun) {
    const int r = lane & 31, h = lane >> 5;
    f32x16 s;
#pragma unroll
    for (int i = 0; i < 16; ++i) s[i] = 0.f;
#pragma unroll
    for (int ks = 0; ks < 4; ++ks) { const bf16x8 a = *(const LAS bf16x8*)(kb + r * KSTR + (16 * ks + 8 * h) * 2); s = mfma32(a, qf[ks], s); }
    float mx = -INFINITY;
#pragma unroll
    for (int i = 0; i < 16; ++i) { s[i] = s[i] * scale_l2e; if (MASK) s[i] += sfun(i); mx = fmaxf(mx, s[i]); }
    mx = fmaxf(mx, __shfl_xor(mx, 32));
    const float mnew = fmaxf(st.m, mx);
    const float muse = (mnew == -INFINITY) ? 0.f : mnew;
    const float alpha = fast_exp2(st.m - muse);
    float rs = 0.f;
#pragma unroll
    for (int i = 0; i < 16; ++i) { s[i] = fast_exp2(s[i] - muse); rs += s[i]; }
    rs += __shfl_xor(rs, 32);
    st.l = st.l * alpha + rs; st.m = mnew;
#pragma unroll
    for (int d = 0; d < DV / 32; ++d)
#pragma unroll
        for (int i = 0; i < 16; ++i) st.o[d][i] *= alpha;
    const bf16x8 p0 = pack_step(s, 0), p1 = pack_step(s, 1);
    const int i16 = lane & 15, q = i16 >> 2, p = i16 & 3, blk = (lane >> 4) & 1;
    const LAS unsigned char* vl = vb + (4 * h + q) * VSTR + (16 * blk + 4 * p) * 2;
#pragma unroll
    for (int d = 0; d < DV / 32; ++d) {
        const s16x4 lo0 = tr_read(vl + d * 64), hi0 = tr_read(vl + 8 * VSTR + d * 64);
        const s16x4 lo1 = tr_read(vl + 16 * VSTR + d * 64), hi1 = tr_read(vl + 24 * VSTR + d * 64);
        st.o[d] = mfma32(cat4(lo0, hi0), p0, st.o[d]);
        st.o[d] = mfma32(cat4(lo1, hi1), p1, st.o[d]);
    }
}

DI int naf(int row) { return (((row >> 1) & 1) << 2) | ((row >> 2) & 3); }
DI void phase_na_attn(Frame& F, int j  , bool with_ctx) {
    const bf16_t* QKV = (const bf16_t*)(F.ws + R_QKV); unsigned char* AO = F.ws + R_AO;
    const float* rpb = F.in[IN_NARPB] + (size_t)j * 16 * 15 * 31;
    LAS unsigned char* L = F.lds;
    LAS float* biasp = (LAS float*)(L + 65536);
    LAS float* bias = biasp + 64;
    LAS float* ninf = biasp + 64 + 465 + 64;
    const int w = F.wave;
    const int n_lat = NB * 16 * 8, n_units = n_lat + (with_ctx ? NB * 16 : 0);
    const int ncb = w & 3, rq = w >> 2;
    const int kst = __builtin_amdgcn_readfirstlane((ncb == 0) ? 0 : (ncb == 1) ? 8 : (ncb == 2) ? 24 : 32);
    for (int unit0 = F.bid; unit0 < n_units; unit0 += F.G) {
        int unit = unit0;
        if (F.G == 256 && unit0 < n_lat) { const int k = unit0 >> 8, wv = unit0 & 255; unit = ((k * 32 + (wv & 7) * 4 + ((wv >> 3) >> 3)) << 3) | ((wv >> 3) & 7); }
    const int lane = hw_lane(), tid = w * 64 + lane, r32 = lane & 31, hh = lane >> 5;
    const int q4 = (lane & 15) >> 2, p4 = lane & 3, blk = (lane >> 4) & 1, LP = 2 * blk + (p4 >> 1);
    const int K0w = (kst + r32) * 128 + ((hh ^ naf(kst + r32)) << 4), K0c = r32 * 128 + ((hh ^ naf(r32)) << 4);
    const int xbw = (kst >> 2) & 3;
    const int V0w = (4 * hh + q4) * 128 + ((q4 >> 1) << 6) + ((LP ^ ((xbw + hh) & 3)) << 4) + (p4 & 1) * 8;
    const int V0c = (4 * hh + q4) * 128 + ((q4 >> 1) << 6) + ((LP ^ (hh & 3)) << 4) + (p4 & 1) * 8;
    const int drow0 = 16 * w + (lane >> 3), dpos = lane & 7;
    const int dsrc0 = (dpos ^ naf(drow0)) * 8, dsrc1 = (dpos ^ naf(drow0 + 8)) * 8;
    {
        const bool lat = unit < n_lat;
        int b, head, rg = 0;
        if (lat) { b = unit >> 7; head = (unit >> 3) & 15; rg = unit & 7; } else { const int u2 = unit - n_lat; b = u2 >> 4; head = u2 & 15; }
        const int r0 = 8 * rg;
        const int kr_lo = min(max(r0 - 4, 0), 56), kr_hi = min(max(r0 + 3, 0), 56) + 7;
        const int nwin = lat ? (kr_hi - kr_lo + 2) / 2 : 0, ntile = 2 + nwin;
        __syncthreads();
        for (int i = tid; i < 64 + 465 + 64 + 128; i += 512) { const int bi = i - 64; biasp[i] = (bi >= 0 && bi < 465) ? rpb[head * 465 + bi] * 1.4426950408889634f : (i >= 64 + 465 + 64 ? -INFINITY : 0.f); }
        const bf16_t* kvbase = QKV + (size_t)(b * TPB) * 3072 + 1024 + head * 64;
        auto issue = [&](int t) {
            LAS unsigned char* dst = L + (t & 1) * 32768 + w * 2048;
            int tok0, tok1;
            if (t < 2) { tok0 = 128 * t + drow0; tok1 = tok0 + 8; }
            else { const int kr0 = kr_lo + 2 * (t - 2); const int ra = drow0, rb = drow0 + 8;
                tok0 = NCTX + min(kr0 + (ra >> 6), 63) * 64 + (ra & 63); tok1 = NCTX + min(kr0 + (rb >> 6), 63) * 64 + (rb & 63); }
            const bf16_t* p0 = kvbase + (size_t)tok0 * 3072 + dsrc0; const bf16_t* p1 = kvbase + (size_t)tok1 * 3072 + dsrc1;
            dma16(p0, dst);
            dma16(p1, (dst + 1024));
            dma16((p0 + 1024), (dst + 16384));
            dma16((p1 + 1024), (dst + 16384 + 1024));
        };
        issue(0);
        int qtok[2], qr[2]; const int qc = 16 * ncb + (r32 & 15);
#pragma unroll
        for (int qi = 0; qi < 2; ++qi) {
            if (lat) { qr[qi] = r0 + 4 * rq + 2 * qi + (r32 >> 4); qtok[qi] = b * TPB + NCTX + qr[qi] * 64 + qc; }
            else { qr[qi] = 0; qtok[qi] = b * TPB + 32 * w + r32; }
        }
        bf16x8 qf[2][4];
#pragma unroll
        for (int qi = 0; qi < 2; ++qi)
#pragma unroll
            for (int ks = 0; ks < 4; ++ks) qf[qi][ks] = *(const bf16x8*)(QKV + (size_t)qtok[qi] * 3072 + head * 64 + 16 * ks + 8 * hh);
#pragma unroll
        for (int qi = 0; qi < 2; ++qi)
#pragma unroll
            for (int ks = 0; ks < 4; ++ks) asm volatile("" : "+v"(qf[qi][ks]));
        const int wst = min(max(qc - 8, 0), 48);
        unsigned colmask = 0u;
#pragma unroll
        for (int i = 0; i < 16; ++i) { const int kc = kst + crow(i, hh); if (kc >= wst && kc < wst + 16) colmask |= 1u << i; }
        const int wr0 = r0 + 4 * rq; const int wlo = min(max(wr0 - 4, 0), 56), whi = min(max(wr0 + 3 - 4, 0), 56) + 7;
        const int qlo0 = min(max(wr0 - 4, 0), 56), qhi0 = min(max(wr0 + 1 - 4, 0), 56) + 7, qlo1 = min(max(wr0 + 2 - 4, 0), 56), qhi1 = min(max(wr0 + 3 - 4, 0), 56) + 7;
        f32x16 O[2][2]; float mrun[2], lrun[2];
#pragma unroll
        for (int qi = 0; qi < 2; ++qi) { mrun[qi] = -INFINITY; lrun[qi] = 0.f;
#pragma unroll
            for (int d = 0; d < 2; ++d)
#pragma unroll
                for (int i = 0; i < 16; ++i) O[qi][d][i] = 0.f; }
        auto subtile = [&](const LAS unsigned char* kb, const LAS unsigned char* vb, const int K0x, const int V0x, const bool masked, const int kr) {
            const int K0t = opaque(K0x), V0t = opaque(V0x);
            bf16x8 P[2][2];
            const bool use0 = !masked || (kr >= qlo0 && kr <= qhi0), use1 = !masked || (kr >= qlo1 && kr <= qhi1);
#pragma unroll
            for (int qi = 0; qi < 2; ++qi) {
                if (!(qi ? use1 : use0)) continue;
                f32x16 s;
                if (masked) {
                    const int rs = min(max(qr[qi] - 4, 0), 56); const bool rowok = (kr >= rs) && (kr < rs + 8);
                    const int dyc = min(max(kr - qr[qi] + 7, 0), 14);
                    const int delta = -qc + kst + 4 * hh;
                    const LAS float* bp = rowok ? (bias + opaque(dyc * 31 + 15 + delta)) : (ninf + opaque(64 + delta));
#pragma unroll
                    for (int i = 0; i < 16; ++i) s[i] = ((colmask >> i) & 1u) ? bp[(i & 3) + 8 * (i >> 2)] : -INFINITY;
                } else {
#pragma unroll
                    for (int i = 0; i < 16; ++i) s[i] = 0.f;
                }
#pragma unroll
                for (int ks = 0; ks < 4; ++ks) { const bf16x8 kf = *(const LAS bf16x8*)(kb + (K0t ^ (ks << 5))); s = mfma32(kf, qf[qi][ks], s); }
                float mx = s[0];
#pragma unroll
                for (int i = 1; i < 16; ++i) mx = fmaxf(mx, s[i]);
                mx = xhalf_max(mx);
                if (__any(mx > mrun[qi] + 8.0f)) {
                    const float mnew = fmaxf(mrun[qi], mx); const float alpha = fast_exp2(mrun[qi] - mnew);
                    mrun[qi] = mnew; lrun[qi] *= alpha;
#pragma unroll
                    for (int d = 0; d < 2; ++d)
#pragma unroll
                        for (int i = 0; i < 16; ++i) O[qi][d][i] *= alpha;
                }
                const float mu = mrun[qi]; float rsum = 0.f;
#pragma unroll
                for (int i = 0; i < 16; ++i) { s[i] = fast_exp2(s[i] - mu); rsum += s[i]; }
                lrun[qi] += rsum;
                P[qi][0] = pack_step(s, 0); P[qi][1] = pack_step(s, 1);
            }
#pragma unroll
            for (int d = 0; d < 2; ++d)
#pragma unroll
                for (int s2 = 0; s2 < 2; ++s2) {
                    const int va = V0t ^ (d << 6); const s16x4 lo = tr_read(vb + s2 * 2048 + va), hi = tr_read(vb + s2 * 2048 + 1024 + (va ^ 32));
                    const bf16x8 vf = cat4(lo, hi);
                    if (use0) O[0][d] = mfma32(vf, P[0][s2], O[0][d]);
                    if (use1) O[1][d] = mfma32(vf, P[1][s2], O[1][d]);
                }
        };
        for (int t = 0; t < ntile; ++t) {
            asm volatile("s_waitcnt vmcnt(0)" ::: "memory"); __builtin_amdgcn_s_barrier(); asm volatile("" ::: "memory");
            if (t + 1 < ntile) issue(t + 1);
            const LAS unsigned char* Kb = L + (t & 1) * 32768; const LAS unsigned char* Vb = Kb + 16384;
            if (t < 2) {
#pragma nounroll
                for (int sb = 0; sb < 4; ++sb) subtile(Kb + sb * 4096, Vb + sb * 4096, K0c, V0c, false, 0);
            } else {
#pragma nounroll
                for (int jr = 0; jr < 2; ++jr) { const int kr = kr_lo + 2 * (t - 2) + jr;
                    if (kr >= wlo && kr <= whi) subtile(Kb + jr * 8192, Vb + jr * 8192 + kst * 128, K0w, V0w, true, kr); }
            }
        }
#pragma unroll
        for (int qi = 0; qi < 2; ++qi) {
            if (!lat && qi == 1) continue;
            const float inv = 1.0f / (lrun[qi] + __shfl_xor(lrun[qi], 32));
            const int l2 = hw_lane(), r2 = l2 & 31, h2 = l2 >> 5;
            const int qt2 = lat ? (b * TPB + NCTX + (r0 + 4 * rq + 2 * qi + (r2 >> 4)) * 64 + 16 * ncb + (r2 & 15)) : (b * TPB + 32 * w + r2);
            unsigned char* op = AO + (size_t)qt2 * D + head * 64 + 4 * h2;
#pragma unroll
            for (int d = 0; d < 2; ++d)
#pragma unroll
                for (int g = 0; g < 4; ++g) *(unsigned*)(op + 32 * d + 8 * g) = pk4_fp8(O[qi][d][4 * g] * inv, O[qi][d][4 * g + 1] * inv, O[qi][d][4 * g + 2] * inv, O[qi][d][4 * g + 3] * inv);
        }
    }
    }
}

DI int gsw(int p) { return ((p & 3) << 2) | ((p >> 2) & 3); }
DI void phase_da_attn(Frame& F, bool with_ctx) {
    const bf16_t* QKV = (const bf16_t*)(F.ws + R_QKV); unsigned char* AO = F.ws + R_AO;
    LAS unsigned char* L = F.lds;
    LAS float* xch = (LAS float*)L;
    LAS float* misc = (LAS float*)(L + 131072);
    const int w = F.wave;
    const float lambda_init = 0.8f - 0.6f * expf(-0.3f * 2.0f);
    __syncthreads();
    if (w == 0) { const int lane = F.lane; const float* lam = F.in[IN_DALAM]; const float a = wave_sum(lam[lane] * lam[64 + lane]), c2 = wave_sum(lam[128 + lane] * lam[192 + lane]);
        if (lane == 0) misc[0] = expf(a) - expf(c2) + lambda_init; }
    __syncthreads();
    const float lam_full = misc[0];
    const int n_lat = NB * 8 * 16, n_units = n_lat + (with_ctx ? NB * 8 : 0);
    const int map = w >> 2, qw = w & 3;
    for (int unit0 = F.bid; unit0 < n_units; unit0 += F.G) {
        int unit = unit0;
        if (F.G == 256 && unit0 < n_lat) { const int k = unit0 >> 8, wv = unit0 & 255; unit = ((k * 16 + (wv & 7) * 2 + ((wv >> 3) >> 4)) << 4) | ((wv >> 3) & 15); }
        const int lane = hw_lane(), r32 = lane & 31, hh = lane >> 5;
        const int K0 = r32 * 256 + ((((map * 8 + hh) ^ gsw(r32))) << 4);
        const int q4 = (lane & 15) >> 2, p4 = lane & 3, blk = (lane >> 4) & 1, LP = 2 * blk + (p4 >> 1);
        const int V0 = (4 * hh + q4) * 256 + (q4 << 6) + ((LP ^ (hh & 3)) << 4) + (p4 & 1) * 8;
        const int drow0 = 8 * w + (lane >> 4), dpos = lane & 15;
        const int dsrc0 = (dpos ^ gsw(drow0)) * 8, dsrc1 = (dpos ^ gsw(drow0 + 4)) * 8;
        const bool lat = unit < n_lat;
        int b, head, qb;
        if (lat) { b = unit >> 7; head = (unit >> 4) & 7; qb = unit & 15; } else { const int u2 = unit - n_lat; b = u2 >> 3; head = u2 & 7; qb = 0; }
        const int qtok0 = b * TPB + (lat ? NCTX : 0) + qb * 256 + qw * 64;
        __syncthreads();
        const bf16_t* kbase = QKV + (size_t)(b * TPB) * 3072 + 1024 + head * 128;
        auto issue = [&](int t) {
            LAS unsigned char* dst = L + (t & 1) * 32768 + w * 2048;
            const bf16_t* r0 = kbase + (size_t)(t * 64 + drow0) * 3072; const bf16_t* r1 = r0 + (size_t)4 * 3072;
            dma16((r0 + dsrc0), dst);
            dma16((r1 + dsrc1), (dst + 1024));
            dma16((r0 + 1024 + dsrc0), (dst + 16384));
            dma16((r1 + 1024 + dsrc1), (dst + 16384 + 1024));
        };
        issue(0);
        bf16x8 qf[2][4];
#pragma unroll
        for (int qi = 0; qi < 2; ++qi)
#pragma unroll
            for (int ks = 0; ks < 4; ++ks) qf[qi][ks] = *(const bf16x8*)(QKV + (size_t)(qtok0 + 32 * qi + r32) * 3072 + head * 128 + map * 64 + 16 * ks + 8 * hh);
#pragma unroll
        for (int qi = 0; qi < 2; ++qi)
#pragma unroll
            for (int ks = 0; ks < 4; ++ks) asm volatile("" : "+v"(qf[qi][ks]));
        f32x16 O[2][4]; float mrun[2], lrun[2];
#pragma unroll
        for (int qi = 0; qi < 2; ++qi) { mrun[qi] = 0.f; lrun[qi] = 0.f;
#pragma unroll
            for (int d = 0; d < 4; ++d)
#pragma unroll
                for (int i = 0; i < 16; ++i) O[qi][d][i] = 0.f; }
        const int ntile = lat ? 68 : 4;
        for (int t = 0; t < ntile; ++t) {
            asm volatile("s_waitcnt vmcnt(0)" ::: "memory"); __builtin_amdgcn_s_barrier(); asm volatile("" ::: "memory");
            if (t + 1 < ntile) issue(t + 1);
            const LAS unsigned char* Kb = L + (t & 1) * 32768; const LAS unsigned char* Vb = Kb + 16384;
#pragma unroll
            for (int kb = 0; kb < 2; ++kb) {
                const bool first = (t == 0) && (kb == 0);
                const int K0t = opaque(K0), V0t = opaque(V0);
                bf16x8 P[2][2];
#pragma unroll
                for (int qi = 0; qi < 2; ++qi) {
                    f32x16 s; { float ninit = -mrun[qi]; asm volatile("" : "+v"(ninit));
#pragma unroll
                        for (int i = 0; i < 16; ++i) s[i] = ninit; }
#pragma unroll
                    for (int ks = 0; ks < 4; ++ks) { const bf16x8 kf = *(const LAS bf16x8*)(Kb + kb * 8192 + (K0t ^ (ks << 5))); s = mfma32(kf, qf[qi][ks], s); }
                    if (first) {
                        float mx = s[0];
#pragma unroll
                        for (int i = 1; i < 16; ++i) mx = fmaxf(mx, s[i]);
                        mx = xhalf_max(mx); mrun[qi] += mx;
#pragma unroll
                        for (int i = 0; i < 16; ++i) s[i] -= mx;
                    }
                    float rs = 0.f;
#pragma unroll
                    for (int i = 0; i < 16; ++i) { s[i] = fast_exp2(s[i]); rs += s[i]; }
                    if (!first && __any(!(rs < 0x1p30f))) {
                        { float ninit = -mrun[qi]; asm volatile("" : "+v"(ninit));
#pragma unroll
                          for (int i = 0; i < 16; ++i) s[i] = ninit; }
#pragma unroll
                        for (int ks = 0; ks < 4; ++ks) { const bf16x8 kf = *(const LAS bf16x8*)(Kb + kb * 8192 + (K0t ^ (ks << 5))); s = mfma32(kf, qf[qi][ks], s); }
                        float mx = s[0];
#pragma unroll
                        for (int i = 1; i < 16; ++i) mx = fmaxf(mx, s[i]);
                        mx = xhalf_max(mx);
                        const float shift = fmaxf(mx, 0.f), alpha = fast_exp2(-shift);
                        mrun[qi] += shift; lrun[qi] *= alpha;
#pragma unroll
                        for (int d = 0; d < 4; ++d)
#pragma unroll
                            for (int i = 0; i < 16; ++i) O[qi][d][i] *= alpha;
                        rs = 0.f;
#pragma unroll
                        for (int i = 0; i < 16; ++i) { s[i] = fast_exp2(s[i] - shift); rs += s[i]; }
                    }
                    lrun[qi] += rs;
                    P[qi][0] = pack_step(s, 0); P[qi][1] = pack_step(s, 1);
                }
#pragma unroll
                for (int d = 0; d < 4; ++d)
#pragma unroll
                    for (int s2 = 0; s2 < 2; ++s2) {
                        const int va = V0t ^ (d << 6); const s16x4 lo = tr_read(Vb + (32 * kb + 16 * s2) * 256 + va), hi = tr_read(Vb + (32 * kb + 16 * s2) * 256 + 2048 + (va ^ 32));
                        const bf16x8 vf = cat4(lo, hi);
                        O[0][d] = mfma32(vf, P[0][s2], O[0][d]);
                        O[1][d] = mfma32(vf, P[1][s2], O[1][d]);
                    }
            }
        }
        lrun[0] += __shfl_xor(lrun[0], 32); lrun[1] += __shfl_xor(lrun[1], 32);
        __syncthreads();
        const int lane2 = hw_lane(), r32b = lane2 & 31, hhb = lane2 >> 5;
        if (map == 1) {
#pragma unroll
            for (int qi = 0; qi < 2; ++qi) { const float inv = 1.0f / lrun[qi];
#pragma unroll
                for (int d = 0; d < 4; ++d)
#pragma unroll
                    for (int i = 0; i < 16; ++i) xch[(qw * 128 + qi * 64 + d * 16 + i) * 64 + lane2] = O[qi][d][i] * inv; }
        }
        __syncthreads();
        if (map == 0) {
            const float* sg = F.in[IN_DASUBLN];
#pragma unroll
            for (int qi = 0; qi < 2; ++qi) {
                const float inv = 1.0f / lrun[qi]; float ss = 0.f;
#pragma unroll
                for (int d = 0; d < 4; ++d)
#pragma unroll
                    for (int i = 0; i < 16; ++i) { const float v = O[qi][d][i] * inv - lam_full * xch[(qw * 128 + qi * 64 + d * 16 + i) * 64 + lane2]; O[qi][d][i] = v; ss += v * v; }
                ss += __shfl_xor(ss, 32);
                const float rn = (1.0f - lambda_init) / sqrtf(ss * (1.0f / 128.0f) + EPS);
                unsigned char* op = AO + (size_t)(b * TPB + (lat ? NCTX : 0) + qb * 256 + qw * 64 + 32 * qi + r32b) * D + head * 128 + 4 * hhb;
#pragma unroll
                for (int d = 0; d < 4; ++d)
#pragma unroll
                    for (int g = 0; g < 4; ++g) { const f32x4 gg = *(const f32x4*)(sg + 32 * d + 8 * g + 4 * hhb);
                        *(unsigned*)(op + 32 * d + 8 * g) = pk4_fp8(O[qi][d][4 * g] * rn * gg[0], O[qi][d][4 * g + 1] * rn * gg[1], O[qi][d][4 * g + 2] * rn * gg[2], O[qi][d][4 * g + 3] * rn * gg[3]); }
            }
        }
    }
}

#if PREP_PROBE
#define PREP_STAMP(k) do { const unsigned long long t_ = __builtin_amdgcn_s_memtime(); pacc[k] += t_ - plast; plast = t_; } while (0)
#else
#define PREP_STAMP(k) do { } while (0)
#endif
DI void phase_ml_prep(Frame& F) {
#if PREP_PROBE
    unsigned long long pacc[4] = {0, 0, 0, 0}; unsigned long long plast = __builtin_amdgcn_s_memtime();
#endif
    const bf16_t* XM = (const bf16_t*)(F.ws + R_XM); bf16_t* XC = (bf16_t*)(F.ws + R_XC); bf16_t* V = (bf16_t*)(F.ws + R_V); float* GATES = (float*)(F.ws + R_GATES);
    const bf16_t* WGt = (const bf16_t*)(F.ws + WS_MISC + 512 * 1024);
    LAS unsigned char* XT = F.lds;
    LAS float* part = (LAS float*)(F.lds + 131072);
    const int tid = F.tid, lane = F.lane, w = F.wave;
    const int g = tid;
    f32x2 cw2[5][2], cb2[2], wv2[4][2];
#pragma unroll
    for (int jj = 0; jj < 5; ++jj) { const f32x4 a = *(const f32x4*)(F.in[IN_MLCONVW] + jj * ML_INNER + 4 * g); cw2[jj][0] = (f32x2){a[0], a[1]}; cw2[jj][1] = (f32x2){a[2], a[3]}; }
    { const f32x4 a = *(const f32x4*)(F.in[IN_MLCONVB] + 4 * g); cb2[0] = (f32x2){a[0], a[1]}; cb2[1] = (f32x2){a[2], a[3]}; }
#pragma unroll
    for (int i = 0; i < 4; ++i) { const f32x4 a = *(const f32x4*)(F.in[IN_MLWV] + g * 16 + 4 * i); wv2[i][0] = (f32x2){a[0], a[1]}; wv2[i][1] = (f32x2){a[2], a[3]}; }
    const float bgate = (tid < 256) ? F.in[IN_MLBGATE][tid & 15] : 0.f;
    auto load_rows = [&](int tile, u32x2 (&rw)[20], unsigned& mask) {
        const int t0 = tile * 16; const int b = t0 / TPB, tt = t0 - b * TPB; const int seg0 = b * TPB + (tt < NCTX ? 0 : NCTX), seg1 = b * TPB + (tt < NCTX ? NCTX : TPB);
        unsigned m = 0u;
#pragma unroll
        for (int i = 0; i < 20; ++i) { const int row = t0 - 2 + i; const bool in = (row >= seg0 && row < seg1); const int rc = in ? row : t0; m |= (in ? 1u : 0u) << i;
            rw[i] = *(const u32x2*)(XM + (size_t)rc * ML_INNER + 4 * g); }
        mask = m;
    };
    u32x2 nxt[20]; unsigned nmask = 0u;
    if (F.bid < T / 16) load_rows(F.bid, nxt, nmask);
    for (int tile = F.bid; tile < T / 16; tile += F.G) {
        const int t0 = tile * 16;
        bf16x8 bw[16];
#pragma unroll
        for (int ks = 0; ks < 16; ++ks) bw[ks] = *(const bf16x8*)(WGt + (size_t)(lane & 15) * 4096 + w * 512 + 32 * ks + 8 * (lane >> 4));
        u32x2 raw[20]; const unsigned cmask = nmask;
#pragma unroll
        for (int i = 0; i < 20; ++i) raw[i] = nxt[i];
        if (tile + F.G < T / 16) load_rows(tile + F.G, nxt, nmask);
#pragma unroll
        for (int i = 0; i < 20; ++i) if (!((cmask >> i) & 1u)) { raw[i].x = 0u; raw[i].y = 0u; }
#if PREP_PROBE
        asm volatile("s_waitcnt vmcnt(0)" ::: "memory"); PREP_STAMP(0);
#endif
#pragma unroll
        for (int i = 0; i < 16; ++i) {
            f32x2 a01 = cb2[0], a23 = cb2[1];
#pragma unroll
            for (int jj = 0; jj < 5; ++jj) { const u32x2 u = raw[i + jj]; a01 += cw2[jj][0] * (f32x2){bflo(u.x), bfhi(u.x)}; a23 += cw2[jj][1] * (f32x2){bflo(u.y), bfhi(u.y)}; }
            const float x0 = bflo(raw[i + 2].x), x1 = bfhi(raw[i + 2].x), x2 = bflo(raw[i + 2].y), x3 = bfhi(raw[i + 2].y);
            const f32x2 v01 = wv2[0][0] * x0 + wv2[1][0] * x1 + wv2[2][0] * x2 + wv2[3][0] * x3, v23 = wv2[0][1] * x0 + wv2[1][1] * x1 + wv2[2][1] * x2 + wv2[3][1] * x3;
            u32x2 xcp; xcp.x = pk2(silu_f(a01[0]), silu_f(a01[1])); xcp.y = pk2(silu_f(a23[0]), silu_f(a23[1]));
            u32x2 vp; vp.x = pk2(v01[0], v01[1]); vp.y = pk2(v23[0], v23[1]);
            *(u32x2*)(XC + (size_t)(t0 + i) * ML_INNER + 4 * g) = xcp;
            *(u32x2*)(V + (size_t)(t0 + i) * ML_INNER + 4 * g) = vp;
            const int lo = i * 4096 + (((g >> 1) ^ i) << 4) + (g & 1) * 8;
            *(LAS u32x2*)(XT + lo) = xcp; *(LAS u32x2*)(XT + 65536 + lo) = raw[i + 2];
        }
        PREP_STAMP(1);
        __syncthreads();
        PREP_STAMP(2);
        {
            const int tok = lane & 15; const LAS unsigned char* abase = XT + (w >> 2) * 65536 + tok * 4096;
            f32x4 acc = {0.f, 0.f, 0.f, 0.f};
#pragma unroll
            for (int ks = 0; ks < 16; ++ks) { const int c = (w & 3) * 64 + 4 * ks + (lane >> 4); acc = mfma16(*(const LAS bf16x8*)(abase + ((c ^ tok) << 4)), bw[ks], acc); }
#pragma unroll
            for (int i = 0; i < 4; ++i) part[w * 256 + ((lane >> 4) * 4 + i) * 16 + (lane & 15)] = acc[i];
        }
        __syncthreads();
        if (tid < 256) { const int row = tid >> 4, n = tid & 15; float s = bgate;
#pragma unroll
            for (int ww = 0; ww < 8; ++ww) s += part[ww * 256 + tid];
            if ((n >> 2) & 1) s = fminf(s, 0.f) - log1pf(expf(-fabsf(s)));
            GATES[(size_t)(t0 + row) * 16 + n] = s; }
        PREP_STAMP(3);
    }
#if PREP_PROBE
    if (F.bid == 0 && F.tid == 0) { unsigned long long tot = 0; for (int k = 0; k < 4; ++k) tot += pacc[k]; ((float*)(F.ws + WS_CTL))[2048] = floorf(8.0f * (float)pacc[PREP_PROBE - 1] / (float)tot + 0.5f) / 8.0f; }
#endif
}

constexpr int SC_Q = 0, SC_K = 65536, SC_V = 131072, SC_S = 147456  , SC_VEC = 156672  ;
constexpr int SC_STR = 144;
DI int qk_off(int p, int qd) { const int grp = qd >> 2, q4 = qd & 3; const int pq = (q4 == 1) ? 2 : (q4 == 2) ? 1 : q4; const int c = grp * 2 + (pq >> 1); return p * 1024 + ((c ^ gsw(p)) << 4) + ((pq & 1) << 3); }
DI int qk_chunk(int p, int c) { return p * 1024 + ((c ^ gsw(p)) << 4); }
DI int v_off(int s, int qd) { const int c = qd >> 1; return s * 256 + ((c ^ gsw(s)) << 4) + ((qd & 1) << 3); }

#ifndef SCAN_PROBE
#define SCAN_PROBE 0
#endif
#if SCAN_PROBE
#define SCAN_STAMP(k) do { const unsigned long long t_ = __builtin_amdgcn_s_memtime(); acc_t[((k) + 6) % 7] += t_ - last_t; last_t = t_; } while (0)
#else
#define SCAN_STAMP(k) do { } while (0)
#endif
DI void phase_ml_scan(Frame& F) {
#if SCAN_PROBE
    unsigned long long acc_t[7] = {0, 0, 0, 0, 0, 0, 0}; unsigned long long last_t = __builtin_amdgcn_s_memtime();
#endif
    const bf16_t* XC = (const bf16_t*)(F.ws + R_XC); const bf16_t* V = (const bf16_t*)(F.ws + R_V); const float* GATES = (const float*)(F.ws + R_GATES);
    bf16_t* HF = (bf16_t*)(F.ws + R_XM); bf16_t* HBk = (bf16_t*)(F.ws + R_HBW);
    LAS unsigned char* L = F.lds;
    LAS float* vecA = (LAS float*)(L + SC_VEC);
    LAS float* vecM = vecA + 64;
    LAS float* vecI = vecA + 128;
    LAS float* vecW = vecA + 192;
    LAS float* vecRS = vecA + 256;
    LAS float* vecQN = vecA + 512;
    LAS float* vecN = vecA + 576;
    LAS float* vecS = vecA + 1088;
    LAS float* vecFL = vecA + 1152;
    LAS float* red = (LAS float*)(L + SC_Q);
    LAS float* nsum = (LAS float*)(L + SC_VEC + 4864);
    const int w = F.wave;
    const int etile = w & 3, dhalf = w >> 2;
    for (int unit = F.bid; unit < 256; unit += F.G) {
        const int chain = unit >> 2, es = unit & 3; const int b = chain >> 3, dir = (chain >> 2) & 1, head = chain & 3;
        bf16_t* HO = dir ? HBk : HF;
        f32x16 C[8];
#pragma unroll
        for (int t = 0; t < 8; ++t)
#pragma unroll
            for (int i = 0; i < 16; ++i) C[t][i] = 0.f;
        __syncthreads();
        vecN[F.tid] = 0.f; float nreg = 0.f;
        if (F.tid == 0) { vecS[1] = -INFINITY; }
        { const int j = F.tid >> 4, c4 = F.tid & 15; *(LAS unsigned*)(L + SC_S + j * SC_STR + 64 + 4 * c4) = 0u; if (F.tid < 32) vecRS[64 + F.tid] = 0.f; }
        u32x2 xr[16]; u32x4 vr[2]; float g_i = 0.f, g_f = 0.f;
        auto rowof = [&](int c, int p) -> int { const bool cx = c < 4; const int cc = cx ? c : c - 4; const int seglen = cx ? NCTX : SEQ; const int st = 64 * cc + p; const int segtok = dir ? (seglen - 1 - st) : st; return b * TPB + (cx ? 0 : NCTX) + segtok; };
        auto issue = [&](int c) {
            const bool cx = c < 4; const int cc = cx ? c : c - 4; const int seglen = cx ? NCTX : SEQ;
            const int R0 = b * TPB + (cx ? 0 : NCTX) + (dir ? (seglen - 1 - 64 * cc) : 64 * cc); const int sgn = dir ? -1 : 1;
            const int tid = opaque(F.tid);
            { const int l = tid & 63; const bf16_t* xp = XC + (ptrdiff_t)(R0 + sgn * (l & 15)) * ML_INNER + head * 512 + 64 * w + 4 * (l >> 4); const ptrdiff_t xstep = (ptrdiff_t)sgn * 16 * ML_INNER;
#pragma unroll
              for (int gi = 0; gi < 4; ++gi)
#pragma unroll
                for (int rb = 0; rb < 4; ++rb) xr[gi * 4 + rb] = *(const u32x2*)(xp + gi * 16 + rb * xstep); }
            const bf16_t* vp = V + (ptrdiff_t)(R0 + sgn * (tid >> 4)) * ML_INNER + head * 512 + es * 128 + 8 * (tid & 15); const ptrdiff_t vstep = (ptrdiff_t)sgn * 32 * ML_INNER;
            vr[0] = *(const u32x4*)vp; vr[1] = *(const u32x4*)(vp + vstep);
            if (w == 0) { const int row = R0 + sgn * tid; g_i = GATES[(size_t)row * 16 + dir * 8 + head]; g_f = GATES[(size_t)row * 16 + dir * 8 + 4 + head]; }
        };
        { const int l = hw_lane(); const int n = l & 15, kq = l >> 4; const bool nz = kq == (n >> 2);
          u32x4* frec = (u32x4*)(F.ws + WS_HB) + (size_t)(F.bid * 512 + w * 64 + l) * 4;
          u32x2 uq[4], uk[4];
#pragma unroll
          for (int gi = 0; gi < 4; ++gi) { const int wofs = (head * 128 + 4 * (4 * w + gi) + kq) * 16 + (n & 3);
              const float* pq = F.in[IN_MLWQ] + wofs; const float* pk = F.in[IN_MLWK] + wofs; const float qs = nz ? 0.044194173824159216f : 0.f, ks = nz ? 1.f : 0.f;
              uq[gi].x = pk2(pq[0] * qs, pq[4] * qs); uq[gi].y = pk2(pq[8] * qs, pq[12] * qs); uk[gi].x = pk2(pk[0] * ks, pk[4] * ks); uk[gi].y = pk2(pk[8] * ks, pk[12] * ks); }
          frec[0] = (u32x4){uq[0].x, uq[0].y, uq[1].x, uq[1].y}; frec[1] = (u32x4){uq[2].x, uq[2].y, uq[3].x, uq[3].y};
          frec[2] = (u32x4){uk[0].x, uk[0].y, uk[1].x, uk[1].y}; frec[3] = (u32x4){uk[2].x, uk[2].y, uk[3].x, uk[3].y};
          asm volatile("s_waitcnt vmcnt(0)" ::: "memory"); }
        issue(0);
        for (int c = 0; c < 68; ++c) {
            s16x4 aq[4], ak[4];
            { const int l = opaque(F.lane); const u32x4* frec = (const u32x4*)(F.ws + WS_HB) + (size_t)(F.bid * 512 + w * 64 + l) * 4;
              const u32x4 f0 = frec[0], f1 = frec[1], f2 = frec[2], f3 = frec[3];
              aq[0] = __builtin_bit_cast(s16x4, (u32x2){f0.x, f0.y}); aq[1] = __builtin_bit_cast(s16x4, (u32x2){f0.z, f0.w}); aq[2] = __builtin_bit_cast(s16x4, (u32x2){f1.x, f1.y}); aq[3] = __builtin_bit_cast(s16x4, (u32x2){f1.z, f1.w});
              ak[0] = __builtin_bit_cast(s16x4, (u32x2){f2.x, f2.y}); ak[1] = __builtin_bit_cast(s16x4, (u32x2){f2.z, f2.w}); ak[2] = __builtin_bit_cast(s16x4, (u32x2){f3.x, f3.y}); ak[3] = __builtin_bit_cast(s16x4, (u32x2){f3.z, f3.w}); }
            __syncthreads();
            for (int rp_ = 0; rp_ < ((SCAN_DUP & 1) ? 2 : 1); ++rp_) {
                const int tid = opaque(F.tid);
                { const int l = tid & 63; const int row = l & 15, nq = l >> 4; const int pq_ = (nq == 1) ? 2 : (nq == 2) ? 1 : nq;
                  const int base = row * 1024 + ((((8 * w) | (pq_ >> 1)) ^ gsw(row)) << 4) + ((pq_ & 1) << 3);
#pragma unroll
                  for (int gi = 0; gi < 4; ++gi)
#pragma unroll
                    for (int rb = 0; rb < 4; ++rb) {
                        const s16x4 xb = __builtin_bit_cast(s16x4, xr[gi * 4 + rb]);
                        const f32x4 dq = __builtin_amdgcn_mfma_f32_16x16x16bf16_1k(aq[gi], xb, (f32x4){0.f, 0.f, 0.f, 0.f}, 0, 0, 0);
                        const f32x4 dk = __builtin_amdgcn_mfma_f32_16x16x16bf16_1k(ak[gi], xb, (f32x4){0.f, 0.f, 0.f, 0.f}, 0, 0, 0);
                        u32x2 qq; qq.x = pk2(dq[0], dq[1]); qq.y = pk2(dq[2], dq[3]); u32x2 kk; kk.x = pk2(dk[0], dk[1]); kk.y = pk2(dk[2], dk[3]);
                        const int off = (base ^ ((2 * gi) << 4)) + rb * 16384; *(LAS u32x2*)(L + SC_Q + off) = qq; *(LAS u32x2*)(L + SC_K + off) = kk; } }
#pragma unroll
                for (int i = 0; i < 2; ++i) { const int id = tid + 512 * i; const int p = id >> 4, ch = id & 15; *(LAS u32x4*)(L + SC_V + p * 256 + ((ch ^ gsw(p)) << 4)) = vr[i]; }
            }
            if (w == 0) {
                const int lane = opaque(F.lane);
                const float ig = g_i, lf = g_f;
                float bc = lf;
#pragma unroll
                for (int o = 1; o < 64; o <<= 1) { const float t = __shfl_up(bc, o); if (lane >= o) bc += t; }
                const float a = ig - bc; float pm = a;
#pragma unroll
                for (int o = 1; o < 64; o <<= 1) { const float t = __shfl_up(pm, o); if (lane >= o) pm = fmaxf(pm, t); }
                const float mprev = vecS[1];
                const float M = fmaxf(mprev, pm);
                const float M63 = __shfl(M, 63), blast = __shfl(bc, 63);
                vecA[lane] = a; vecM[lane] = M; vecI[lane] = fast_exp(mprev - M); vecW[lane] = fast_exp(a - M63);
                vecFL[lane] = fast_exp(-(bc + M));
                if (lane == 0) { vecS[0] = fast_exp(mprev - M63); vecS[2] = blast + M63; }
            }
            __syncthreads();
            __builtin_amdgcn_sched_barrier(0);
            for (int rp_ = 0; rp_ < ((SCAN_DUP & 2) ? 2 : 1); ++rp_) {
            {
                const int tid = opaque(F.tid);
                const int j = tid >> 3, part = tid & 7; float s = 0.f;
#pragma unroll
                for (int cc = 0; cc < 8; ++cc) { const int chunk = cc * 8 + part;
                    const u32x4 u = *(const LAS u32x4*)(L + SC_Q + qk_chunk(j, chunk));
                    const int grp = chunk >> 1, hq = chunk & 1; const int d0 = grp * 16 + (hq ? 4 : 0), d1 = grp * 16 + (hq ? 12 : 8);
                    const f32x4 n0 = *(const LAS f32x4*)(vecN + d0), n1 = *(const LAS f32x4*)(vecN + d1);
                    s += bflo(u.x) * n0[0] + bfhi(u.x) * n0[1] + bflo(u.y) * n0[2] + bfhi(u.y) * n0[3];
                    s += bflo(u.z) * n1[0] + bfhi(u.z) * n1[1] + bflo(u.w) * n1[2] + bfhi(u.w) * n1[3]; }
                s += __shfl_xor(s, 1); s += __shfl_xor(s, 2); s += __shfl_xor(s, 4);
                if (part == 0) vecQN[j] = s;
            }
            __builtin_amdgcn_sched_barrier(0);
            if (w >= 4) {
                const int t2 = opaque(F.tid) - 256; const int qd = t2 >> 1, par = t2 & 1; f32x4 acc = {0.f, 0.f, 0.f, 0.f};
#pragma unroll 8
                for (int i = 0; i < 32; ++i) { const int s_ = 2 * i + par; const u32x2 kv = *(const LAS u32x2*)(L + SC_K + qk_off(s_, qd)); const float ws_ = vecW[s_];
                    acc[0] += ws_ * bflo(kv.x); acc[1] += ws_ * bfhi(kv.x); acc[2] += ws_ * bflo(kv.y); acc[3] += ws_ * bfhi(kv.y); }
#pragma unroll
                for (int i = 0; i < 4; ++i) acc[i] += __shfl_xor(acc[i], 1);
                if (par == 0) *(LAS f32x4*)(nsum + 4 * qd) = acc;
            }
            if (w < 3) {
                const int lane = opaque(F.lane); const int r32 = lane & 31, hh = lane >> 5;
                const int jb = (w == 0) ? 0 : 1, sb = (w == 2) ? 1 : 0;
                const int srow = 32 * sb + r32, jrow = 32 * jb + r32;
                f32x16 g0, g1;
#pragma unroll
                for (int i = 0; i < 16; ++i) { g0[i] = 0.f; g1[i] = 0.f; }
                const int kbase = SC_K + srow * 1024, qbase = SC_Q + jrow * 1024; const int gk = gsw(srow), gq = gsw(jrow);
                bf16x8 ca0 = *(const LAS bf16x8*)(L + kbase + (((0 + hh) ^ gk) << 4)), cb0 = *(const LAS bf16x8*)(L + qbase + (((0 + hh) ^ gq) << 4));
                bf16x8 ca1 = *(const LAS bf16x8*)(L + kbase + (((2 + hh) ^ gk) << 4)), cb1 = *(const LAS bf16x8*)(L + qbase + (((2 + hh) ^ gq) << 4));
#pragma unroll
                for (int it = 0; it < 16; ++it) {
                    bf16x8 na0 = ca0, nb0 = cb0, na1 = ca1, nb1 = cb1;
                    if (it + 1 < 16) { const int c0 = 4 * (it + 1) + hh;
                        na0 = *(const LAS bf16x8*)(L + kbase + ((c0 ^ gk) << 4)); nb0 = *(const LAS bf16x8*)(L + qbase + ((c0 ^ gq) << 4));
                        na1 = *(const LAS bf16x8*)(L + kbase + (((c0 + 2) ^ gk) << 4)); nb1 = *(const LAS bf16x8*)(L + qbase + (((c0 + 2) ^ gq) << 4)); }
                    g0 = mfma32(ca0, cb0, g0); g1 = mfma32(ca1, cb1, g1);
                    ca0 = na0; cb0 = nb0; ca1 = na1; cb1 = nb1;
                }
                const float Mj = vecM[jrow]; float rs = 0.f;
#pragma unroll
                for (int g = 0; g < 4; ++g) {
                    const int s0 = 32 * sb + 8 * g + 4 * hh; const f32x4 av = *(const LAS f32x4*)(vecA + s0); float sc[4];
#pragma unroll
                    for (int i = 0; i < 4; ++i) { const float dm = (s0 + i <= jrow) ? fast_exp(av[i] - Mj) : 0.f; sc[i] = (g0[4 * g + i] + g1[4 * g + i]) * dm; rs += sc[i]; }
                    u32x2 pkv; pkv.x = pk2(sc[0], sc[1]); pkv.y = pk2(sc[2], sc[3]);
                    *(LAS u32x2*)(L + SC_S + jrow * SC_STR + s0 * 2) = pkv;
                }
                rs = xhalf_sum(rs);
                if (hh == 0) vecRS[sb * 64 + jrow] = rs;
            }
            }
            __syncthreads();
            __builtin_amdgcn_sched_barrier(0);
            f32x16 O[2];
            for (int rp_ = 0; rp_ < ((SCAN_DUP & 4) ? 2 : 1); ++rp_) {
#pragma unroll
            for (int jb = 0; jb < 2; ++jb)
#pragma unroll
                for (int i = 0; i < 16; ++i) O[jb][i] = 0.f;
                const int lane = opaque(F.lane); const int r32 = lane & 31, hh = lane >> 5;
#pragma unroll
                for (int t = 0; t < 8; ++t) {
#pragma unroll
                    for (int s2 = 0; s2 < 2; ++s2) {
                        const bf16x8 xs = pack_step(C[t], s2);
                        const int chunk = (dhalf * 256 + 32 * t + 16 * s2) / 8 + hh;
#pragma unroll
                        for (int jb = 0; jb < 2; ++jb) { const bf16x8 qb = *(const LAS bf16x8*)(L + SC_Q + qk_chunk(32 * jb + r32, chunk)); O[jb] = mfma32(xs, qb, O[jb]); }
                    }
                    if (t & 1) __builtin_amdgcn_sched_barrier(0);
                }
#pragma unroll
                for (int jb = 0; jb < 2; ++jb) { const float it = vecI[32 * jb + r32];
#pragma unroll
                    for (int i = 0; i < 16; ++i) O[jb][i] *= it; }
                const int i16 = lane & 15, tq = i16 >> 2, tp = i16 & 3, blk = (lane >> 4) & 1;
#pragma unroll
                for (int ks = 0; ks < 2; ++ks) {
                    const int s0 = 32 * dhalf + 16 * ks + 8 * hh;
                    const int qd = (32 * etile + 16 * blk + 4 * tp) >> 2;
                    const s16x4 lo = tr_read(L + SC_V + v_off(s0 + tq, qd)), hi = tr_read(L + SC_V + v_off(s0 + 4 + tq, qd));
                    const bf16x8 af = cat4(lo, hi);
#pragma unroll
                    for (int jb = 0; jb < 2; ++jb) { const bf16x8 sb = *(const LAS bf16x8*)(L + SC_S + (32 * jb + r32) * SC_STR + (32 * dhalf + 16 * ks + 8 * hh) * 2); O[jb] = mfma32(af, sb, O[jb]); }
                }
            }
            __syncthreads();
            __builtin_amdgcn_sched_barrier(0);
            {
                const int lane = opaque(F.lane);
#pragma unroll
                for (int i = 0; i < 16; ++i) red[((etile * 2 + dhalf) * 16 + i) * 64 + lane] = dhalf ? O[0][i] : O[1][i];
            }
            __syncthreads();
            __builtin_amdgcn_sched_barrier(0);
            {
                const int lane = opaque(F.lane); const int r32 = lane & 31, hh = lane >> 5;
                const int j = 32 * dhalf + r32;
                const float den = vecI[j] * vecQN[j] + (vecRS[j] + vecRS[64 + j]);
                const float dinv = 1.0f / fmaxf(fabsf(den), vecFL[j]);
                bf16_t* op = HO + (size_t)rowof(c, j) * ML_INNER + head * 512 + es * 128 + etile * 32 + 4 * hh;
#pragma unroll
                for (int g = 0; g < 4; ++g) { float v[4];
#pragma unroll
                    for (int i = 0; i < 4; ++i) v[i] = ((dhalf ? O[1][4 * g + i] : O[0][4 * g + i]) + red[((etile * 2 + (1 - dhalf)) * 16 + 4 * g + i) * 64 + lane]) * dinv;
                    u32x2 wv; wv.x = pk2(v[0], v[1]); wv.y = pk2(v[2], v[3]); *(u32x2*)(op + 8 * g) = wv; }
            }
            __builtin_amdgcn_sched_barrier(0);
            SCAN_STAMP(0);
            if (c + 1 < 68) issue(c + 1);
            __builtin_amdgcn_sched_barrier(0);
            SCAN_STAMP(1);
            float decay_keep;
            {
                const float decay = vecS[0]; decay_keep = decay;
                const float ndep = decay;
            __builtin_amdgcn_sched_barrier(0);
                int lane = opaque_dep(F.lane, ndep);
#pragma unroll
                for (int t = 0; t < 8; ++t)
#pragma unroll
                    for (int i = 0; i < 16; ++i) C[t][i] *= decay;
                bf16x8 vf[4];
                {
                    const int hh = lane >> 5, i16 = lane & 15, tq = i16 >> 2, tp = i16 & 3, blk = (lane >> 4) & 1;
#pragma unroll
                    for (int ks = 0; ks < 4; ++ks) {
                        const int s0 = 16 * ks + 8 * hh; const int qd = (32 * etile + 16 * blk + 4 * tp) >> 2;
                        const s16x4 lo = tr_read(L + SC_V + v_off(s0 + tq, qd)), hi = tr_read(L + SC_V + v_off(s0 + 4 + tq, qd));
                        const f32x4 w0 = *(const LAS f32x4*)(vecW + s0), w1 = *(const LAS f32x4*)(vecW + s0 + 4);
                        u32x4 pkv;
                        pkv.x = pk2(bf2f((bf16_t)lo[0]) * w0[0], bf2f((bf16_t)lo[1]) * w0[1]); pkv.y = pk2(bf2f((bf16_t)lo[2]) * w0[2], bf2f((bf16_t)lo[3]) * w0[3]);
                        pkv.z = pk2(bf2f((bf16_t)hi[0]) * w1[0], bf2f((bf16_t)hi[1]) * w1[1]); pkv.w = pk2(bf2f((bf16_t)hi[2]) * w1[2], bf2f((bf16_t)hi[3]) * w1[3]);
                        vf[ks] = __builtin_bit_cast(bf16x8, pkv);
                    }
                }
                __builtin_amdgcn_sched_barrier(0);
            SCAN_STAMP(3);
#pragma unroll
                for (int t = 0; t < 8; ++t) {
                    if (t >= 3) lane = opaque_dep(lane, C[t - 3][0]);
                    const int hh = lane >> 5, i16 = lane & 15, tq = i16 >> 2, tp = i16 & 3, blk = (lane >> 4) & 1;
                    const int qd = (dhalf * 256 + 32 * t + 16 * blk + 4 * tp) >> 2;
#pragma unroll
                    for (int ks = 0; ks < 4; ++ks) {
                        const int s0 = 16 * ks + 8 * hh;
                        const s16x4 lo = tr_read(L + SC_K + qk_off(s0 + tq, qd)), hi = tr_read(L + SC_K + qk_off(s0 + 4 + tq, qd));
                        C[t] = mfma32(cat4(lo, hi), vf[ks], C[t]);
                    }
                }
            }
            SCAN_STAMP(4);
            __syncthreads();
            SCAN_STAMP(5);
            nreg = nreg * decay_keep + nsum[F.tid];
            vecN[F.tid] = nreg;
            if (F.tid == 0) vecS[1] = vecS[2];
        }
    }
#if SCAN_PROBE
    if (F.bid == 0 && F.tid == 0) { unsigned long long tot = 0; for (int k = 0; k < 7; ++k) tot += acc_t[k]; ((float*)(F.ws + WS_CTL))[2048] = floorf(16.0f * (float)acc_t[SCAN_PROBE - 1] / (float)tot + 0.5f) / 16.0f; }
#endif
}

DI void phase_ml_finish(Frame& F) {
    const bf16_t* HF = (const bf16_t*)(F.ws + R_XM); const bf16_t* HBk = (const bf16_t*)(F.ws + R_HBW); const bf16_t* Z = (const bf16_t*)(F.ws + R_Z); bf16_t* XC = (bf16_t*)(F.ws + R_XC);
    const int gw = F.bid * 8 + F.wave, NGW = F.G * 8, lane = F.lane;
    f32x4 gwc[4][2], skc[4][2];
#pragma unroll
    for (int hd = 0; hd < 4; ++hd)
#pragma unroll
        for (int q = 0; q < 2; ++q) { gwc[hd][q] = *(const f32x4*)(F.in[IN_MLGNW] + hd * 512 + 8 * lane + 4 * q); skc[hd][q] = *(const f32x4*)(F.in[IN_MLSKIP] + hd * 512 + 8 * lane + 4 * q); }
    u32x4 nx[4][4];
    auto load_row = [&](int r) {
#pragma unroll
        for (int hd = 0; hd < 4; ++hd) { const size_t off = (size_t)r * ML_INNER + hd * 512 + 8 * lane;
            nx[hd][0] = *(const u32x4*)(HF + off); nx[hd][1] = *(const u32x4*)(HBk + off); nx[hd][2] = *(const u32x4*)(Z + off); nx[hd][3] = *(const u32x4*)(XC + off); }
    };
    if (gw < T) load_row(gw);
    for (int r = gw; r < T; r += NGW) {
        u32x4 cur[4][4];
#pragma unroll
        for (int hd = 0; hd < 4; ++hd)
#pragma unroll
            for (int q = 0; q < 4; ++q) cur[hd][q] = nx[hd][q];
        if (r + NGW < T) load_row(r + NGW);
#pragma unroll
        for (int hd = 0; hd < 4; ++hd) {
            const size_t off = (size_t)r * ML_INNER + hd * 512 + 8 * lane;
            const u32x4 a = cur[hd][0], bq = cur[hd][1], zc = cur[hd][2], xq = cur[hd][3];
            float h[8];
            h[0] = bflo(a.x) + bflo(bq.x); h[1] = bfhi(a.x) + bfhi(bq.x); h[2] = bflo(a.y) + bflo(bq.y); h[3] = bfhi(a.y) + bfhi(bq.y);
            h[4] = bflo(a.z) + bflo(bq.z); h[5] = bfhi(a.z) + bfhi(bq.z); h[6] = bflo(a.w) + bflo(bq.w); h[7] = bfhi(a.w) + bfhi(bq.w);
            float s = 0.f;
#pragma unroll
            for (int i = 0; i < 8; ++i) s += h[i];
            const float mu = wave_sum(s) * (1.0f / 512.0f); float q = 0.f;
#pragma unroll
            for (int i = 0; i < 8; ++i) { h[i] -= mu; q += h[i] * h[i]; }
            const float rstd = 1.0f / sqrtf(wave_sum(q) * (1.0f / 512.0f) + EPS);
            float zf[8], xf[8];
            zf[0] = bflo(zc.x); zf[1] = bfhi(zc.x); zf[2] = bflo(zc.y); zf[3] = bfhi(zc.y); zf[4] = bflo(zc.z); zf[5] = bfhi(zc.z); zf[6] = bflo(zc.w); zf[7] = bfhi(zc.w);
            xf[0] = bflo(xq.x); xf[1] = bfhi(xq.x); xf[2] = bflo(xq.y); xf[3] = bfhi(xq.y); xf[4] = bflo(xq.z); xf[5] = bfhi(xq.z); xf[6] = bflo(xq.w); xf[7] = bfhi(xq.w);
            float o[8];
#pragma unroll
            for (int i = 0; i < 8; ++i) o[i] = (h[i] * rstd * gwc[hd][i >> 2][i & 3] + skc[hd][i >> 2][i & 3] * xf[i]) * silu_f(zf[i]);
            u32x2 wv; wv.x = pk4_fp8(o[0], o[1], o[2], o[3]); wv.y = pk4_fp8(o[4], o[5], o[6], o[7]);
            *(u32x2*)(F.ws + R_V + off) = wv;
        }
    }
}

__global__ void __launch_bounds__(512, 2) mk_fwd(Args args) {
    extern __shared__ __attribute__((aligned(16))) unsigned char lds_raw[];
    Frame F;
    F.lds = (LAS unsigned char*)lds_raw; F.ws = args.ws; F.in = args.in; F.out = args.out;
    F.wave = __builtin_amdgcn_readfirstlane((int)threadIdx.x >> 6); F.lane = hw_lane(); F.tid = F.wave * 64 + F.lane; F.G = gridDim.x; F.bid = blockIdx.x;
    volatile LAS unsigned* lctl = (volatile LAS unsigned*)(F.lds + LDS_CTL);
    if (F.tid < 64) lctl[F.tid] = 0u;
    __syncthreads();
    unsigned* ctl = (unsigned*)(F.ws + WS_CTL);
    XcdBarrier bar; bar.bar = ctl + CW_BAR; bar.x = 0; bar.st = nullptr;
    if (!MK_PER_PHASE) bar = xcd_barrier_post(ctl + CW_BAR, lctl, F.tid == 0);
    const int lo = args.ph_lo, hi = args.ph_hi;
    int ph = 0;
    if (PHASE_PROBE >= 0) lctl[10] = (unsigned)__builtin_amdgcn_s_memrealtime();
#define NREP_(p) ((((unsigned long long)(MK_DUP) >> (p)) & 1ull) ? 2 : 1)
#define PHASE_BEGIN if (lo <= ph && ph < hi && ph <= MK_LAST_PHASE && (MK_ONLY < 0 || ph == MK_ONLY)) { if (PHASE_PROBE == ph) lctl[8] = (unsigned)__builtin_amdgcn_s_memrealtime(); for (int rep_ = 0; rep_ < NREP_(ph); ++rep_) { F.lane = hw_lane(); F.tid = F.wave * 64 + F.lane;
#define PHASE_END   if (!MK_PER_PHASE && (ph + 1 < hi || rep_ + 1 < NREP_(ph))) { const int l0 = hw_lane(); xcd_barrier(bar, F.wave == 0 && l0 == 0); } } if (PHASE_PROBE == ph) lctl[9] = (unsigned)__builtin_amdgcn_s_memrealtime() - lctl[8]; } ++ph;

    bf16_t* HB = (bf16_t*)(F.ws + WS_HB);
    bf16_t* XS = (bf16_t*)(F.ws + WS_XS);
    const float* modv = (const float*)(F.ws + WS_MODV);
    LAS int* tbl = (LAS int*)(F.lds + pg8::STAGE_BYTES);

    PHASE_BEGIN phase_prologue(F); PHASE_END

#define MOE_BLOCK(layer) \
    PHASE_BEGIN phase_norm2_router(F, layer); PHASE_END \
    PHASE_BEGIN { const int ntl = moe_build_table(F, layer, tbl); \
        MoeOrder S; S.G = F.G; S.c = F.bid; S.ntiles = ntl; S.K = D / 2; S.A = (const char*)(F.ws + WS_HB8); S.Bt = (const char*)(F.ws + WS_WMOE13); S.bstride = (size_t)1024 * D; \
        S.idx = (const int*)(F.ws + WS_ROUTE + 2 * MiB); S.gather = true; S.tbl = tbl; S.xcdmap = moe_xcd_balanced(F, tbl, ntl); \
        pg8::EpiMoE1 E{F.ws + R_HMID}; pg8::gemm_phase<pg8::EpiMoE1, MoeOrder, true>(F.lds, D / 2, S, E, F.tid); } PHASE_END \
    PHASE_BEGIN { const int ntl = moe_build_table(F, layer, tbl); \
        MoeOrder S; S.G = F.G; S.c = F.bid; S.ntiles = ntl; S.K = MOE_H / 2; S.A = (const char*)(F.ws + R_HMID); S.Bt = (const char*)(F.ws + WS_WMOE2); S.bstride = (size_t)1024 * MOE_H; \
        S.idx = nullptr; S.gather = false; S.tbl = tbl; S.xcdmap = moe_xcd_balanced(F, tbl, ntl); \
        pg8::EpiMoE2 E{F.ws + R_Y}; pg8::gemm_phase<pg8::EpiMoE2, MoeOrder, true>(F.lds, MOE_H / 2, S, E, F.tid); } PHASE_END

#define GEMM_DENSE8X(SKIP, Aptr, Wptr, N_, K_, EPI_T, ...) { pg8::DenseOrder S; S.init((const bf16_t*)(Aptr), (const bf16_t*)(Wptr), T, N_, (K_) / 2, F.G, F.bid, SKIP); EPI_T E{__VA_ARGS__}; pg8::gemm_phase<EPI_T, pg8::DenseOrder, true>(F.lds, (K_) / 2, S, E, F.tid); }
#define GEMM_DENSE8(...) GEMM_DENSE8X(0, __VA_ARGS__)
#define GEMM_DENSE(Aptr, Wptr, N_, K_, EPI_T, ...) { pg8::DenseOrder S; S.init((const bf16_t*)(Aptr), (const bf16_t*)(Wptr), T, N_, K_, F.G, F.bid); EPI_T E{__VA_ARGS__}; pg8::gemm_phase<EPI_T, pg8::DenseOrder>(F.lds, K_, S, E, F.tid); }

    PHASE_BEGIN phase_modulate<0>(F, 0); PHASE_END
    PHASE_BEGIN GEMM_DENSE8(F.ws + WS_HB8, F.ws + WS_WNAQKV, 3072, D, pg8::EpiBf16, (bf16_t*)(F.ws + R_QKV), 3072, 0, 0, 4, 0.125f * 1.4426950408889634f, 1.0f / 32.0f)
        in_gemm_tail(F, (T / 256) * 12, [&](int g0, int ng, LAS float* scr) { convert_matrix(F, F.in[IN_MLUP], D, 4096, (bf16_t*)(F.ws + WS_WMLUP), g0, ng, scr); }); PHASE_END
    PHASE_BEGIN phase_na_attn(F, 0, true); PHASE_END
    PHASE_BEGIN GEMM_DENSE8(F.ws + R_AO, F.ws + WS_WNAO, D, D, pg8::EpiResid, XS, modv + (size_t)0 * 9 * 6144 + 2048, 1.0f / 32.0f) convert_moe_in_tail(F, 0, (T / 256) * (D / 256)); PHASE_END
    MOE_BLOCK(0)
    PHASE_BEGIN phase_modulate<1>(F, 1); PHASE_END
    PHASE_BEGIN GEMM_DENSE(HB, F.ws + WS_WMLUP, 4096, D, pg8::EpiBf16, (bf16_t*)(F.ws + R_XM), ML_INNER, ML_INNER, (size_t)(R_Z - R_XM) / 2, 0, 1.0f, 1.0f)
        in_gemm_tail(F, (T / 256) * 16, [&](int g0, int ng, LAS float* scr) { convert_matrix_fp8(F, F.in[IN_MLDOWN], ML_INNER, D, F.ws + WS_WMLDN, g0, ng, scr); convert_matrix_fp8(F, F.in[IN_DAQKV], D, 3072, F.ws + WS_WDAQKV, g0, ng, scr); }); PHASE_END
    PHASE_BEGIN phase_ml_prep(F); PHASE_END
    PHASE_BEGIN phase_ml_scan(F); PHASE_END
    PHASE_BEGIN phase_ml_finish(F); PHASE_END
    PHASE_BEGIN GEMM_DENSE8(F.ws + R_V, F.ws + WS_WMLDN, D, ML_INNER, pg8::EpiResid, XS, modv + (size_t)1 * 9 * 6144 + 2048, 1.0f / 32.0f) convert_moe_in_tail(F, 1, (T / 256) * (D / 256));
        in_gemm_tail(F, (T / 256) * (D / 256), [&](int g0, int ng, LAS float* scr) { convert_matrix_fp8(F, F.in[IN_DAO], D, D, F.ws + WS_WDAO, g0, ng, scr);
            convert_matrix_fp8(F, F.in[IN_NAQKV] + (size_t)D * 3072, D, 3072, F.ws + WS_WNAQKV + (size_t)3072 * D, g0, ng, scr); convert_matrix_fp8(F, F.in[IN_NAO] + (size_t)D * D, D, D, F.ws + WS_WNAO + (size_t)D * D, g0, ng, scr); }); PHASE_END
    MOE_BLOCK(1)
    PHASE_BEGIN phase_modulate<1>(F, 2); PHASE_END
    PHASE_BEGIN GEMM_DENSE8(F.ws + WS_HB8, F.ws + WS_WDAQKV, 3072, D, pg8::EpiBf16Rope, (bf16_t*)(F.ws + R_QKV), (const float*)(F.ws + WS_MISC + 768 * 1024), 1.0f / 32.0f) PHASE_END
    PHASE_BEGIN phase_da_attn(F, true); PHASE_END
    PHASE_BEGIN GEMM_DENSE8(F.ws + R_AO, F.ws + WS_WDAO, D, D, pg8::EpiResid, XS, modv + (size_t)2 * 9 * 6144 + 2048, 1.0f / 32.0f) convert_moe_in_tail(F, 2, (T / 256) * (D / 256)); PHASE_END
    MOE_BLOCK(2)
    PHASE_BEGIN phase_modulate<1>(F, 3); { LAS float* scr = (LAS float*)(F.lds + F.wave * 16384); __syncthreads(); convert_moe(F, 3, F.bid * 8 + F.wave, F.G * 8, scr); } PHASE_END
    PHASE_BEGIN GEMM_DENSE8(F.ws + WS_HB8, F.ws + WS_WNAQKV + (size_t)3072 * D, 3072, D, pg8::EpiBf16, (bf16_t*)(F.ws + R_QKV), 3072, 0, 0, 4, 0.125f * 1.4426950408889634f, 1.0f / 32.0f) PHASE_END
    PHASE_BEGIN phase_na_attn(F, 1, false); PHASE_END
    PHASE_BEGIN GEMM_DENSE8X(1, F.ws + R_AO, F.ws + WS_WNAO + (size_t)D * D, D, D, pg8::EpiResid, XS, modv + (size_t)3 * 9 * 6144 + 2048, 1.0f / 32.0f) PHASE_END
    MOE_BLOCK(3)
    if (PHASE_PROBE >= 0 && F.bid == 0) { const float fr = (float)lctl[9] / (float)((unsigned)__builtin_amdgcn_s_memrealtime() - lctl[10]); ((float*)(F.ws + WS_CTL))[2048] = 0.04f * fr; }
    if (PHASE_PROBE >= 0) __syncthreads();
    if (lo <= ph && ph < hi) { F.lane = hw_lane(); F.tid = F.wave * 64 + F.lane; phase_modulate<3>(F, 3); } ++ph;
}
constexpr int N_PHASES = 1 + 7 + 9 + 7 + 7 + 1;

extern "C" void kernel_launch(void* const* d_in, const int* in_sizes, int n_in, void* d_out, int out_size, void* d_ws, size_t ws_size, hipStream_t stream) {
    static int grid = 0;
    if (grid == 0) {
        if (n_in != 33 || ws_size < WS_END) { fprintf(stderr, "kernel_launch: unexpected n_in %d or ws_size %zu (< %zu)\n", n_in, ws_size, (size_t)WS_END); grid = -1; return; }
        int dev = 0, cus = 0;
        if (hipGetDevice(&dev) != hipSuccess || hipDeviceGetAttribute(&cus, hipDeviceAttributeMultiprocessorCount, dev) != hipSuccess) { grid = -1; return; }
        if (hipFuncSetAttribute((const void*)mk_fwd, hipFuncAttributeMaxDynamicSharedMemorySize, LDS_BYTES) != hipSuccess) { fprintf(stderr, "kernel_launch: hipFuncSetAttribute failed\n"); grid = -1; return; }
        int per_cu = 0;
        if (hipOccupancyMaxActiveBlocksPerMultiprocessor(&per_cu, (const void*)mk_fwd, 512, LDS_BYTES) != hipSuccess || per_cu < 1) fprintf(stderr, "kernel_launch: occupancy query says %d\n", per_cu);
        (void)hipGetLastError();
        grid = cus;
    }
    if (grid < 0) return;
    (void)hipMemsetAsync((char*)d_ws + WS_CTL, 0, CTL_BYTES, stream);
    Args a{};
    for (int i = 0; i < 33; ++i) a.in[i] = (const float*)d_in[i];
    a.out = (float*)d_out; a.ws = (unsigned char*)d_ws;
#if MK_PER_PHASE
    for (int p = 0; p < N_PHASES; ++p) { a.ph_lo = p; a.ph_hi = p + 1; hipLaunchKernelGGL(mk_fwd, dim3(grid), dim3(512), LDS_BYTES, stream, a); }
#else
    a.ph_lo = 0; a.ph_hi = N_PHASES;
    hipLaunchKernelGGL(mk_fwd, dim3(grid), dim3(512), LDS_BYTES, stream, a);
#endif
}
```

```cpp
#include <hip/hip_runtime.h>
#include <cstdio>
#include <cstdint>

#define DI __device__ __forceinline__
#define LAS __attribute__((address_space(3)))
typedef unsigned short bf16_t;
typedef short bf16x8 __attribute__((ext_vector_type(8)));
typedef short s16x4 __attribute__((ext_vector_type(4)));
typedef float f32x2 __attribute__((ext_vector_type(2)));
typedef float f32x4 __attribute__((ext_vector_type(4)));
typedef float f32x16 __attribute__((ext_vector_type(16)));
typedef unsigned u32x2 __attribute__((ext_vector_type(2)));
typedef unsigned u32x4 __attribute__((ext_vector_type(4)));
typedef __bf16 nbf2 __attribute__((ext_vector_type(2)));
typedef int i32x4 __attribute__((ext_vector_type(4)));
typedef int i32x8 __attribute__((ext_vector_type(8)));

#ifndef MK_PER_PHASE
#define MK_PER_PHASE 0
#endif
#ifndef MK_DUP
#define MK_DUP 0ull
#endif
#ifndef SCAN_PROBE
#define SCAN_PROBE 0
#endif
#ifndef PREP_PROBE
#define PREP_PROBE 0
#endif
#ifndef PHASE_PROBE
#define PHASE_PROBE (-1)
#endif
#ifndef SCAN_DUP
#define SCAN_DUP 0
#endif
#ifndef MK_ONLY
#define MK_ONLY (-1)
#endif
#ifndef MK_LAST_PHASE
#define MK_LAST_PHASE 1000
#endif

constexpr int D = 1024, NB = 8, SEQ = 4096, NCTX = 256, TPB = SEQ + NCTX  , T = NB * TPB  ;
constexpr int NRT = T / 256;
constexpr float EPS = 1e-6f;
constexpr int ML_INNER = 2048;
constexpr int MOE_H = 512, NEXP = 32;
constexpr int MAXTILES = 304;

constexpr size_t MiB = 1u << 20;
constexpr size_t WS_CTL = 0, CTL_BYTES = 1 * MiB;
constexpr size_t WS_MODV = 1 * MiB;
constexpr size_t WS_MISC = 2 * MiB;
constexpr size_t WS_WNAQKV = 3 * MiB;
constexpr size_t WS_WNAO = 15 * MiB;
constexpr size_t WS_WMLUP = 19 * MiB;
constexpr size_t WS_WMLDN = 27 * MiB;
constexpr size_t WS_WDAQKV = 31 * MiB;
constexpr size_t WS_WDAO = 37 * MiB;
constexpr size_t WS_WMOE13 = 39 * MiB;
constexpr size_t WS_WMOE2 = 71 * MiB;
constexpr size_t WS_HB8 = 88 * MiB;
constexpr size_t WS_XS = 135 * MiB;
constexpr size_t WS_HB = 271 * MiB;
constexpr size_t WS_ROUTE = 339 * MiB;
constexpr size_t WS_R = 346 * MiB;
constexpr size_t R_QKV = WS_R;
constexpr size_t R_AO = WS_R + 204 * MiB;
constexpr size_t R_XM = WS_R;
constexpr size_t R_Z = WS_R + 136 * MiB;
constexpr size_t R_XC = WS_R + 272 * MiB;
constexpr size_t R_V = WS_R + 408 * MiB;
constexpr size_t R_HBW = WS_R + 544 * MiB;
constexpr size_t R_GATES = WS_R + 680 * MiB;
constexpr size_t R_HMID = WS_R;
constexpr size_t R_Y = WS_R + 76 * MiB;
constexpr size_t WS_END = WS_R + 683 * MiB;
constexpr int CW_BAR = 4096;
constexpr int CW_CNT = 16384;

constexpr int LDS_BYTES = 163840;
constexpr int LDS_CTL = LDS_BYTES - 256;

DI unsigned pk2(float lo, float hi) { f32x2 v = {lo, hi}; nbf2 r = __builtin_convertvector(v, nbf2); return __builtin_bit_cast(unsigned, r); }
DI unsigned pk4_fp8(float a, float b, float c, float d) { int r = 0; r = __builtin_amdgcn_cvt_pk_fp8_f32(a, b, r, false); r = __builtin_amdgcn_cvt_pk_fp8_f32(c, d, r, true); return (unsigned)r; }
DI float bflo(unsigned u) { return __builtin_bit_cast(float, u << 16); }
DI float bfhi(unsigned u) { return __builtin_bit_cast(float, u & 0xffff0000u); }
DI float bf2f(bf16_t b) { return __builtin_bit_cast(float, ((unsigned)b) << 16); }
DI int hw_lane() { int l; asm volatile("v_mbcnt_lo_u32_b32 %0, -1, 0\n\tv_mbcnt_hi_u32_b32 %0, -1, %0" : "=v"(l)); return l; }
DI int opaque(int v) { asm volatile("" : "+v"(v)); return v; }
DI int opaque_dep(int v, float dep) { asm volatile("" : "+v"(v) : "v"(dep)); return v; }
DI void dma16(const void* g, LAS unsigned char* dst) {
    unsigned keep;
    asm volatile("s_mov_b32 %0, m0\n\ts_mov_b32 m0, %2\n\ts_nop 0\n\tglobal_load_lds_dwordx4 %1, off\n\ts_mov_b32 m0, %0" : "=&s"(keep) : "v"(g), "s"((unsigned)(__UINTPTR_TYPE__)dst) : "memory");
}
DI float xhalf_max(float x) { unsigned a = __builtin_bit_cast(unsigned, x), c = a; asm volatile("" : "+v"(c)); const auto r = __builtin_amdgcn_permlane32_swap(a, c, false, false); return fmaxf(__builtin_bit_cast(float, r[0]), __builtin_bit_cast(float, r[1])); }
DI float xhalf_sum(float x) { return x + __shfl_xor(x, 32); }
DI float xhalf_sum_pl(float x) { unsigned a = __builtin_bit_cast(unsigned, x), c = a; asm volatile("" : "+v"(c)); const auto r = __builtin_amdgcn_permlane32_swap(a, c, false, false); return __builtin_bit_cast(float, r[0]) + __builtin_bit_cast(float, r[1]); }
DI float wave_sum(float v) {
#pragma unroll
    for (int o = 1; o < 64; o <<= 1) v += __shfl_xor(v, o);
    return v;
}
DI float fast_exp2(float x) { return __builtin_amdgcn_exp2f(x); }
DI float fast_exp(float x) { return __builtin_amdgcn_exp2f(x * 1.4426950408889634f); }
DI float fast_rcp(float x) { return __builtin_amdgcn_rcpf(x); }
DI float silu_f(float x) { return x * fast_rcp(1.f + fast_exp(-x)); }
DI f32x16 mfma32(bf16x8 a, bf16x8 b, f32x16 c) { return __builtin_amdgcn_mfma_f32_32x32x16_bf16(a, b, c, 0, 0, 0); }
DI f32x4 mfma16(bf16x8 a, bf16x8 b, f32x4 c) { return __builtin_amdgcn_mfma_f32_16x16x32_bf16(a, b, c, 0, 0, 0); }
DI int crow(int reg, int h) { return (reg & 3) + 8 * (reg >> 2) + 4 * h; }
DI bf16x8 pack_step(const f32x16& x, int s) {
    u32x4 p; p.x = pk2(x[8 * s], x[8 * s + 1]); p.y = pk2(x[8 * s + 2], x[8 * s + 3]); p.z = pk2(x[8 * s + 4], x[8 * s + 5]); p.w = pk2(x[8 * s + 6], x[8 * s + 7]);
    return __builtin_bit_cast(bf16x8, p);
}
DI s16x4 tr_read(const LAS unsigned char* p) { return __builtin_amdgcn_ds_read_tr16_b64_v4i16((LAS s16x4*)p); }
DI bf16x8 cat4(s16x4 lo, s16x4 hi) { return __builtin_shufflevector(lo, hi, 0, 1, 2, 3, 4, 5, 6, 7); }

#define XB_TMO      128
#define XB_XCNT(j)  (256  + 64 * (j))
#define XB_XSUB(j)  (1280 + 64 * (j))
#define XB_XGEN(j)  (2304 + 64 * (j))
#define XB_TOP      3328
#define XB_TOPGEN   3392
#define XCD_BAR_WORDS 3456
#define XB_SPIN_CAP (1u << 22)
DI unsigned xb_ld(unsigned* p)              { return __hip_atomic_load(p, __ATOMIC_RELAXED, __HIP_MEMORY_SCOPE_AGENT); }
DI unsigned xb_add(unsigned* p, unsigned v) { return __hip_atomic_fetch_add(p, v, __ATOMIC_RELAXED, __HIP_MEMORY_SCOPE_AGENT); }
DI unsigned xb_xcc_id() { return (unsigned)__builtin_amdgcn_s_getreg((3 << 11) | 20) & 0xFu; }
#define XB_SPIN(cond, bar) do { unsigned _sp = 0; while (cond) { __builtin_amdgcn_s_sleep(1); \
    if ((++_sp & 255u) == 0u) { if (xb_ld(&(bar)[XB_TMO])) break; if (_sp > XB_SPIN_CAP) { atomicAdd(&(bar)[XB_TMO], 1u); break; } } } } while (0)
struct XcdBarrier { unsigned* bar; unsigned x; volatile LAS unsigned* st; };
DI XcdBarrier xcd_barrier_post(unsigned* bar, volatile LAS unsigned* st, bool t0) {
    XcdBarrier b; b.bar = bar; b.x = xb_xcc_id(); b.st = st;
    if (t0) (void)xb_add(&bar[XB_XCNT(b.x)], 1u);
    return b;
}
DI void xcd_barrier_complete(unsigned* bar, unsigned x, unsigned& nloc, unsigned& nx) {
    const unsigned G = gridDim.x * gridDim.y * gridDim.z;
    unsigned sum, cnt, mine, sp = 0u;
    for (;;) {
        sum = 0u; cnt = 0u; mine = 0u;
#pragma unroll
        for (unsigned j = 0; j < 16; ++j) { const unsigned c = xb_ld(&bar[XB_XCNT(j)]); sum += c; cnt += (c > 0u) ? 1u : 0u; mine = (j == x) ? c : mine; }
        if (sum == G) break;
        __builtin_amdgcn_s_sleep(1);
        if ((++sp & 255u) == 0u) { if (xb_ld(&bar[XB_TMO])) break; if (sp > XB_SPIN_CAP) { atomicAdd(&bar[XB_TMO], 1u); break; } }
    }
    nloc = mine > 0u ? mine : 1u; nx = cnt > 0u ? cnt : 1u;
}
DI void xcd_barrier(const XcdBarrier& b, bool t0) {
    asm volatile("s_waitcnt vmcnt(0)" ::: "memory");
    __syncthreads();
    if (t0) {
        unsigned* bar = b.bar;
        __builtin_amdgcn_s_waitcnt(0);
        unsigned nloc = b.st[0], nx = b.st[1];
        if (nloc == 0u) { xcd_barrier_complete(bar, b.x, nloc, nx); b.st[0] = nloc; b.st[1] = nx; }
        const unsigned old = xb_add(&bar[XB_XSUB(b.x)], 1u);
        const unsigned gen = old / nloc;
        if (old + 1u == (gen + 1u) * nloc) {
            __builtin_amdgcn_fence(__ATOMIC_RELEASE, "agent");
            asm volatile("s_waitcnt vmcnt(0)" ::: "memory");
            const unsigned og = xb_add(&bar[XB_TOP], 1u);
            const unsigned tg = og / nx;
            if (og + 1u == (tg + 1u) * nx) xb_add(&bar[XB_TOPGEN], 1u);
            else XB_SPIN(xb_ld(&bar[XB_TOPGEN]) == tg, bar);
            __builtin_amdgcn_fence(__ATOMIC_ACQUIRE, "agent");
            xb_add(&bar[XB_XGEN(b.x)], 1u);
            asm volatile("s_waitcnt vmcnt(0)" ::: "memory");
        } else {
            XB_SPIN(xb_ld(&bar[XB_XGEN(b.x)]) == gen, bar);
            __builtin_amdgcn_fence(__ATOMIC_ACQUIRE, "agent");
            asm volatile("s_waitcnt vmcnt(0)" ::: "memory");
        }
    }
    __syncthreads();
}

namespace pg8 {
constexpr int BM = 256, BK = 64, HALF = 128, HTB = HALF * BK * 2, STAGE_BYTES = 8 * HTB, NXCD = 8, WGM = 8;
DI int lds_byte(int r, int c) { const int st = (r >> 4) * 2 + (c >> 5), rr = r & 15, cc = c & 31, ob = rr * 64 + cc * 2; return st * 1024 + (ob ^ (((ob >> 9) & 1) << 5)); }
DI void stage_rc(int b, int& R, int& C) { const int st = b / 1024, sb = b % 1024, swz = sb ^ (((sb >> 9) & 1) << 5); R = (st >> 1) * 16 + swz / 64; C = (st & 1) * 32 + (swz % 64) / 2; }
DI int perm32(int rho) { const int n = rho >> 4, i = rho & 15; return 8 * (i >> 2) + 4 * n + (i & 3); }
struct Unit { int pm, pn; const char* a; const char* b; int e, r0, cnt; };

struct DenseOrder {
    int nM, nN, nwg, G, c; const char* A; const char* Bt; size_t tstep; int skipctx;
    DI void init(const bf16_t* A_, const bf16_t* Bt_, int M, int N, int K, int G_, int c_, int skipctx_ = 0) { skipctx = skipctx_; nM = skipctx ? (M / BM) / 17 * 16 : M / BM; nN = N / BM; nwg = nM * nN; G = G_; c = c_; A = (const char*)A_; Bt = (const char*)Bt_; tstep = (size_t)BM * K * 2; }
    DI bool next(int i, Unit& u) const {
        const long L = (long)i * G + c; if (L >= nwg) return false;
        int wgid = (int)L; { const int q = nwg / NXCD, r = nwg % NXCD, xcd = wgid % NXCD, off = wgid / NXCD; wgid = (xcd < r ? xcd * (q + 1) : r * (q + 1) + (xcd - r) * q) + off; }
        const int nig = WGM * nN, gid = wgid / nig, fm = gid * WGM, gsz = (nM - fm) < WGM ? (nM - fm) : WGM;
        u.pm = fm + ((wgid % nig) % gsz); if (skipctx) u.pm = (u.pm >> 4) * 17 + 1 + (u.pm & 15); u.pn = (wgid % nig) / gsz; u.a = A + (size_t)u.pm * tstep; u.b = Bt + (size_t)u.pn * tstep; u.e = 0; u.r0 = 0; u.cnt = 0; return true;
    }
    DI void aoff(const Unit&, int K, const int (&R)[2], const int (&C)[2], unsigned (&va)[2][2]) const {
#pragma unroll
        for (int h = 0; h < 2; ++h)
#pragma unroll
            for (int i = 0; i < 2; ++i) va[h][i] = (unsigned)((R[i] + HALF * h) * K + C[i]) * 2u;
    }
};

template <class Epi, class Sched, bool FP8 = false>
DI void gemm_phase(LAS unsigned char* lds, const int K, const Sched& S, const Epi& E, const int tid) {
    const int wid = __builtin_amdgcn_readfirstlane(tid >> 6), lane = tid & 63, wr = wid >> 2, wc = wid & 3, fr = lane & 15, fq = lane >> 4;
    const int nt = K / BK;
    int Rr[2], Cc[2]; unsigned vb[2][2];
#pragma unroll
    for (int i = 0; i < 2; ++i) { stage_rc(tid * 16 + i * 8192, Rr[i], Cc[i]); const int Rb = Epi::PERM ? ((Rr[i] & ~31) + perm32(Rr[i] & 31)) : Rr[i];
#pragma unroll
        for (int h = 0; h < 2; ++h) vb[h][i] = (unsigned)((Rb + HALF * h) * K + Cc[i]) * 2u; }
    const size_t kstep = (size_t)(BK * 2);
    const unsigned ldsw = (unsigned)wid * 1024u;
    const int aoff = lds_byte(wr * 64 + fr, fq * 8), boff = lds_byte(wc * 32 + fr, fq * 8);
#define PG8_SA(b, h) (((b) * 2 + (h)) * HTB)
#define PG8_SB(b, h) ((4 + (b) * 2 + (h)) * HTB)
#define PG8_STAGE(bufoff, gbase, voff) do { _Pragma("unroll") for (int _i = 0; _i < 2; ++_i) \
        __builtin_amdgcn_global_load_lds((const unsigned*)((const char*)(gbase) + (voff)[_i]), (LAS unsigned*)(lds + (bufoff) + ldsw + _i * 8192), 16, 0, 0); } while (0)
#define PG8_LDA(dst, b, h) do { _Pragma("unroll") for (int m = 0; m < 4; ++m) { const i32x4 l_ = *(const LAS i32x4*)(lds + PG8_SA(b, h) + aoff + m * 2048); const i32x4 h_ = *(const LAS i32x4*)(lds + PG8_SA(b, h) + aoff + m * 2048 + 1024); dst[m] = __builtin_shufflevector(l_, h_, 0, 1, 2, 3, 4, 5, 6, 7); } } while (0)
#define PG8_LDB(dst, b, h) do { _Pragma("unroll") for (int n = 0; n < 2; ++n) { const i32x4 l_ = *(const LAS i32x4*)(lds + PG8_SB(b, h) + boff + n * 2048); const i32x4 h_ = *(const LAS i32x4*)(lds + PG8_SB(b, h) + boff + n * 2048 + 1024); dst[n] = __builtin_shufflevector(l_, h_, 0, 1, 2, 3, 4, 5, 6, 7); } } while (0)
#define PG8_LO(v) __builtin_bit_cast(bf16x8, __builtin_shufflevector(v, v, 0, 1, 2, 3))
#define PG8_HI(v) __builtin_bit_cast(bf16x8, __builtin_shufflevector(v, v, 4, 5, 6, 7))
#define PG8_MMA(ai, bj, At, Bt) do { __builtin_amdgcn_s_setprio(1); _Pragma("unroll") for (int m = 0; m < 4; ++m) _Pragma("unroll") for (int n = 0; n < 2; ++n) { \
        if constexpr (FP8) asm volatile("v_mfma_scale_f32_16x16x128_f8f6f4 %0, %1, %2, %0, %3, %3 op_sel_hi:[0,0,0]" : "+v"(acc[ai][bj][m][n]) : "v"(Bt[n]), "v"(At[m]), "v"(fp8_unit_scale)); \
        else { acc[ai][bj][m][n] = __builtin_amdgcn_mfma_f32_16x16x32_bf16(PG8_LO(Bt[n]), PG8_LO(At[m]), acc[ai][bj][m][n], 0, 0, 0); \
               acc[ai][bj][m][n] = __builtin_amdgcn_mfma_f32_16x16x32_bf16(PG8_HI(Bt[n]), PG8_HI(At[m]), acc[ai][bj][m][n], 0, 0, 0); } } __builtin_amdgcn_s_setprio(0); } while (0)
#define PG8_WAIT_V(n) asm volatile("s_waitcnt vmcnt(" #n ")" ::: "memory")
#define PG8_WAIT_L(n) asm volatile("s_waitcnt lgkmcnt(" #n ")" ::: "memory")
#define PG8_BAR __builtin_amdgcn_s_barrier()
#define PG8_SCHED __builtin_amdgcn_sched_barrier(0)
    Unit cur, nxt; int ui = 0;
    if (!S.next(0, cur)) return;
    f32x4 acc[2][2][4][2];
#pragma unroll
    for (int a = 0; a < 2; ++a)
#pragma unroll
        for (int b = 0; b < 2; ++b)
#pragma unroll
            for (int m = 0; m < 4; ++m)
#pragma unroll
                for (int n = 0; n < 2; ++n) acc[a][b][m][n] = (f32x4){0.f, 0.f, 0.f, 0.f};
    i32x8 At[4], B0[2], B1[2];
    const int fp8_unit_scale = 0x7f7f7f7f;
    unsigned vac[2][2], van[2][2];
    S.aoff(cur, K, Rr, Cc, vac);
    const char* cA = cur.a; const char* cB = cur.b;
    PG8_STAGE(PG8_SB(0, 0), cB, vb[0]); PG8_STAGE(PG8_SB(0, 1), cB, vb[1]); PG8_STAGE(PG8_SA(0, 0), cA, vac[0]); PG8_STAGE(PG8_SA(0, 1), cA, vac[1]);
    if (wr == 1) PG8_BAR;
    PG8_WAIT_V(2); PG8_BAR;
    PG8_STAGE(PG8_SB(1, 0), cB + kstep, vb[0]); PG8_STAGE(PG8_SA(1, 0), cA + kstep, vac[0]); PG8_STAGE(PG8_SB(1, 1), cB + kstep, vb[1]);
    PG8_WAIT_V(6); PG8_BAR;
    for (;;) {
        const bool has_next = S.next(ui + 1, nxt);
        const char* nA = has_next ? nxt.a : cA; const char* nB = has_next ? nxt.b : cB;
        if (has_next) S.aoff(nxt, K, Rr, Cc, van);
        else {
#pragma unroll
            for (int h = 0; h < 2; ++h)
#pragma unroll
                for (int i = 0; i < 2; ++i) van[h][i] = vac[h][i]; }
#pragma nounroll
        for (int t = 0; t < nt; t += 2) {
            const bool last = (t == nt - 2);
            const char* a1 = cA + (size_t)(t + 1) * kstep;
            const char* a2 = last ? nA : cA + (size_t)(t + 2) * kstep; const char* b2 = last ? nB : cB + (size_t)(t + 2) * kstep;
            const char* a3 = a2 + kstep; const char* b3 = b2 + kstep;
            unsigned v2[2][2];
#pragma unroll
            for (int h = 0; h < 2; ++h)
#pragma unroll
                for (int i = 0; i < 2; ++i) v2[h][i] = last ? van[h][i] : vac[h][i];
            PG8_LDB(B0, 0, 0); PG8_LDB(B1, 0, 1); PG8_SCHED; PG8_LDA(At, 0, 0); PG8_STAGE(PG8_SA(1, 1), a1, vac[1]);
            PG8_WAIT_V(8); PG8_WAIT_L(0); PG8_BAR; PG8_MMA(0, 0, At, B0); PG8_MMA(0, 1, At, B1); PG8_BAR; PG8_SCHED;
            PG8_LDA(At, 0, 1); PG8_STAGE(PG8_SB(0, 0), b2, vb[0]); PG8_STAGE(PG8_SB(0, 1), b2, vb[1]); PG8_STAGE(PG8_SA(0, 0), a2, v2[0]);
            PG8_WAIT_V(8); PG8_WAIT_L(0); PG8_BAR; PG8_MMA(1, 0, At, B0); PG8_MMA(1, 1, At, B1); PG8_BAR; PG8_SCHED;
            PG8_LDB(B0, 1, 0); PG8_LDB(B1, 1, 1); PG8_SCHED; PG8_LDA(At, 1, 0); PG8_STAGE(PG8_SA(0, 1), a2, v2[1]);
            PG8_WAIT_V(8); PG8_WAIT_L(0); PG8_BAR; PG8_MMA(0, 0, At, B0); PG8_MMA(0, 1, At, B1); PG8_BAR; PG8_SCHED;
            PG8_LDA(At, 1, 1); PG8_STAGE(PG8_SB(1, 0), b3, vb[0]); PG8_STAGE(PG8_SB(1, 1), b3, vb[1]); PG8_STAGE(PG8_SA(1, 0), a3, v2[0]);
            PG8_WAIT_V(8); PG8_WAIT_L(0); PG8_BAR; PG8_MMA(1, 0, At, B0); PG8_MMA(1, 1, At, B1); PG8_BAR; PG8_SCHED;
        }
        if (wr == 0) PG8_BAR;
        if constexpr (FP8) asm volatile("s_nop 15\n\ts_nop 15\n\ts_nop 15" ::: "memory");
        E(acc, cur, wr, wc, fr, fq);
        if (!has_next) break;
#pragma unroll
        for (int a = 0; a < 2; ++a)
#pragma unroll
            for (int b = 0; b < 2; ++b)
#pragma unroll
                for (int m = 0; m < 4; ++m)
#pragma unroll
                    for (int n = 0; n < 2; ++n) acc[a][b][m][n] = (f32x4){0.f, 0.f, 0.f, 0.f};
        cur = nxt; cA = nA; cB = nB; ++ui;
#pragma unroll
        for (int h = 0; h < 2; ++h)
#pragma unroll
            for (int i = 0; i < 2; ++i) vac[h][i] = van[h][i];
        if (wr == 1) PG8_BAR;
    }
    PG8_WAIT_V(0);
    PG8_BAR;
#undef PG8_SA
#undef PG8_SB
#undef PG8_STAGE
#undef PG8_LDA
#undef PG8_LDB
#undef PG8_MMA
#undef PG8_WAIT_V
#undef PG8_WAIT_L
#undef PG8_BAR
#undef PG8_SCHED
}

struct EpiBf16 {
    static constexpr bool PERM = true;
    bf16_t* O; int ldc; int split_cols; size_t split_stride; int qtiles; float qs; float os;
    DI void operator()(const f32x4 (&acc)[2][2][4][2], const Unit& u, int wr, int wc, int fr, int fq) const {
        const int row0 = u.pm * BM + wr * 64 + fr; int colt = u.pn * BM; bf16_t* base = O;
        if (split_cols) { const int t = colt / split_cols; base += (size_t)t * split_stride; colt -= t * split_cols; }
        const int col0 = colt + wc * 32 + 8 * fq; const float sc = ((u.pn < qtiles) ? qs : 1.0f) * os;
#pragma unroll
        for (int ai = 0; ai < 2; ++ai)
#pragma unroll
            for (int m = 0; m < 4; ++m) { bf16_t* rowp = base + (size_t)(row0 + ai * HALF + m * 16) * ldc + col0;
#pragma unroll
                for (int bj = 0; bj < 2; ++bj) { const f32x4 v0 = acc[ai][bj][m][0] * sc, v1 = acc[ai][bj][m][1] * sc;
                    u32x4 w; w.x = pk2(v0[0], v0[1]); w.y = pk2(v0[2], v0[3]); w.z = pk2(v1[0], v1[1]); w.w = pk2(v1[2], v1[3]);
                    *(u32x4*)(rowp + bj * HALF) = w; } }
    }
};
struct EpiBf16Rope {
    static constexpr bool PERM = true;
    bf16_t* O; const float* rope; float os;
    DI void operator()(const f32x4 (&acc)[2][2][4][2], const Unit& u, int wr, int wc, int fr, int fq) const {
        const int row0 = u.pm * BM + wr * 64 + fr; const int col0 = u.pn * BM + wc * 32 + 8 * fq;
        const int jj = u.pm % 17; const bool dorope = (u.pn < 8) && (jj != 0);
        const float qs = ((u.pn < 4) ? 0.125f * 1.4426950408889634f : 1.0f) * os;
        const bool first = fq < 2; const int fbase = 8 * (fq & 1);
#pragma unroll
        for (int ai = 0; ai < 2; ++ai)
#pragma unroll
            for (int m = 0; m < 4; ++m) { bf16_t* rowp = O + (size_t)(row0 + ai * HALF + m * 16) * 3072 + col0;
                const int pos = (wc & 1) ? (16 * m + fr) : ((jj - 1) * 4 + 2 * ai + wr);
                const float* tb = rope + ((dorope ? pos : 0) * 16 + fbase) * 2;
                const f32x4 t0 = *(const f32x4*)(tb), t1 = *(const f32x4*)(tb + 4), t2 = *(const f32x4*)(tb + 8), t3 = *(const f32x4*)(tb + 12);
                const float cs[8] = {t0[0], t0[2], t1[0], t1[2], t2[0], t2[2], t3[0], t3[2]}, sn[8] = {t0[1], t0[3], t1[1], t1[3], t2[1], t2[3], t3[1], t3[3]};
#pragma unroll
                for (int bj = 0; bj < 2; ++bj) { f32x4 v0 = acc[ai][bj][m][0], v1 = acc[ai][bj][m][1];
                    if (dorope) {
                        float x[8] = {v0[0], v0[1], v0[2], v0[3], v1[0], v1[1], v1[2], v1[3]};
#pragma unroll
                        for (int e = 0; e < 8; ++e) { const float p = __shfl_xor(x[e], 32); x[e] = first ? (x[e] * cs[e] - p * sn[e]) : (x[e] * cs[e] + p * sn[e]); }
                        v0 = (f32x4){x[0], x[1], x[2], x[3]}; v1 = (f32x4){x[4], x[5], x[6], x[7]};
                    }
                    v0 = v0 * qs; v1 = v1 * qs;
                    u32x4 w; w.x = pk2(v0[0], v0[1]); w.y = pk2(v0[2], v0[3]); w.z = pk2(v1[0], v1[1]); w.w = pk2(v1[2], v1[3]);
                    *(u32x4*)(rowp + bj * HALF) = w; } }
    }
};
struct EpiMoE1 {
    static constexpr bool PERM = true;
    unsigned char* O;
    DI void operator()(const f32x4 (&acc)[2][2][4][2], const Unit& u, int wr, int wc, int fr, int fq) const {
        const int row0 = u.pm * BM + wr * 64 + fr; const int col0 = (u.pn * BM + wc * 32 + 8 * fq) >> 1;
        const float is = 1.0f / 32.0f;
#pragma unroll
        for (int ai = 0; ai < 2; ++ai)
#pragma unroll
            for (int m = 0; m < 4; ++m) { unsigned char* rowp = O + (size_t)(row0 + ai * HALF + m * 16) * MOE_H + col0;
#pragma unroll
                for (int bj = 0; bj < 2; ++bj) { const f32x4 a = acc[ai][bj][m][0] * is, b = acc[ai][bj][m][1] * (is * 8.0f);
                    *(unsigned*)(rowp + bj * (HALF / 2)) = pk4_fp8(silu_f(a[0]) * b[0], silu_f(a[1]) * b[1], silu_f(a[2]) * b[2], silu_f(a[3]) * b[3]); } }
    }
};
struct EpiMoE2 {
    static constexpr bool PERM = true;
    unsigned char* O;
    DI void operator()(const f32x4 (&acc)[2][2][4][2], const Unit& u, int wr, int wc, int fr, int fq) const {
        const int row0 = u.pm * BM + wr * 64 + fr; const int col0 = u.pn * BM + wc * 32 + 8 * fq;
        const float is = 16.0f / 256.0f;
#pragma unroll
        for (int ai = 0; ai < 2; ++ai)
#pragma unroll
            for (int m = 0; m < 4; ++m) { unsigned char* rowp = O + (size_t)(row0 + ai * HALF + m * 16) * D + col0;
#pragma unroll
                for (int bj = 0; bj < 2; ++bj) { const f32x4 v0 = acc[ai][bj][m][0] * is, v1 = acc[ai][bj][m][1] * is;
                    u32x2 w; w.x = pk4_fp8(v0[0], v0[1], v0[2], v0[3]); w.y = pk4_fp8(v1[0], v1[1], v1[2], v1[3]);
                    *(u32x2*)(rowp + bj * HALF) = w; } }
    }
};
struct EpiResid {
    static constexpr bool PERM = false;
    bf16_t* XS; const float* modv_gate; float os;
    DI void operator()(const f32x4 (&acc)[2][2][4][2], const Unit& u, int wr, int wc, int fr, int fq) const {
        const int row0 = u.pm * BM + wr * 64 + fr, col0 = u.pn * BM + wc * 32 + 4 * fq;
        const int bb = u.pm / 17, jj = u.pm - bb * 17; const int mr = (jj == 0) ? 8 : bb;
        const float* gp = modv_gate + (size_t)mr * 6144 + col0;
        f32x4 gv[2][2];
#pragma unroll
        for (int bj = 0; bj < 2; ++bj)
#pragma unroll
            for (int n = 0; n < 2; ++n) gv[bj][n] = *(const f32x4*)(gp + bj * HALF + n * 16) * os;
        u32x2 ro[2][4][2][2];
#pragma unroll
        for (int ai = 0; ai < 2; ++ai)
#pragma unroll
            for (int m = 0; m < 4; ++m) { const bf16_t* rowp = XS + (size_t)(row0 + ai * HALF + m * 16) * D + col0;
#pragma unroll
                for (int bj = 0; bj < 2; ++bj)
#pragma unroll
                    for (int n = 0; n < 2; ++n) ro[ai][m][bj][n] = *(const u32x2*)(rowp + bj * HALF + n * 16); }
        __builtin_amdgcn_sched_barrier(0);
#pragma unroll
        for (int ai = 0; ai < 2; ++ai)
#pragma unroll
            for (int m = 0; m < 4; ++m) { bf16_t* rowp = XS + (size_t)(row0 + ai * HALF + m * 16) * D + col0;
#pragma unroll
                for (int bj = 0; bj < 2; ++bj)
#pragma unroll
                    for (int n = 0; n < 2; ++n) { u32x2* p = (u32x2*)(rowp + bj * HALF + n * 16); const u32x2 o = ro[ai][m][bj][n]; const f32x4 a = acc[ai][bj][m][n], g = gv[bj][n];
                        u32x2 w; w.x = pk2(bflo(o.x) + g[0] * a[0], bfhi(o.x) + g[1] * a[1]); w.y = pk2(bflo(o.y) + g[2] * a[2], bfhi(o.y) + g[3] * a[3]); *p = w; } }
    }
};
}

struct Args { const float* in[33]; float* out; unsigned char* ws; int ph_lo, ph_hi; };
struct Frame {
    LAS unsigned char* lds;
    unsigned char* ws;
    const float* const* in;
    float* out;
    int tid, lane, wave, G, bid;
};
#define IN_X 0
#define IN_C 1
#define IN_CTX 2
#define IN_CCTX 3
#define IN_MODW 4
#define IN_MODB 5
#define IN_NORMG 6
#define IN_FINALG 7
#define IN_NAQKV 8
#define IN_NAO 9
#define IN_NARPB 10
#define IN_MLUP 11
#define IN_MLCONVW 12
#define IN_MLCONVB 13
#define IN_MLWQ 14
#define IN_MLWK 15
#define IN_MLWV 16
#define IN_MLWGATE 17
#define IN_MLBGATE 18
#define IN_MLGNW 19
#define IN_MLSKIP 20
#define IN_MLDOWN 21
#define IN_DAQKV 22
#define IN_DALAM 23
#define IN_DASUBLN 24
#define IN_DAO 25
#define IN_MOEWG 26
#define IN_MOEBG 27
#define IN_MOEWR 28
#define IN_MOEBR 29
#define IN_MOEW1 30
#define IN_MOEW3 31
#define IN_MOEW2 32

DI void transpose_item(const float* W, int ldw, int K, bf16_t* WT, int k0, int n0src, int n0dst, LAS float* scr, int lane) {
#pragma unroll
    for (int i = 0; i < 32; ++i) { const int kk = 2 * i + (lane >> 5); scr[kk * 33 + (lane & 31)] = W[(size_t)(k0 + kk) * ldw + n0src + (lane & 31)]; }
    asm volatile("s_waitcnt lgkmcnt(0)" ::: "memory");
    const int c = lane & 7;
#pragma unroll
    for (int j = 0; j < 4; ++j) { const int n = (lane >> 3) + 8 * j; const LAS float* s = scr + (8 * c) * 33 + n;
        u32x4 o; o.x = pk2(s[0 * 33], s[1 * 33]); o.y = pk2(s[2 * 33], s[3 * 33]); o.z = pk2(s[4 * 33], s[5 * 33]); o.w = pk2(s[6 * 33], s[7 * 33]);
        *(u32x4*)(WT + (size_t)(n0dst + n) * K + k0 + 8 * c) = o; }
    asm volatile("s_waitcnt lgkmcnt(0)" ::: "memory");
}
DI void convert_matrix(Frame& F, const float* W, int K, int N, bf16_t* WT, int gw0, int ngw, LAS float* scr) {
    const int nblk = N / 32, nitems = (K / 64) * nblk;
    for (int it = gw0; it < nitems; it += ngw) { const int kb = it / nblk, nb = it - kb * nblk; transpose_item(W, N, K, WT, kb * 64, nb * 32, nb * 32, scr, F.lane); }
}
template <class RowMap>
DI void transpose_item_fp8(const float* W, int ldw, int K, unsigned char* WT, int k0, int n0src, const RowMap& drow, LAS float* scr, int lane) {
#pragma unroll
    for (int i = 0; i < 32; ++i) { const int kk = 2 * i + (lane >> 5); scr[kk * 33 + (lane & 31)] = W[(size_t)(k0 + kk) * ldw + n0src + (lane & 31)] * 32.0f; }
    asm volatile("s_waitcnt lgkmcnt(0)" ::: "memory");
    const int n = lane >> 1, hf = lane & 1; const LAS float* sp = scr + (32 * hf) * 33 + n;
    u32x4 o0, o1;
    o0.x = pk4_fp8(sp[0 * 33], sp[1 * 33], sp[2 * 33], sp[3 * 33]); o0.y = pk4_fp8(sp[4 * 33], sp[5 * 33], sp[6 * 33], sp[7 * 33]);
    o0.z = pk4_fp8(sp[8 * 33], sp[9 * 33], sp[10 * 33], sp[11 * 33]); o0.w = pk4_fp8(sp[12 * 33], sp[13 * 33], sp[14 * 33], sp[15 * 33]);
    o1.x = pk4_fp8(sp[16 * 33], sp[17 * 33], sp[18 * 33], sp[19 * 33]); o1.y = pk4_fp8(sp[20 * 33], sp[21 * 33], sp[22 * 33], sp[23 * 33]);
    o1.z = pk4_fp8(sp[24 * 33], sp[25 * 33], sp[26 * 33], sp[27 * 33]); o1.w = pk4_fp8(sp[28 * 33], sp[29 * 33], sp[30 * 33], sp[31 * 33]);
    unsigned char* dp = WT + (size_t)drow(n0src + n) * K + k0 + 32 * hf;
    *(u32x4*)dp = o0; *(u32x4*)(dp + 16) = o1;
    asm volatile("s_waitcnt lgkmcnt(0)" ::: "memory");
}
DI void convert_matrix_fp8(Frame& F, const float* W, int K, int N, unsigned char* WT, int gw0, int ngw, LAS float* scr) {
    const int nblk = N / 32, nitems = (K / 64) * nblk;
    auto rm = [&](int col) -> int { return col; };
    for (int it = gw0; it < nitems; it += ngw) { const int kb = it / nblk, nb = it - kb * nblk; transpose_item_fp8(W, N, K, WT, kb * 64, nb * 32, rm, scr, F.lane); }
}
DI void convert_moe(Frame& F, int layer, int gw0, int ngw, LAS float* scr) {
    const float* w1 = F.in[IN_MOEW1] + (size_t)layer * NEXP * D * MOE_H;
    const float* w3 = F.in[IN_MOEW3] + (size_t)layer * NEXP * D * MOE_H;
    const float* w2 = F.in[IN_MOEW2] + (size_t)layer * NEXP * MOE_H * D;
    unsigned char* W13T = F.ws + WS_WMOE13; unsigned char* W2T = F.ws + WS_WMOE2;
    const int per_mat = 16 * 16, per_e13 = 2 * per_mat, per_e2 = 8 * 32, per_e = per_e13 + per_e2, nitems = NEXP * per_e;
    const int lane = F.lane;
    for (int it = gw0; it < nitems; it += ngw) {
        const int e = it / per_e; int r = it - e * per_e;
        if (r < per_e13) {
            const int which = r / per_mat; r -= which * per_mat; const int kb = r >> 4, nb = r & 15;
            const float* W = (which ? w3 : w1) + (size_t)e * D * MOE_H;
            auto rm = [&](int col) -> int { return 8 * (col >> 2) + (col & 3) + 4 * which; };
            transpose_item_fp8(W, MOE_H, D, W13T + (size_t)e * 1024 * D, kb * 64, nb * 32, rm, scr, lane);
        } else {
            r -= per_e13; const int kb = r >> 5, nb = r & 31;
            auto rm = [&](int col) -> int { return col; };
            transpose_item_fp8(w2 + (size_t)e * MOE_H * D, D, MOE_H, W2T + (size_t)e * D * MOE_H, kb * 64, nb * 32, rm, scr, lane);
        }
    }
}

DI void convert_moe_in_tail(Frame& F, int layer, int nwg) {
    const int rem = nwg % F.G;
    if (F.bid < rem) return;
    __syncthreads();
    LAS float* scr = (LAS float*)(F.lds + F.wave * 16384);
    convert_moe(F, layer, (F.bid - rem) * 8 + F.wave, (F.G - rem) * 8, scr);
}

template <class Fn>
DI void in_gemm_tail(Frame& F, int nwg, Fn fn) {
    const int rem = nwg % F.G;
    if (F.bid < rem) return;
    __syncthreads();
    fn((F.bid - rem) * 8 + F.wave, (F.G - rem) * 8, (LAS float*)(F.lds + F.wave * 16384));
}

DI void phase_prologue(Frame& F) {
#ifdef TLB_TOUCH
    {
        const int gt = F.bid * 512 + F.tid, NTT = F.G * 512; unsigned acc = 0u;
        const int idxs[9] = {IN_X, IN_MODW, IN_NAQKV, IN_MLUP, IN_MLDOWN, IN_DAQKV, IN_MOEW1, IN_MOEW3, IN_MOEW2};
        const size_t lens[9] = {(size_t)NB * SEQ * D, (size_t)4 * D * 6144, (size_t)2 * D * 3072, (size_t)D * 4096, (size_t)ML_INNER * D, (size_t)D * 3072, (size_t)4 * NEXP * D * MOE_H, (size_t)4 * NEXP * D * MOE_H, (size_t)4 * NEXP * MOE_H * D};
#pragma unroll
        for (int a = 0; a < 9; ++a) { const unsigned* p = (const unsigned*)F.in[idxs[a]]; const size_t npages = lens[a] / 1024;
            for (size_t pg = gt; pg < npages; pg += NTT) acc ^= __builtin_nontemporal_load(p + pg * 1024); }
        if (acc == 0x12345678u) ((unsigned*)(F.ws + WS_CTL))[3000] = acc;
    }
#endif
    LAS float* scr = (LAS float*)(F.lds + F.wave * 16384);
    const int gw = F.bid * 8 + F.wave, NGW = F.G * 8;
    convert_matrix_fp8(F, F.in[IN_NAQKV], D, 3072, F.ws + WS_WNAQKV, gw, NGW, scr);
    convert_matrix_fp8(F, F.in[IN_NAO], D, D, F.ws + WS_WNAO, gw, NGW, scr);
    {
        bf16_t* WrT = (bf16_t*)(F.ws + WS_MISC);
        const int gt = F.bid * 512 + F.tid, NT = F.G * 512;
        for (int i = gt; i < 4 * 48 * 1024; i += NT) {
            const int l = i / (48 * 1024), r = i - l * 48 * 1024, n = r >> 10, k = r & 1023; float v = 0.f;
            if (n < 4) v = F.in[IN_MOEWG][((size_t)l * D + k) * 4 + n]; else if (n < 36) v = F.in[IN_MOEWR][((size_t)l * D + k) * 32 + (n - 4)];
            WrT[i] = (bf16_t)(pk2(v, 0.f) & 0xffffu);
        }
        bf16_t* WGt = (bf16_t*)(F.ws + WS_MISC + 512 * 1024);
        const float* wq = F.in[IN_MLWQ]; const float* wk = F.in[IN_MLWK]; const float* wv = F.in[IN_MLWV]; const float* wg = F.in[IN_MLWGATE];
        for (int i = gt; i < 16 * 4096; i += NT) {
            const int n = i >> 12, k = i & 4095; float v = 0.f;
            if (k < 2048) { const int g = k >> 2, ii = k & 3;
                for (int o = 0; o < 4; ++o) v += wq[g * 16 + ii * 4 + o] * wg[(size_t)(4 * g + o) * 16 + n] + wk[g * 16 + ii * 4 + o] * wg[(size_t)(2048 + 4 * g + o) * 16 + n];
            } else { const int kk = k - 2048, g = kk >> 2, ii = kk & 3;
                for (int o = 0; o < 4; ++o) v += wv[g * 16 + ii * 4 + o] * wg[(size_t)(4096 + 4 * g + o) * 16 + n]; }
            WGt[i] = (bf16_t)(pk2(v, 0.f) & 0xffffu);
        }
        float* rope = (float*)(F.ws + WS_MISC + 768 * 1024);
        for (int i = gt; i < 64 * 16; i += NT) { const int pos = i >> 4, f = i & 15; const float fr = powf(10000.0f, -(float)(2 * f) / 32.0f); const float ang = (float)pos * fr;
            rope[2 * i] = cosf(ang); rope[2 * i + 1] = sinf(ang); }
    }
    {
        __syncthreads();
        LAS float* sc = (LAS float*)F.lds;
        LAS float* red = (LAS float*)(F.lds + 40960);
        for (int i = F.tid; i < 9 * 1024; i += 512) { const int r = i >> 10, k = i & 1023; const float v = (r < 8) ? F.in[IN_C][r * 1024 + k] : F.in[IN_CCTX][k]; sc[i] = silu_f(v); }
        __syncthreads();
        float* modv = (float*)(F.ws + WS_MODV);
        const int c4 = (F.tid & 31) * 4, ks = F.tid >> 5;
        for (int it = F.bid; it < 4 * 48; it += F.G) {
            const int l = it / 48, n0 = (it - l * 48) * 128;
            const float* W = F.in[IN_MODW] + (size_t)l * D * 6144 + n0 + c4;
            f32x4 a[9];
#pragma unroll
            for (int r = 0; r < 9; ++r) a[r] = f32x4{0.f, 0.f, 0.f, 0.f};
#pragma unroll 8
            for (int j = 0; j < 64; ++j) { const int k = j * 16 + ks; const f32x4 w = *(const f32x4*)(W + (size_t)k * 6144);
#pragma unroll
                for (int r = 0; r < 9; ++r) { const float sv = sc[r * 1024 + k]; a[r] += w * sv; } }
#pragma unroll
            for (int r = 0; r < 9; ++r) *(LAS f32x4*)(red + (ks * 9 + r) * 128 + c4) = a[r];
            __syncthreads();
            for (int i = F.tid; i < 9 * 128; i += 512) { const int r = i >> 7, c2 = i & 127; float sum = F.in[IN_MODB][l * 6144 + n0 + c2];
#pragma unroll
                for (int g = 0; g < 16; ++g) sum += red[(g * 9 + r) * 128 + c2];
                modv[((size_t)l * 9 + r) * 6144 + n0 + c2] = sum; }
            __syncthreads();
        }
    }
}

struct RouteRec { int e0, e1, r0, r1; float w0, w1; int p0, p1; };
#if SCAN_PROBE || PREP_PROBE || (PHASE_PROBE >= 0)
#define PROBE_SCALE (1.0f + sqrtf(((const float*)(F.ws + WS_CTL))[2048]))
#else
#define PROBE_SCALE 1.0f
#endif
template <int MODE>
DI void phase_modulate(Frame& F, int layer) {
    const int gw = F.bid * 8 + F.wave, NGW = F.G * 8, lane = F.lane;
    const int RPW = (T + NGW - 1) / NGW;
    const int r_begin = gw * RPW, r_end = (r_begin + RPW < T) ? r_begin + RPW : T;
    bf16_t* XS = (bf16_t*)(F.ws + WS_XS); bf16_t* HB = (bf16_t*)(F.ws + WS_HB);
    const float* modv = (const float*)(F.ws + WS_MODV);
    const RouteRec* route = (const RouteRec*)(F.ws + WS_ROUTE);
    const unsigned char* Y = F.ws + R_Y;
    const int sh_off = (MODE == 2) ? 3072 : 0, sc_off = sh_off + 1024;
    const float* ng = F.in[IN_NORMG] + (size_t)layer * 2 * D + ((MODE == 2) ? D : 0);
    constexpr bool COMB = (MODE == 1 || MODE == 3);
    constexpr int NR = COMB ? 4 : 4;
    int tb = 0;
    if (COMB) {
        const int pl = (MODE == 3) ? 3 : layer - 1;
        unsigned* cntp = (unsigned*)(F.ws + WS_CTL) + CW_CNT + pl * 32 * 64;
        int c = (lane < 32) ? (int)__hip_atomic_load(cntp + lane * 64, __ATOMIC_RELAXED, __HIP_MEMORY_SCOPE_AGENT) : 0;
        int ntl = (c + 255) >> 8, incl = ntl;
#pragma unroll
        for (int o = 1; o < 32; o <<= 1) { const int t = __shfl_up(incl, o); if ((lane & 31) >= o) incl += t; }
        tb = incl - ntl;
    }
    const float* gnp = (MODE == 3) ? F.in[IN_FINALG] : ng;
    f32x4 gnc[4], shc[4], scc[4]; int mr_c = -1;
#pragma unroll
    for (int j = 0; j < 4; ++j) { gnc[j] = *(const f32x4*)(gnp + 4 * lane + 256 * j); shc[j] = (f32x4){0.f, 0.f, 0.f, 0.f}; scc[j] = shc[j]; }
    for (int rb = r_begin; rb < r_end; rb += NR) {
        f32x4 v[NR][4]; int rr[NR]; bool ok[NR];
#pragma unroll
        for (int k = 0; k < NR; ++k) { ok[k] = rb + k < r_end; rr[k] = ok[k] ? rb + k : r_end - 1; if (MODE == 3 && rr[k] % TPB < NCTX) { ok[k] = false; rr[k] = (rr[k] / TPB) * TPB + NCTX; } }
#pragma unroll
        for (int k = 0; k < NR; ++k) {
            const int r = rr[k]; const int b = r / TPB, t = r - b * TPB; const bool isctx = t < NCTX;
            if (MODE == 0) { const float* src = isctx ? F.in[IN_CTX] + ((size_t)b * NCTX + t) * D : F.in[IN_X] + ((size_t)b * SEQ + (t - NCTX)) * D;
#pragma unroll
                for (int j = 0; j < 4; ++j) v[k][j] = *(const f32x4*)(src + 4 * lane + 256 * j);
            } else {
#pragma unroll
                for (int j = 0; j < 4; ++j) { const u32x2 u = *(const u32x2*)(XS + (size_t)r * D + 4 * lane + 256 * j); v[k][j] = (f32x4){bflo(u.x), bfhi(u.x), bflo(u.y), bfhi(u.y)}; }
            }
        }
        if (COMB) {
            const int pl = (MODE == 3) ? 3 : layer - 1;
            unsigned y0[NR][4], y1[NR][4]; float w0[NR], w1[NR];
#pragma unroll
            for (int k = 0; k < NR; ++k) {
                const RouteRec rec = route[rr[k]];
                const int s0 = __shfl(tb, rec.e0) * 256 + rec.r0, s1 = __shfl(tb, rec.e1) * 256 + rec.r1; w0[k] = rec.w0 * (1.0f / 16.0f); w1[k] = rec.w1 * (1.0f / 16.0f);
#pragma unroll
                for (int j = 0; j < 4; ++j) { y0[k][j] = *(const unsigned*)(Y + (size_t)s0 * D + 4 * lane + 256 * j); y1[k][j] = *(const unsigned*)(Y + (size_t)s1 * D + 4 * lane + 256 * j); }
            }
#pragma unroll
            for (int k = 0; k < NR; ++k) {
                const int r = rr[k]; const int b = r / TPB, t = r - b * TPB; const int mr = (t < NCTX) ? 8 : b;
                const float* g2 = modv + ((size_t)pl * 9 + mr) * 6144 + 5120;
#pragma unroll
                for (int j = 0; j < 4; ++j) {
                    const f32x4 gg = *(const f32x4*)(g2 + 4 * lane + 256 * j);
                    const f32x2 a01 = __builtin_amdgcn_cvt_pk_f32_fp8((int)y0[k][j], false), a23 = __builtin_amdgcn_cvt_pk_f32_fp8((int)y0[k][j], true);
                    const f32x2 b01 = __builtin_amdgcn_cvt_pk_f32_fp8((int)y1[k][j], false), b23 = __builtin_amdgcn_cvt_pk_f32_fp8((int)y1[k][j], true);
                    f32x4 yy; yy[0] = w0[k] * a01[0] + w1[k] * b01[0]; yy[1] = w0[k] * a01[1] + w1[k] * b01[1]; yy[2] = w0[k] * a23[0] + w1[k] * b23[0]; yy[3] = w0[k] * a23[1] + w1[k] * b23[1];
                    v[k][j] = v[k][j] + gg * yy;
                }
            }
        }
#pragma unroll
        for (int k = 0; k < NR; ++k) {
            if (!ok[k]) continue;
            const int r = rr[k]; const int b = r / TPB, t = r - b * TPB; const bool isctx = t < NCTX; const int mr = isctx ? 8 : b;
            if (MODE == 0 || MODE == 1) {
#pragma unroll
                for (int j = 0; j < 4; ++j) { u32x2 w; w.x = pk2(v[k][j][0], v[k][j][1]); w.y = pk2(v[k][j][2], v[k][j][3]); *(u32x2*)(XS + (size_t)r * D + 4 * lane + 256 * j) = w; }
            }
            float ss = 0.f;
#pragma unroll
            for (int j = 0; j < 4; ++j) ss += (v[k][j][0] * v[k][j][0] + v[k][j][1] * v[k][j][1]) + (v[k][j][2] * v[k][j][2] + v[k][j][3] * v[k][j][3]);
            const float rstd = 1.0f / sqrtf(wave_sum(ss) * (1.0f / D) + EPS);
            if (MODE == 3) {
                if (!isctx) { float* o = F.out + ((size_t)b * SEQ + (t - NCTX)) * D;
#pragma unroll
                    for (int j = 0; j < 4; ++j) *(f32x4*)(o + 4 * lane + 256 * j) = v[k][j] * rstd * gnc[j] * PROBE_SCALE; }
            } else {
                if (__builtin_amdgcn_readfirstlane(mr) != mr_c) { mr_c = __builtin_amdgcn_readfirstlane(mr); const float* mv = modv + ((size_t)layer * 9 + mr_c) * 6144;
#pragma unroll
                    for (int j = 0; j < 4; ++j) { shc[j] = *(const f32x4*)(mv + sh_off + 4 * lane + 256 * j); scc[j] = *(const f32x4*)(mv + sc_off + 4 * lane + 256 * j) + 1.0f; } }
#pragma unroll
                for (int j = 0; j < 4; ++j) {
                    const f32x4 o = v[k][j] * rstd * gnc[j] * scc[j] + shc[j];
                    if (MODE == 2 || (MODE == 1 && layer == 1)) { u32x2 w; w.x = pk2(o[0], o[1]); w.y = pk2(o[2], o[3]); *(u32x2*)(HB + (size_t)r * D + 4 * lane + 256 * j) = w; }
                    if (!(MODE == 1 && layer == 1)) *(unsigned*)(F.ws + WS_HB8 + (size_t)r * D + 4 * lane + 256 * j) = pk4_fp8(o[0], o[1], o[2], o[3]);
                }
            }
        }
    }
    if (MODE == 2) {
        asm volatile("s_waitcnt vmcnt(0)" ::: "memory");
        const bf16_t* WrT = (const bf16_t*)(F.ws + WS_MISC) + (size_t)layer * 48 * 1024;
        LAS float* lg = (LAS float*)(F.lds + F.wave * 3072);
        unsigned* cntp = (unsigned*)(F.ws + WS_CTL) + CW_CNT + layer * 32 * 64;
        RouteRec* routew = (RouteRec*)(F.ws + WS_ROUTE);
        int* idx = (int*)(F.ws + WS_ROUTE + 2 * MiB);
        const float* bg = F.in[IN_MOEBG] + layer * 4; const float* br = F.in[IN_MOEBR] + layer * 32;
        for (int t0 = r_begin; t0 < r_end; t0 += 16) {
            int ar = t0 + (lane & 15); if (ar >= r_end) ar = r_end - 1;
            const bf16_t* ap = HB + (size_t)ar * D + 8 * (lane >> 4);
            const bf16_t* bp = WrT + (size_t)(lane & 15) * D + 8 * (lane >> 4);
            f32x4 a0 = {0.f, 0.f, 0.f, 0.f}, a1 = a0, a2 = a0;
#pragma unroll 8
            for (int ks = 0; ks < 32; ++ks) {
                const bf16x8 af = *(const bf16x8*)(ap + 32 * ks);
                a0 = mfma16(af, *(const bf16x8*)(bp + 32 * ks), a0);
                a1 = mfma16(af, *(const bf16x8*)(bp + 16 * D + 32 * ks), a1);
                a2 = mfma16(af, *(const bf16x8*)(bp + 32 * D + 32 * ks), a2);
            }
#pragma unroll
            for (int i = 0; i < 4; ++i) { const int row = (lane >> 4) * 4 + i; lg[row * 48 + (lane & 15)] = a0[i]; lg[row * 48 + 16 + (lane & 15)] = a1[i]; lg[row * 48 + 32 + (lane & 15)] = a2[i]; }
            asm volatile("s_waitcnt lgkmcnt(0)" ::: "memory");
            const int row = t0 + lane;
            if (lane < 16 && row < r_end) {
                const LAS float* L = lg + lane * 48;
                float gl[4]; int gi = 0; float gm = -3.0e38f;
#pragma unroll
                for (int k = 0; k < 4; ++k) { gl[k] = L[k] + bg[k]; if (gl[k] > gm) { gm = gl[k]; gi = k; } }
                float gs = 0.f;
#pragma unroll
                for (int k = 0; k < 4; ++k) gs += fast_exp(gl[k] - gm);
                const float gval = 1.0f / gs;
                float el[8]; float em = -3.0e38f; int i0 = 0;
#pragma unroll
                for (int k = 0; k < 8; ++k) { el[k] = L[4 + 8 * gi + k] + br[8 * gi + k]; if (el[k] > em) { em = el[k]; i0 = k; } }
                float em2 = -3.0e38f; int i1 = 0;
#pragma unroll
                for (int k = 0; k < 8; ++k) if (k != i0 && el[k] > em2) { em2 = el[k]; i1 = k; }
                const float p0 = 1.0f, p1 = fast_exp(em2 - em);
                const float inv = 1.0f / (p0 + p1);
                RouteRec rec; rec.e0 = gi * 8 + i0; rec.e1 = gi * 8 + i1; rec.w0 = gval * p0 * inv; rec.w1 = gval * p1 * inv;
                rec.r0 = (int)__hip_atomic_fetch_add(cntp + rec.e0 * 64, 1u, __ATOMIC_RELAXED, __HIP_MEMORY_SCOPE_AGENT);
                rec.r1 = (int)__hip_atomic_fetch_add(cntp + rec.e1 * 64, 1u, __ATOMIC_RELAXED, __HIP_MEMORY_SCOPE_AGENT);
                rec.p0 = 0; rec.p1 = 0;
                routew[row] = rec;
                idx[(size_t)rec.e0 * T + rec.r0] = row; idx[(size_t)rec.e1 * T + rec.r1] = row;
            }
            asm volatile("s_waitcnt lgkmcnt(0)" ::: "memory");
        }
    }
}

DI void phase_norm2_router(Frame& F, int layer) {
    const int lane = F.lane, w = F.wave, tid = F.tid;
    const int RPB = (T + F.G - 1) / F.G;
    const int row_beg = F.bid * RPB, row_end = (row_beg + RPB < T) ? row_beg + RPB : T;
    const bf16_t* XS = (const bf16_t*)(F.ws + WS_XS);
    const float* modv = (const float*)(F.ws + WS_MODV);
    const float* ng = F.in[IN_NORMG] + (size_t)layer * 2 * D + D;
    LAS unsigned char* XT = F.lds;
    LAS float* part = (LAS float*)(F.lds + 32768);
    LAS float* lg = (LAS float*)(F.lds + 32768 + 24576);
    LAS u32x4* lrec = (LAS u32x4*)(F.lds + 61440);
    LAS unsigned* lcnt = (LAS unsigned*)(F.lds + 61440 + 32768);
    const bf16_t* WrT = (const bf16_t*)(F.ws + WS_MISC) + (size_t)layer * 48 * 1024;
    unsigned* cntp = (unsigned*)(F.ws + WS_CTL) + CW_CNT + layer * 32 * 64;
    RouteRec* routew = (RouteRec*)(F.ws + WS_ROUTE);
    int* idx = (int*)(F.ws + WS_ROUTE + 2 * MiB);
    const float* bg = F.in[IN_MOEBG] + layer * 4; const float* br = F.in[IN_MOEBR] + layer * 32;
    bf16x8 bwr[3][4];
#pragma unroll
    for (int nt = 0; nt < 3; ++nt)
#pragma unroll
        for (int ks = 0; ks < 4; ++ks) bwr[nt][ks] = *(const bf16x8*)(WrT + (size_t)(16 * nt + (lane & 15)) * D + 128 * w + 32 * ks + 8 * (lane >> 4));
    f32x4 gn[4];
#pragma unroll
    for (int j = 0; j < 4; ++j) gn[j] = *(const f32x4*)(ng + 4 * lane + 256 * j);
    f32x4 shc[4], scc[4]; int mr_c = -1;
#pragma unroll
    for (int j = 0; j < 4; ++j) { shc[j] = (f32x4){0.f, 0.f, 0.f, 0.f}; scc[j] = shc[j]; }
    u32x2 nx[2][4];
    auto load_rows = [&](int r0) {
#pragma unroll
        for (int k = 0; k < 2; ++k) { const int r = min(r0 + 2 * w + k, row_end - 1);
#pragma unroll
            for (int j = 0; j < 4; ++j) nx[k][j] = *(const u32x2*)(XS + (size_t)r * D + 4 * lane + 256 * j); }
    };
    load_rows(row_beg);
    if (tid < 64) lcnt[tid] = 0u;
    for (int r0 = row_beg; r0 < row_end; r0 += 16) {
        u32x2 cur[2][4];
#pragma unroll
        for (int k = 0; k < 2; ++k)
#pragma unroll
            for (int j = 0; j < 4; ++j) cur[k][j] = nx[k][j];
        if (r0 + 16 < row_end) load_rows(r0 + 16);
#pragma unroll
        for (int k = 0; k < 2; ++k) {
            const int rl = 2 * w + k, r = r0 + rl; const bool ok = r < row_end; const int rc = ok ? r : row_end - 1;
            const int b = rc / TPB, t = rc - b * TPB; const int mr = (t < NCTX) ? 8 : b;
            f32x4 v[4]; float ss = 0.f;
#pragma unroll
            for (int j = 0; j < 4; ++j) { v[j] = (f32x4){bflo(cur[k][j].x), bfhi(cur[k][j].x), bflo(cur[k][j].y), bfhi(cur[k][j].y)}; ss += (v[j][0] * v[j][0] + v[j][1] * v[j][1]) + (v[j][2] * v[j][2] + v[j][3] * v[j][3]); }
            const float rstd = 1.0f / sqrtf(wave_sum(ss) * (1.0f / D) + EPS);
            if (__builtin_amdgcn_readfirstlane(mr) != mr_c) { mr_c = __builtin_amdgcn_readfirstlane(mr); const float* mv = modv + ((size_t)layer * 9 + mr_c) * 6144;
#pragma unroll
                for (int j = 0; j < 4; ++j) { shc[j] = *(const f32x4*)(mv + 3072 + 4 * lane + 256 * j); scc[j] = *(const f32x4*)(mv + 4096 + 4 * lane + 256 * j) + 1.0f; } }
#pragma unroll
            for (int j = 0; j < 4; ++j) {
                const f32x4 o = v[j] * rstd * gn[j] * scc[j] + shc[j];
                if (ok) *(unsigned*)(F.ws + WS_HB8 + (size_t)r * D + 4 * lane + 256 * j) = pk4_fp8(o[0], o[1], o[2], o[3]);
                u32x2 pw; pw.x = pk2(o[0], o[1]); pw.y = pk2(o[2], o[3]);
                const int chunk = (lane >> 1) + 32 * j;
                *(LAS u32x2*)(XT + rl * 2048 + ((chunk ^ rl) << 4) + (lane & 1) * 8) = pw;
            }
        }
        __syncthreads();
        {
            const int rr = lane & 15; const LAS unsigned char* abase = XT + rr * 2048;
            f32x4 a0 = {0.f, 0.f, 0.f, 0.f}, a1 = a0, a2 = a0;
#pragma unroll
            for (int ks = 0; ks < 4; ++ks) { const int c = 16 * w + 4 * ks + (lane >> 4); const bf16x8 af = *(const LAS bf16x8*)(abase + ((c ^ rr) << 4));
                a0 = mfma16(af, bwr[0][ks], a0); a1 = mfma16(af, bwr[1][ks], a1); a2 = mfma16(af, bwr[2][ks], a2); }
            LAS float* pp = part + w * 768;
#pragma unroll
            for (int i = 0; i < 4; ++i) { const int row = (lane >> 4) * 4 + i; pp[row * 48 + (lane & 15)] = a0[i]; pp[row * 48 + 16 + (lane & 15)] = a1[i]; pp[row * 48 + 32 + (lane & 15)] = a2[i]; }
        }
        __syncthreads();
        for (int vI = tid; vI < 768; vI += 512) { float s = 0.f;
#pragma unroll
            for (int ww = 0; ww < 8; ++ww) s += part[ww * 768 + vI];
            lg[vI] = s; }
        __syncthreads();
        if (tid < 16 && r0 + tid < row_end && (layer == 3 && (r0 + tid) % TPB < NCTX)) lrec[2 * (r0 + tid - row_beg)] = (u32x4){0xffffffffu, 0u, 0u, 0u};
        else if (tid < 16 && r0 + tid < row_end) {
            const int row = r0 + tid;
            const LAS float* Lr = lg + tid * 48;
            float gl[4]; int gi = 0; float gm = -3.0e38f;
#pragma unroll
            for (int k = 0; k < 4; ++k) { gl[k] = Lr[k] + bg[k]; if (gl[k] > gm) { gm = gl[k]; gi = k; } }
            float gs = 0.f;
#pragma unroll
            for (int k = 0; k < 4; ++k) gs += fast_exp(gl[k] - gm);
            const float gval = 1.0f / gs;
            float el[8]; float em = -3.0e38f; int i0 = 0;
#pragma unroll
            for (int k = 0; k < 8; ++k) { el[k] = Lr[4 + 8 * gi + k] + br[8 * gi + k]; if (el[k] > em) { em = el[k]; i0 = k; } }
            float em2 = -3.0e38f; int i1 = 0;
#pragma unroll
            for (int k = 0; k < 8; ++k) if (k != i0 && el[k] > em2) { em2 = el[k]; i1 = k; }
            const float p1 = fast_exp(em2 - em);
            const float inv = 1.0f / (1.0f + p1);
            RouteRec rec; rec.e0 = gi * 8 + i0; rec.e1 = gi * 8 + i1; rec.w0 = gval * inv; rec.w1 = gval * p1 * inv;
            rec.r0 = (int)__hip_atomic_fetch_add(lcnt + rec.e0, 1u, __ATOMIC_RELAXED, __HIP_MEMORY_SCOPE_WORKGROUP);
            rec.r1 = (int)__hip_atomic_fetch_add(lcnt + rec.e1, 1u, __ATOMIC_RELAXED, __HIP_MEMORY_SCOPE_WORKGROUP);
            rec.p0 = 0; rec.p1 = 0;
            lrec[2 * (row - row_beg)] = (u32x4){(unsigned)rec.e0, (unsigned)rec.e1, (unsigned)rec.r0, (unsigned)rec.r1}; lrec[2 * (row - row_beg) + 1] = (u32x4){__float_as_uint(rec.w0), __float_as_uint(rec.w1), 0u, 0u};
        }
    }
    __syncthreads();
    if (tid < 32) { const unsigned c = lcnt[tid]; lcnt[32 + tid] = c ? __hip_atomic_fetch_add(cntp + tid * 64, c, __ATOMIC_RELAXED, __HIP_MEMORY_SCOPE_AGENT) : 0u; }
    __syncthreads();
    for (int i = tid; i < row_end - row_beg; i += 512) {
        const u32x4 ra = lrec[2 * i], rb = lrec[2 * i + 1];
        if ((int)ra.x < 0) continue;
        RouteRec rec; rec.e0 = (int)ra.x; rec.e1 = (int)ra.y; rec.r0 = (int)ra.z; rec.r1 = (int)ra.w; rec.w0 = __uint_as_float(rb.x); rec.w1 = __uint_as_float(rb.y); rec.p0 = 0; rec.p1 = 0;
        rec.r0 += (int)lcnt[32 + rec.e0]; rec.r1 += (int)lcnt[32 + rec.e1];
        const int row = row_beg + i;
        routew[row] = rec;
        idx[(size_t)rec.e0 * T + rec.r0] = row; idx[(size_t)rec.e1 * T + rec.r1] = row;
    }
}

struct MoeOrder {
    int G, c, ntiles, K; const char* A; const char* Bt; size_t bstride; const int* idx; bool gather; bool xcdmap;
    const LAS int* tbl;
    DI bool next(int i, pg8::Unit& u) const {
        int rt, pn, e = 0;
        if (xcdmap) {
            const int x = c & 7, j = c >> 3; const int U = j + 32 * i; int tt = U >> 2; pn = U & 3; bool found = false;
            for (int k = 0; k < 4; ++k) { const int ee = x + 8 * k; const int n = tbl[ee + 1] - tbl[ee]; if (!found) { if (tt < n) { e = ee; found = true; } else tt -= n; } }
            if (!found) return false;
            rt = tbl[e] + tt;
        } else {
        const long L = (long)i * G + c; if (L >= (long)ntiles * 4) return false;
        rt = (int)(L >> 2); pn = (int)(L & 3);
        for (int k = 1; k < 32; ++k) if (tbl[k] <= rt) e = k;
        }
        u.pm = rt; u.pn = pn; u.e = e; u.r0 = (rt - tbl[e]) * 256; u.cnt = tbl[64 + e];
        u.a = gather ? A : A + (size_t)rt * 256 * K * 2;
        u.b = Bt + (size_t)e * bstride + (size_t)pn * 256 * K * 2;
        return true;
    }
    DI void aoff(const pg8::Unit& u, int K_, const int (&R)[2], const int (&C)[2], unsigned (&va)[2][2]) const {
#pragma unroll
        for (int h = 0; h < 2; ++h)
#pragma unroll
            for (int i = 0; i < 2; ++i) {
                if (gather) { int rr = u.r0 + R[i] + 128 * h; if (rr >= u.cnt) rr = 0; const int tok = idx[(size_t)u.e * T + rr]; va[h][i] = (unsigned)(tok * K_ + C[i]) * 2u; }
                else va[h][i] = (unsigned)((R[i] + 128 * h) * K_ + C[i]) * 2u;
            }
    }
};
DI int moe_build_table(Frame& F, int layer, LAS int* tbl) {
    __syncthreads();
    if (F.tid < 64) {
        unsigned* cntp = (unsigned*)(F.ws + WS_CTL) + CW_CNT + layer * 32 * 64;
        const int lane = F.tid;
        int c = (lane < 32) ? (int)__hip_atomic_load(cntp + lane * 64, __ATOMIC_RELAXED, __HIP_MEMORY_SCOPE_AGENT) : 0;
        int ntl = (c + 255) >> 8, incl = ntl;
#pragma unroll
        for (int o = 1; o < 32; o <<= 1) { const int t = __shfl_up(incl, o); if ((lane & 31) >= o) incl += t; }
        if (lane < 32) { tbl[lane] = incl - ntl; tbl[64 + lane] = c; }
        if (lane == 31) tbl[32] = incl;
    }
    __syncthreads();
    return tbl[32];
}

DI bool moe_xcd_balanced(const Frame& F, const LAS int* tbl, int ntl) {
    if (F.G != 256) return false;
    int mx = 0;
    for (int x = 0; x < 8; ++x) { int sum = 0; for (int k = 0; k < 4; ++k) sum += tbl[x + 8 * k + 1] - tbl[x + 8 * k]; mx = sum > mx ? sum : mx; }
    return mx * 8 <= ntl + (ntl >> 2) + 8;
}

template <int DV> struct FlashSt { f32x16 o[DV / 32]; float m, l; };
template <int DV, int KSTR, int VSTR, bool MASK, class SF>
DI void flash_subtile(const LAS unsigned char* kb, const LAS unsigned char* vb, const bf16x8 (&qf)[4], FlashSt<DV>& st, const float scale_l2e, const int lane, const SF& sfun) {
    const int r = lane & 31, h = lane >> 5;
    f32x16 s;
#pragma unroll
    for (int i = 0; i < 16; ++i) s[i] = 0.f;
#pragma unroll
    for (int ks = 0; ks < 4; ++ks) { const bf16x8 a = *(const LAS bf16x8*)(kb + r * KSTR + (16 * ks + 8 * h) * 2); s = mfma32(a, qf[ks], s); }
    float mx = -INFINITY;
#pragma unroll
    for (int i = 0; i < 16; ++i) { s[i] = s[i] * scale_l2e; if (MASK) s[i] += sfun(i); mx = fmaxf(mx, s[i]); }
    mx = fmaxf(mx, __shfl_xor(mx, 32));
    const float mnew = fmaxf(st.m, mx);
    const float muse = (mnew == -INFINITY) ? 0.f : mnew;
    const float alpha = fast_exp2(st.m - muse);
    float rs = 0.f;
#pragma unroll
    for (int i = 0; i < 16; ++i) { s[i] = fast_exp2(s[i] - muse); rs += s[i]; }
    rs += __shfl_xor(rs, 32);
    st.l = st.l * alpha + rs; st.m = mnew;
#pragma unroll
    for (int d = 0; d < DV / 32; ++d)
#pragma unroll
        for (int i = 0; i < 16; ++i) st.o[d][i] *= alpha;
    const bf16x8 p0 = pack_step(s, 0), p1 = pack_step(s, 1);
    const int i16 = lane & 15, q = i16 >> 2, p = i16 & 3, blk = (lane >> 4) & 1;
    const LAS unsigned char* vl = vb + (4 * h + q) * VSTR + (16 * blk + 4 * p) * 2;
#pragma unroll
    for (int d = 0; d < DV / 32; ++d) {
        const s16x4 lo0 = tr_read(vl + d * 64), hi0 = tr_read(vl + 8 * VSTR + d * 64);
        const s16x4 lo1 = tr_read(vl + 16 * VSTR + d * 64), hi1 = tr_read(vl + 24 * VSTR + d * 64);
        st.o[d] = mfma32(cat4(lo0, hi0), p0, st.o[d]);
        st.o[d] = mfma32(cat4(lo1, hi1), p1, st.o[d]);
    }
}

DI int naf(int row) { return (((row >> 1) & 1) << 2) | ((row >> 2) & 3); }
DI void phase_na_attn(Frame& F, int j  , bool with_ctx) {
    const bf16_t* QKV = (const bf16_t*)(F.ws + R_QKV); unsigned char* AO = F.ws + R_AO;
    const float* rpb = F.in[IN_NARPB] + (size_t)j * 16 * 15 * 31;
    LAS unsigned char* L = F.lds;
    LAS float* biasp = (LAS float*)(L + 65536);
    LAS float* bias = biasp + 64;
    LAS float* ninf = biasp + 64 + 465 + 64;
    const int w = F.wave;
    const int n_lat = NB * 16 * 8, n_units = n_lat + (with_ctx ? NB * 16 : 0);
    const int ncb = w & 3, rq = w >> 2;
    const int kst = __builtin_amdgcn_readfirstlane((ncb == 0) ? 0 : (ncb == 1) ? 8 : (ncb == 2) ? 24 : 32);
    for (int unit0 = F.bid; unit0 < n_units; unit0 += F.G) {
        int unit = unit0;
        if (F.G == 256 && unit0 < n_lat) { const int k = unit0 >> 8, wv = unit0 & 255; unit = ((k * 32 + (wv & 7) * 4 + ((wv >> 3) >> 3)) << 3) | ((wv >> 3) & 7); }
    const int lane = hw_lane(), tid = w * 64 + lane, r32 = lane & 31, hh = lane >> 5;
    const int q4 = (lane & 15) >> 2, p4 = lane & 3, blk = (lane >> 4) & 1, LP = 2 * blk + (p4 >> 1);
    const int K0w = (kst + r32) * 128 + ((hh ^ naf(kst + r32)) << 4), K0c = r32 * 128 + ((hh ^ naf(r32)) << 4);
    const int xbw = (kst >> 2) & 3;
    const int V0w = (4 * hh + q4) * 128 + ((q4 >> 1) << 6) + ((LP ^ ((xbw + hh) & 3)) << 4) + (p4 & 1) * 8;
    const int V0c = (4 * hh + q4) * 128 + ((q4 >> 1) << 6) + ((LP ^ (hh & 3)) << 4) + (p4 & 1) * 8;
    const int drow0 = 16 * w + (lane >> 3), dpos = lane & 7;
    const int dsrc0 = (dpos ^ naf(drow0)) * 8, dsrc1 = (dpos ^ naf(drow0 + 8)) * 8;
    {
        const bool lat = unit < n_lat;
        int b, head, rg = 0;
        if (lat) { b = unit >> 7; head = (unit >> 3) & 15; rg = unit & 7; } else { const int u2 = unit - n_lat; b = u2 >> 4; head = u2 & 15; }
        const int r0 = 8 * rg;
        const int kr_lo = min(max(r0 - 4, 0), 56), kr_hi = min(max(r0 + 3, 0), 56) + 7;
        const int nwin = lat ? (kr_hi - kr_lo + 2) / 2 : 0, ntile = 2 + nwin;
        __syncthreads();
        for (int i = tid; i < 64 + 465 + 64 + 128; i += 512) { const int bi = i - 64; biasp[i] = (bi >= 0 && bi < 465) ? rpb[head * 465 + bi] * 1.4426950408889634f : (i >= 64 + 465 + 64 ? -INFINITY : 0.f); }
        const bf16_t* kvbase = QKV + (size_t)(b * TPB) * 3072 + 1024 + head * 64;
        auto issue = [&](int t) {
            LAS unsigned char* dst = L + (t & 1) * 32768 + w * 2048;
            int tok0, tok1;
            if (t < 2) { tok0 = 128 * t + drow0; tok1 = tok0 + 8; }
            else { const int kr0 = kr_lo + 2 * (t - 2); const int ra = drow0, rb = drow0 + 8;
                tok0 = NCTX + min(kr0 + (ra >> 6), 63) * 64 + (ra & 63); tok1 = NCTX + min(kr0 + (rb >> 6), 63) * 64 + (rb & 63); }
            const bf16_t* p0 = kvbase + (size_t)tok0 * 3072 + dsrc0; const bf16_t* p1 = kvbase + (size_t)tok1 * 3072 + dsrc1;
            dma16(p0, dst);
            dma16(p1, (dst + 1024));
            dma16((p0 + 1024), (dst + 16384));
            dma16((p1 + 1024), (dst + 16384 + 1024));
        };
        issue(0);
        int qtok[2], qr[2]; const int qc = 16 * ncb + (r32 & 15);
#pragma unroll
        for (int qi = 0; qi < 2; ++qi) {
            if (lat) { qr[qi] = r0 + 4 * rq + 2 * qi + (r32 >> 4); qtok[qi] = b * TPB + NCTX + qr[qi] * 64 + qc; }
            else { qr[qi] = 0; qtok[qi] = b * TPB + 32 * w + r32; }
        }
        bf16x8 qf[2][4];
#pragma unroll
        for (int qi = 0; qi < 2; ++qi)
#pragma unroll
            for (int ks = 0; ks < 4; ++ks) qf[qi][ks] = *(const bf16x8*)(QKV + (size_t)qtok[qi] * 3072 + head * 64 + 16 * ks + 8 * hh);
#pragma unroll
        for (int qi = 0; qi < 2; ++qi)
#pragma unroll
            for (int ks = 0; ks < 4; ++ks) asm volatile("" : "+v"(qf[qi][ks]));
        const int wst = min(max(qc - 8, 0), 48);
        unsigned colmask = 0u;
#pragma unroll
        for (int i = 0; i < 16; ++i) { const int kc = kst + crow(i, hh); if (kc >= wst && kc < wst + 16) colmask |= 1u << i; }
        const int wr0 = r0 + 4 * rq; const int wlo = min(max(wr0 - 4, 0), 56), whi = min(max(wr0 + 3 - 4, 0), 56) + 7;
        const int qlo0 = min(max(wr0 - 4, 0), 56), qhi0 = min(max(wr0 + 1 - 4, 0), 56) + 7, qlo1 = min(max(wr0 + 2 - 4, 0), 56), qhi1 = min(max(wr0 + 3 - 4, 0), 56) + 7;
        f32x16 O[2][2]; float mrun[2], lrun[2];
#pragma unroll
        for (int qi = 0; qi < 2; ++qi) { mrun[qi] = -INFINITY; lrun[qi] = 0.f;
#pragma unroll
            for (int d = 0; d < 2; ++d)
#pragma unroll
                for (int i = 0; i < 16; ++i) O[qi][d][i] = 0.f; }
        auto subtile = [&](const LAS unsigned char* kb, const LAS unsigned char* vb, const int K0x, const int V0x, const bool masked, const int kr) {
            const int K0t = opaque(K0x), V0t = opaque(V0x);
            bf16x8 P[2][2];
            const bool use0 = !masked || (kr >= qlo0 && kr <= qhi0), use1 = !masked || (kr >= qlo1 && kr <= qhi1);
#pragma unroll
            for (int qi = 0; qi < 2; ++qi) {
                if (!(qi ? use1 : use0)) continue;
                f32x16 s;
                if (masked) {
                    const int rs = min(max(qr[qi] - 4, 0), 56); const bool rowok = (kr >= rs) && (kr < rs + 8);
                    const int dyc = min(max(kr - qr[qi] + 7, 0), 14);
                    const int delta = -qc + kst + 4 * hh;
                    const LAS float* bp = rowok ? (bias + opaque(dyc * 31 + 15 + delta)) : (ninf + opaque(64 + delta));
#pragma unroll
                    for (int i = 0; i < 16; ++i) s[i] = ((colmask >> i) & 1u) ? bp[(i & 3) + 8 * (i >> 2)] : -INFINITY;
                } else {
#pragma unroll
                    for (int i = 0; i < 16; ++i) s[i] = 0.f;
                }
#pragma unroll
                for (int ks = 0; ks < 4; ++ks) { const bf16x8 kf = *(const LAS bf16x8*)(kb + (K0t ^ (ks << 5))); s = mfma32(kf, qf[qi][ks], s); }
                float mx = s[0];
#pragma unroll
                for (int i = 1; i < 16; ++i) mx = fmaxf(mx, s[i]);
                mx = xhalf_max(mx);
                if (__any(mx > mrun[qi] + 8.0f)) {
                    const float mnew = fmaxf(mrun[qi], mx); const float alpha = fast_exp2(mrun[qi] - mnew);
                    mrun[qi] = mnew; lrun[qi] *= alpha;
#pragma unroll
                    for (int d = 0; d < 2; ++d)
#pragma unroll
                        for (int i = 0; i < 16; ++i) O[qi][d][i] *= alpha;
                }
                const float mu = mrun[qi]; float rsum = 0.f;
#pragma unroll
                for (int i = 0; i < 16; ++i) { s[i] = fast_exp2(s[i] - mu); rsum += s[i]; }
                lrun[qi] += rsum;
                P[qi][0] = pack_step(s, 0); P[qi][1] = pack_step(s, 1);
            }
#pragma unroll
            for (int d = 0; d < 2; ++d)
#pragma unroll
                for (int s2 = 0; s2 < 2; ++s2) {
                    const int va = V0t ^ (d << 6); const s16x4 lo = tr_read(vb + s2 * 2048 + va), hi = tr_read(vb + s2 * 2048 + 1024 + (va ^ 32));
                    const bf16x8 vf = cat4(lo, hi);
                    if (use0) O[0][d] = mfma32(vf, P[0][s2], O[0][d]);
                    if (use1) O[1][d] = mfma32(vf, P[1][s2], O[1][d]);
                }
        };
        for (int t = 0; t < ntile; ++t) {
            asm volatile("s_waitcnt vmcnt(0)" ::: "memory"); __builtin_amdgcn_s_barrier(); asm volatile("" ::: "memory");
            if (t + 1 < ntile) issue(t + 1);
            const LAS unsigned char* Kb = L + (t & 1) * 32768; const LAS unsigned char* Vb = Kb + 16384;
            if (t < 2) {
#pragma nounroll
                for (int sb = 0; sb < 4; ++sb) subtile(Kb + sb * 4096, Vb + sb * 4096, K0c, V0c, false, 0);
            } else {
#pragma nounroll
                for (int jr = 0; jr < 2; ++jr) { const int kr = kr_lo + 2 * (t - 2) + jr;
                    if (kr >= wlo && kr <= whi) subtile(Kb + jr * 8192, Vb + jr * 8192 + kst * 128, K0w, V0w, true, kr); }
            }
        }
#pragma unroll
        for (int qi = 0; qi < 2; ++qi) {
            if (!lat && qi == 1) continue;
            const float inv = 1.0f / (lrun[qi] + __shfl_xor(lrun[qi], 32));
            const int l2 = hw_lane(), r2 = l2 & 31, h2 = l2 >> 5;
            const int qt2 = lat ? (b * TPB + NCTX + (r0 + 4 * rq + 2 * qi + (r2 >> 4)) * 64 + 16 * ncb + (r2 & 15)) : (b * TPB + 32 * w + r2);
            unsigned char* op = AO + (size_t)qt2 * D + head * 64 + 4 * h2;
#pragma unroll
            for (int d = 0; d < 2; ++d)
#pragma unroll
                for (int g = 0; g < 4; ++g) *(unsigned*)(op + 32 * d + 8 * g) = pk4_fp8(O[qi][d][4 * g] * inv, O[qi][d][4 * g + 1] * inv, O[qi][d][4 * g + 2] * inv, O[qi][d][4 * g + 3] * inv);
        }
    }
    }
}

DI int gsw(int p) { return ((p & 3) << 2) | ((p >> 2) & 3); }
DI void phase_da_attn(Frame& F, bool with_ctx) {
    const bf16_t* QKV = (const bf16_t*)(F.ws + R_QKV); unsigned char* AO = F.ws + R_AO;
    LAS unsigned char* L = F.lds;
    LAS float* xch = (LAS float*)L;
    LAS float* misc = (LAS float*)(L + 131072);
    const int w = F.wave;
    const float lambda_init = 0.8f - 0.6f * expf(-0.3f * 2.0f);
    __syncthreads();
    if (w == 0) { const int lane = F.lane; const float* lam = F.in[IN_DALAM]; const float a = wave_sum(lam[lane] * lam[64 + lane]), c2 = wave_sum(lam[128 + lane] * lam[192 + lane]);
        if (lane == 0) misc[0] = expf(a) - expf(c2) + lambda_init; }
    __syncthreads();
    const float lam_full = misc[0];
    const int n_lat = NB * 8 * 16, n_units = n_lat + (with_ctx ? NB * 8 : 0);
    const int map = w >> 2, qw = w & 3;
    for (int unit0 = F.bid; unit0 < n_units; unit0 += F.G) {
        int unit = unit0;
        if (F.G == 256 && unit0 < n_lat) { const int k = unit0 >> 8, wv = unit0 & 255; unit = ((k * 16 + (wv & 7) * 2 + ((wv >> 3) >> 4)) << 4) | ((wv >> 3) & 15); }
        const int lane = hw_lane(), r32 = lane & 31, hh = lane >> 5;
        const int K0 = r32 * 256 + ((((map * 8 + hh) ^ gsw(r32))) << 4);
        const int q4 = (lane & 15) >> 2, p4 = lane & 3, blk = (lane >> 4) & 1, LP = 2 * blk + (p4 >> 1);
        const int V0 = (4 * hh + q4) * 256 + (q4 << 6) + ((LP ^ (hh & 3)) << 4) + (p4 & 1) * 8;
        const int drow0 = 8 * w + (lane >> 4), dpos = lane & 15;
        const int dsrc0 = (dpos ^ gsw(drow0)) * 8, dsrc1 = (dpos ^ gsw(drow0 + 4)) * 8;
        const bool lat = unit < n_lat;
        int b, head, qb;
        if (lat) { b = unit >> 7; head = (unit >> 4) & 7; qb = unit & 15; } else { const int u2 = unit - n_lat; b = u2 >> 3; head = u2 & 7; qb = 0; }
        const int qtok0 = b * TPB + (lat ? NCTX : 0) + qb * 256 + qw * 64;
        __syncthreads();
        const bf16_t* kbase = QKV + (size_t)(b * TPB) * 3072 + 1024 + head * 128;
        auto issue = [&](int t) {
            LAS unsigned char* dst = L + (t & 1) * 32768 + w * 2048;
            const bf16_t* r0 = kbase + (size_t)(t * 64 + drow0) * 3072; const bf16_t* r1 = r0 + (size_t)4 * 3072;
            dma16((r0 + dsrc0), dst);
            dma16((r1 + dsrc1), (dst + 1024));
            dma16((r0 + 1024 + dsrc0), (dst + 16384));
            dma16((r1 + 1024 + dsrc1), (dst + 16384 + 1024));
        };
        issue(0);
        bf16x8 qf[2][4];
#pragma unroll
        for (int qi = 0; qi < 2; ++qi)
#pragma unroll
            for (int ks = 0; ks < 4; ++ks) qf[qi][ks] = *(const bf16x8*)(QKV + (size_t)(qtok0 + 32 * qi + r32) * 3072 + head * 128 + map * 64 + 16 * ks + 8 * hh);
#pragma unroll
        for (int qi = 0; qi < 2; ++qi)
#pragma unroll
            for (int ks = 0; ks < 4; ++ks) asm volatile("" : "+v"(qf[qi][ks]));
        f32x16 O[2][4]; float mrun[2], lrun[2];
#pragma unroll
        for (int qi = 0; qi < 2; ++qi) { mrun[qi] = 0.f; lrun[qi] = 0.f;
#pragma unroll
            for (int d = 0; d < 4; ++d)
#pragma unroll
                for (int i = 0; i < 16; ++i) O[qi][d][i] = 0.f; }
        const int ntile = lat ? 68 : 4;
        for (int t = 0; t < ntile; ++t) {
            asm volatile("s_waitcnt vmcnt(0)" ::: "memory"); __builtin_amdgcn_s_barrier(); asm volatile("" ::: "memory");
            if (t + 1 < ntile) issue(t + 1);
            const LAS unsigned char* Kb = L + (t & 1) * 32768; const LAS unsigned char* Vb = Kb + 16384;
#pragma unroll
            for (int kb = 0; kb < 2; ++kb) {
                const bool first = (t == 0) && (kb == 0);
                const int K0t = opaque(K0), V0t = opaque(V0);
                bf16x8 P[2][2];
#pragma unroll
                for (int qi = 0; qi < 2; ++qi) {
                    f32x16 s; { float ninit = -mrun[qi]; asm volatile("" : "+v"(ninit));
#pragma unroll
                        for (int i = 0; i < 16; ++i) s[i] = ninit; }
#pragma unroll
                    for (int ks = 0; ks < 4; ++ks) { const bf16x8 kf = *(const LAS bf16x8*)(Kb + kb * 8192 + (K0t ^ (ks << 5))); s = mfma32(kf, qf[qi][ks], s); }
                    if (first) {
                        float mx = s[0];
#pragma unroll
                        for (int i = 1; i < 16; ++i) mx = fmaxf(mx, s[i]);
                        mx = xhalf_max(mx); mrun[qi] += mx;
#pragma unroll
                        for (int i = 0; i < 16; ++i) s[i] -= mx;
                    }
                    float rs = 0.f;
#pragma unroll
                    for (int i = 0; i < 16; ++i) { s[i] = fast_exp2(s[i]); rs += s[i]; }
                    if (!first && __any(!(rs < 0x1p30f))) {
                        { float ninit = -mrun[qi]; asm volatile("" : "+v"(ninit));
#pragma unroll
                          for (int i = 0; i < 16; ++i) s[i] = ninit; }
#pragma unroll
                        for (int ks = 0; ks < 4; ++ks) { const bf16x8 kf = *(const LAS bf16x8*)(Kb + kb * 8192 + (K0t ^ (ks << 5))); s = mfma32(kf, qf[qi][ks], s); }
                        float mx = s[0];
#pragma unroll
                        for (int i = 1; i < 16; ++i) mx = fmaxf(mx, s[i]);
                        mx = xhalf_max(mx);
                        const float shift = fmaxf(mx, 0.f), alpha = fast_exp2(-shift);
                        mrun[qi] += shift; lrun[qi] *= alpha;
#pragma unroll
                        for (int d = 0; d < 4; ++d)
#pragma unroll
                            for (int i = 0; i < 16; ++i) O[qi][d][i] *= alpha;
                        rs = 0.f;
#pragma unroll
                        for (int i = 0; i < 16; ++i) { s[i] = fast_exp2(s[i] - shift); rs += s[i]; }
                    }
                    lrun[qi] += rs;
                    P[qi][0] = pack_step(s, 0); P[qi][1] = pack_step(s, 1);
                }
#pragma unroll
                for (int d = 0; d < 4; ++d)
#pragma unroll
                    for (int s2 = 0; s2 < 2; ++s2) {
                        const int va = V0t ^ (d << 6); const s16x4 lo = tr_read(Vb + (32 * kb + 16 * s2) * 256 + va), hi = tr_read(Vb + (32 * kb + 16 * s2) * 256 + 2048 + (va ^ 32));
                        const bf16x8 vf = cat4(lo, hi);
                        O[0][d] = mfma32(vf, P[0][s2], O[0][d]);
                        O[1][d] = mfma32(vf, P[1][s2], O[1][d]);
                    }
            }
        }
        lrun[0] += __shfl_xor(lrun[0], 32); lrun[1] += __shfl_xor(lrun[1], 32);
        __syncthreads();
        const int lane2 = hw_lane(), r32b = lane2 & 31, hhb = lane2 >> 5;
        if (map == 1) {
#pragma unroll
            for (int qi = 0; qi < 2; ++qi) { const float inv = 1.0f / lrun[qi];
#pragma unroll
                for (int d = 0; d < 4; ++d)
#pragma unroll
                    for (int i = 0; i < 16; ++i) xch[(qw * 128 + qi * 64 + d * 16 + i) * 64 + lane2] = O[qi][d][i] * inv; }
        }
        __syncthreads();
        if (map == 0) {
            const float* sg = F.in[IN_DASUBLN];
#pragma unroll
            for (int qi = 0; qi < 2; ++qi) {
                const float inv = 1.0f / lrun[qi]; float ss = 0.f;
#pragma unroll
                for (int d = 0; d < 4; ++d)
#pragma unroll
                    for (int i = 0; i < 16; ++i) { const float v = O[qi][d][i] * inv - lam_full * xch[(qw * 128 + qi * 64 + d * 16 + i) * 64 + lane2]; O[qi][d][i] = v; ss += v * v; }
                ss += __shfl_xor(ss, 32);
                const float rn = (1.0f - lambda_init) / sqrtf(ss * (1.0f / 128.0f) + EPS);
                unsigned char* op = AO + (size_t)(b * TPB + (lat ? NCTX : 0) + qb * 256 + qw * 64 + 32 * qi + r32b) * D + head * 128 + 4 * hhb;
#pragma unroll
                for (int d = 0; d < 4; ++d)
#pragma unroll
                    for (int g = 0; g < 4; ++g) { const f32x4 gg = *(const f32x4*)(sg + 32 * d + 8 * g + 4 * hhb);
                        *(unsigned*)(op + 32 * d + 8 * g) = pk4_fp8(O[qi][d][4 * g] * rn * gg[0], O[qi][d][4 * g + 1] * rn * gg[1], O[qi][d][4 * g + 2] * rn * gg[2], O[qi][d][4 * g + 3] * rn * gg[3]); }
            }
        }
    }
}

#if PREP_PROBE
#define PREP_STAMP(k) do { const unsigned long long t_ = __builtin_amdgcn_s_memtime(); pacc[k] += t_ - plast; plast = t_; } while (0)
#else
#define PREP_STAMP(k) do { } while (0)
#endif
DI void phase_ml_prep(Frame& F) {
#if PREP_PROBE
    unsigned long long pacc[4] = {0, 0, 0, 0}; unsigned long long plast = __builtin_amdgcn_s_memtime();
#endif
    const bf16_t* XM = (const bf16_t*)(F.ws + R_XM); bf16_t* XC = (bf16_t*)(F.ws + R_XC); bf16_t* V = (bf16_t*)(F.ws + R_V); float* GATES = (float*)(F.ws + R_GATES);
    const bf16_t* WGt = (const bf16_t*)(F.ws + WS_MISC + 512 * 1024);
    LAS unsigned char* XT = F.lds;
    LAS float* part = (LAS float*)(F.lds + 131072);
    const int tid = F.tid, lane = F.lane, w = F.wave;
    const int g = tid;
    f32x2 cw2[5][2], cb2[2], wv2[4][2];
#pragma unroll
    for (int jj = 0; jj < 5; ++jj) { const f32x4 a = *(const f32x4*)(F.in[IN_MLCONVW] + jj * ML_INNER + 4 * g); cw2[jj][0] = (f32x2){a[0], a[1]}; cw2[jj][1] = (f32x2){a[2], a[3]}; }
    { const f32x4 a = *(const f32x4*)(F.in[IN_MLCONVB] + 4 * g); cb2[0] = (f32x2){a[0], a[1]}; cb2[1] = (f32x2){a[2], a[3]}; }
#pragma unroll
    for (int i = 0; i < 4; ++i) { const f32x4 a = *(const f32x4*)(F.in[IN_MLWV] + g * 16 + 4 * i); wv2[i][0] = (f32x2){a[0], a[1]}; wv2[i][1] = (f32x2){a[2], a[3]}; }
    const float bgate = (tid < 256) ? F.in[IN_MLBGATE][tid & 15] : 0.f;
    auto load_rows = [&](int tile, u32x2 (&rw)[20], unsigned& mask) {
        const int t0 = tile * 16; const int b = t0 / TPB, tt = t0 - b * TPB; const int seg0 = b * TPB + (tt < NCTX ? 0 : NCTX), seg1 = b * TPB + (tt < NCTX ? NCTX : TPB);
        unsigned m = 0u;
#pragma unroll
        for (int i = 0; i < 20; ++i) { const int row = t0 - 2 + i; const bool in = (row >= seg0 && row < seg1); const int rc = in ? row : t0; m |= (in ? 1u : 0u) << i;
            rw[i] = *(const u32x2*)(XM + (size_t)rc * ML_INNER + 4 * g); }
        mask = m;
    };
    u32x2 nxt[20]; unsigned nmask = 0u;
    if (F.bid < T / 16) load_rows(F.bid, nxt, nmask);
    for (int tile = F.bid; tile < T / 16; tile += F.G) {
        const int t0 = tile * 16;
        bf16x8 bw[16];
#pragma unroll
        for (int ks = 0; ks < 16; ++ks) bw[ks] = *(const bf16x8*)(WGt + (size_t)(lane & 15) * 4096 + w * 512 + 32 * ks + 8 * (lane >> 4));
        u32x2 raw[20]; const unsigned cmask = nmask;
#pragma unroll
        for (int i = 0; i < 20; ++i) raw[i] = nxt[i];
        if (tile + F.G < T / 16) load_rows(tile + F.G, nxt, nmask);
#pragma unroll
        for (int i = 0; i < 20; ++i) if (!((cmask >> i) & 1u)) { raw[i].x = 0u; raw[i].y = 0u; }
#if PREP_PROBE
        asm volatile("s_waitcnt vmcnt(0)" ::: "memory"); PREP_STAMP(0);
#endif
#pragma unroll
        for (int i = 0; i < 16; ++i) {
            f32x2 a01 = cb2[0], a23 = cb2[1];
#pragma unroll
            for (int jj = 0; jj < 5; ++jj) { const u32x2 u = raw[i + jj]; a01 += cw2[jj][0] * (f32x2){bflo(u.x), bfhi(u.x)}; a23 += cw2[jj][1] * (f32x2){bflo(u.y), bfhi(u.y)}; }
            const float x0 = bflo(raw[i + 2].x), x1 = bfhi(raw[i + 2].x), x2 = bflo(raw[i + 2].y), x3 = bfhi(raw[i + 2].y);
            const f32x2 v01 = wv2[0][0] * x0 + wv2[1][0] * x1 + wv2[2][0] * x2 + wv2[3][0] * x3, v23 = wv2[0][1] * x0 + wv2[1][1] * x1 + wv2[2][1] * x2 + wv2[3][1] * x3;
            u32x2 xcp; xcp.x = pk2(silu_f(a01[0]), silu_f(a01[1])); xcp.y = pk2(silu_f(a23[0]), silu_f(a23[1]));
            u32x2 vp; vp.x = pk2(v01[0], v01[1]); vp.y = pk2(v23[0], v23[1]);
            *(u32x2*)(XC + (size_t)(t0 + i) * ML_INNER + 4 * g) = xcp;
            *(u32x2*)(V + (size_t)(t0 + i) * ML_INNER + 4 * g) = vp;
            const int lo = i * 4096 + (((g >> 1) ^ i) << 4) + (g & 1) * 8;
            *(LAS u32x2*)(XT + lo) = xcp; *(LAS u32x2*)(XT + 65536 + lo) = raw[i + 2];
        }
        PREP_STAMP(1);
        __syncthreads();
        PREP_STAMP(2);
        {
            const int tok = lane & 15; const LAS unsigned char* abase = XT + (w >> 2) * 65536 + tok * 4096;
            f32x4 acc = {0.f, 0.f, 0.f, 0.f};
#pragma unroll
            for (int ks = 0; ks < 16; ++ks) { const int c = (w & 3) * 64 + 4 * ks + (lane >> 4); acc = mfma16(*(const LAS bf16x8*)(abase + ((c ^ tok) << 4)), bw[ks], acc); }
#pragma unroll
            for (int i = 0; i < 4; ++i) part[w * 256 + ((lane >> 4) * 4 + i) * 16 + (lane & 15)] = acc[i];
        }
        __syncthreads();
        if (tid < 256) { const int row = tid >> 4, n = tid & 15; float s = bgate;
#pragma unroll
            for (int ww = 0; ww < 8; ++ww) s += part[ww * 256 + tid];
            if ((n >> 2) & 1) s = fminf(s, 0.f) - log1pf(expf(-fabsf(s)));
            GATES[(size_t)(t0 + row) * 16 + n] = s; }
        PREP_STAMP(3);
    }
#if PREP_PROBE
    if (F.bid == 0 && F.tid == 0) { unsigned long long tot = 0; for (int k = 0; k < 4; ++k) tot += pacc[k]; ((float*)(F.ws + WS_CTL))[2048] = floorf(8.0f * (float)pacc[PREP_PROBE - 1] / (float)tot + 0.5f) / 8.0f; }
#endif
}

constexpr int SC_Q = 0, SC_K = 65536, SC_V = 131072, SC_S = 147456  , SC_VEC = 156672  ;
constexpr int SC_STR = 144;
DI int qk_off(int p, int qd) { const int grp = qd >> 2, q4 = qd & 3; const int pq = (q4 == 1) ? 2 : (q4 == 2) ? 1 : q4; const int c = grp * 2 + (pq >> 1); return p * 1024 + ((c ^ gsw(p)) << 4) + ((pq & 1) << 3); }
DI int qk_chunk(int p, int c) { return p * 1024 + ((c ^ gsw(p)) << 4); }
DI int v_off(int s, int qd) { const int c = qd >> 1; return s * 256 + ((c ^ gsw(s)) << 4) + ((qd & 1) << 3); }

#ifndef SCAN_PROBE
#define SCAN_PROBE 0
#endif
#if SCAN_PROBE
#define SCAN_STAMP(k) do { const unsigned long long t_ = __builtin_amdgcn_s_memtime(); acc_t[((k) + 6) % 7] += t_ - last_t; last_t = t_; } while (0)
#else
#define SCAN_STAMP(k) do { } while (0)
#endif
DI void phase_ml_scan(Frame& F) {
#if SCAN_PROBE
    unsigned long long acc_t[7] = {0, 0, 0, 0, 0, 0, 0}; unsigned long long last_t = __builtin_amdgcn_s_memtime();
#endif
    const bf16_t* XC = (const bf16_t*)(F.ws + R_XC); const bf16_t* V = (const bf16_t*)(F.ws + R_V); const float* GATES = (const float*)(F.ws + R_GATES);
    bf16_t* HF = (bf16_t*)(F.ws + R_XM); bf16_t* HBk = (bf16_t*)(F.ws + R_HBW);
    LAS unsigned char* L = F.lds;
    LAS float* vecA = (LAS float*)(L + SC_VEC);
    LAS float* vecM = vecA + 64;
    LAS float* vecI = vecA + 128;
    LAS float* vecW = vecA + 192;
    LAS float* vecRS = vecA + 256;
    LAS float* vecQN = vecA + 512;
    LAS float* vecN = vecA + 576;
    LAS float* vecS = vecA + 1088;
    LAS float* vecFL = vecA + 1152;
    LAS float* red = (LAS float*)(L + SC_Q);
    LAS float* nsum = (LAS float*)(L + SC_VEC + 4864);
    const int w = F.wave;
    const int etile = w & 3, dhalf = w >> 2;
    for (int unit = F.bid; unit < 256; unit += F.G) {
        const int chain = unit >> 2, es = unit & 3; const int b = chain >> 3, dir = (chain >> 2) & 1, head = chain & 3;
        bf16_t* HO = dir ? HBk : HF;
        f32x16 C[8];
#pragma unroll
        for (int t = 0; t < 8; ++t)
#pragma unroll
            for (int i = 0; i < 16; ++i) C[t][i] = 0.f;
        __syncthreads();
        vecN[F.tid] = 0.f; float nreg = 0.f;
        if (F.tid == 0) { vecS[1] = -INFINITY; }
        { const int j = F.tid >> 4, c4 = F.tid & 15; *(LAS unsigned*)(L + SC_S + j * SC_STR + 64 + 4 * c4) = 0u; if (F.tid < 32) vecRS[64 + F.tid] = 0.f; }
        u32x2 xr[16]; u32x4 vr[2]; float g_i = 0.f, g_f = 0.f;
        auto rowof = [&](int c, int p) -> int { const bool cx = c < 4; const int cc = cx ? c : c - 4; const int seglen = cx ? NCTX : SEQ; const int st = 64 * cc + p; const int segtok = dir ? (seglen - 1 - st) : st; return b * TPB + (cx ? 0 : NCTX) + segtok; };
        auto issue = [&](int c) {
            const bool cx = c < 4; const int cc = cx ? c : c - 4; const int seglen = cx ? NCTX : SEQ;
            const int R0 = b * TPB + (cx ? 0 : NCTX) + (dir ? (seglen - 1 - 64 * cc) : 64 * cc); const int sgn = dir ? -1 : 1;
            const int tid = opaque(F.tid);
            { const int l = tid & 63; const bf16_t* xp = XC + (ptrdiff_t)(R0 + sgn * (l & 15)) * ML_INNER + head * 512 + 64 * w + 4 * (l >> 4); const ptrdiff_t xstep = (ptrdiff_t)sgn * 16 * ML_INNER;
#pragma unroll
              for (int gi = 0; gi < 4; ++gi)
#pragma unroll
                for (int rb = 0; rb < 4; ++rb) xr[gi * 4 + rb] = *(const u32x2*)(xp + gi * 16 + rb * xstep); }
            const bf16_t* vp = V + (ptrdiff_t)(R0 + sgn * (tid >> 4)) * ML_INNER + head * 512 + es * 128 + 8 * (tid & 15); const ptrdiff_t vstep = (ptrdiff_t)sgn * 32 * ML_INNER;
            vr[0] = *(const u32x4*)vp; vr[1] = *(const u32x4*)(vp + vstep);
            if (w == 0) { const int row = R0 + sgn * tid; g_i = GATES[(size_t)row * 16 + dir * 8 + head]; g_f = GATES[(size_t)row * 16 + dir * 8 + 4 + head]; }
        };
        { const int l = hw_lane(); const int n = l & 15, kq = l >> 4; const bool nz = kq == (n >> 2);
          u32x4* frec = (u32x4*)(F.ws + WS_HB) + (size_t)(F.bid * 512 + w * 64 + l) * 4;
          u32x2 uq[4], uk[4];
#pragma unroll
          for (int gi = 0; gi < 4; ++gi) { const int wofs = (head * 128 + 4 * (4 * w + gi) + kq) * 16 + (n & 3);
              const float* pq = F.in[IN_MLWQ] + wofs; const float* pk = F.in[IN_MLWK] + wofs; const float qs = nz ? 0.044194173824159216f : 0.f, ks = nz ? 1.f : 0.f;
              uq[gi].x = pk2(pq[0] * qs, pq[4] * qs); uq[gi].y = pk2(pq[8] * qs, pq[12] * qs); uk[gi].x = pk2(pk[0] * ks, pk[4] * ks); uk[gi].y = pk2(pk[8] * ks, pk[12] * ks); }
          frec[0] = (u32x4){uq[0].x, uq[0].y, uq[1].x, uq[1].y}; frec[1] = (u32x4){uq[2].x, uq[2].y, uq[3].x, uq[3].y};
          frec[2] = (u32x4){uk[0].x, uk[0].y, uk[1].x, uk[1].y}; frec[3] = (u32x4){uk[2].x, uk[2].y, uk[3].x, uk[3].y};
          asm volatile("s_waitcnt vmcnt(0)" ::: "memory"); }
        issue(0);
        for (int c = 0; c < 68; ++c) {
            s16x4 aq[4], ak[4];
            { const int l = opaque(F.lane); const u32x4* frec = (const u32x4*)(F.ws + WS_HB) + (size_t)(F.bid * 512 + w * 64 + l) * 4;
              const u32x4 f0 = frec[0], f1 = frec[1], f2 = frec[2], f3 = frec[3];
              aq[0] = __builtin_bit_cast(s16x4, (u32x2){f0.x, f0.y}); aq[1] = __builtin_bit_cast(s16x4, (u32x2){f0.z, f0.w}); aq[2] = __builtin_bit_cast(s16x4, (u32x2){f1.x, f1.y}); aq[3] = __builtin_bit_cast(s16x4, (u32x2){f1.z, f1.w});
              ak[0] = __builtin_bit_cast(s16x4, (u32x2){f2.x, f2.y}); ak[1] = __builtin_bit_cast(s16x4, (u32x2){f2.z, f2.w}); ak[2] = __builtin_bit_cast(s16x4, (u32x2){f3.x, f3.y}); ak[3] = __builtin_bit_cast(s16x4, (u32x2){f3.z, f3.w}); }
            __syncthreads();
            for (int rp_ = 0; rp_ < ((SCAN_DUP & 1) ? 2 : 1); ++rp_) {
                const int tid = opaque(F.tid);
                { const int l = tid & 63; const int row = l & 15, nq = l >> 4; const int pq_ = (nq == 1) ? 2 : (nq == 2) ? 1 : nq;
                  const int base = row * 1024 + ((((8 * w) | (pq_ >> 1)) ^ gsw(row)) << 4) + ((pq_ & 1) << 3);
#pragma unroll
                  for (int gi = 0; gi < 4; ++gi)
#pragma unroll
                    for (int rb = 0; rb < 4; ++rb) {
                        const s16x4 xb = __builtin_bit_cast(s16x4, xr[gi * 4 + rb]);
                        const f32x4 dq = __builtin_amdgcn_mfma_f32_16x16x16bf16_1k(aq[gi], xb, (f32x4){0.f, 0.f, 0.f, 0.f}, 0, 0, 0);
                        const f32x4 dk = __builtin_amdgcn_mfma_f32_16x16x16bf16_1k(ak[gi], xb, (f32x4){0.f, 0.f, 0.f, 0.f}, 0, 0, 0);
                        u32x2 qq; qq.x = pk2(dq[0], dq[1]); qq.y = pk2(dq[2], dq[3]); u32x2 kk; kk.x = pk2(dk[0], dk[1]); kk.y = pk2(dk[2], dk[3]);
                        const int off = (base ^ ((2 * gi) << 4)) + rb * 16384; *(LAS u32x2*)(L + SC_Q + off) = qq; *(LAS u32x2*)(L + SC_K + off) = kk; } }
#pragma unroll
                for (int i = 0; i < 2; ++i) { const int id = tid + 512 * i; const int p = id >> 4, ch = id & 15; *(LAS u32x4*)(L + SC_V + p * 256 + ((ch ^ gsw(p)) << 4)) = vr[i]; }
            }
            if (w == 0) {
                const int lane = opaque(F.lane);
                const float ig = g_i, lf = g_f;
                float bc = lf;
#pragma unroll
                for (int o = 1; o < 64; o <<= 1) { const float t = __shfl_up(bc, o); if (lane >= o) bc += t; }
                const float a = ig - bc; float pm = a;
#pragma unroll
                for (int o = 1; o < 64; o <<= 1) { const float t = __shfl_up(pm, o); if (lane >= o) pm = fmaxf(pm, t); }
                const float mprev = vecS[1];
                const float M = fmaxf(mprev, pm);
                const float M63 = __shfl(M, 63), blast = __shfl(bc, 63);
                vecA[lane] = a; vecM[lane] = M; vecI[lane] = fast_exp(mprev - M); vecW[lane] = fast_exp(a - M63);
                vecFL[lane] = fast_exp(-(bc + M));
                if (lane == 0) { vecS[0] = fast_exp(mprev - M63); vecS[2] = blast + M63; }
            }
            __syncthreads();
            __builtin_amdgcn_sched_barrier(0);
            for (int rp_ = 0; rp_ < ((SCAN_DUP & 2) ? 2 : 1); ++rp_) {
            {
                const int tid = opaque(F.tid);
                const int j = tid >> 3, part = tid & 7; float s = 0.f;
#pragma unroll
                for (int cc = 0; cc < 8; ++cc) { const int chunk = cc * 8 + part;
                    const u32x4 u = *(const LAS u32x4*)(L + SC_Q + qk_chunk(j, chunk));
                    const int grp = chunk >> 1, hq = chunk & 1; const int d0 = grp * 16 + (hq ? 4 : 0), d1 = grp * 16 + (hq ? 12 : 8);
                    const f32x4 n0 = *(const LAS f32x4*)(vecN + d0), n1 = *(const LAS f32x4*)(vecN + d1);
                    s += bflo(u.x) * n0[0] + bfhi(u.x) * n0[1] + bflo(u.y) * n0[2] + bfhi(u.y) * n0[3];
                    s += bflo(u.z) * n1[0] + bfhi(u.z) * n1[1] + bflo(u.w) * n1[2] + bfhi(u.w) * n1[3]; }
                s += __shfl_xor(s, 1); s += __shfl_xor(s, 2); s += __shfl_xor(s, 4);
                if (part == 0) vecQN[j] = s;
            }
            __builtin_amdgcn_sched_barrier(0);
            if (w >= 4) {
                const int t2 = opaque(F.tid) - 256; const int qd = t2 >> 1, par = t2 & 1; f32x4 acc = {0.f, 0.f, 0.f, 0.f};
#pragma unroll 8
                for (int i = 0; i < 32; ++i) { const int s_ = 2 * i + par; const u32x2 kv = *(const LAS u32x2*)(L + SC_K + qk_off(s_, qd)); const float ws_ = vecW[s_];
                    acc[0] += ws_ * bflo(kv.x); acc[1] += ws_ * bfhi(kv.x); acc[2] += ws_ * bflo(kv.y); acc[3] += ws_ * bfhi(kv.y); }
#pragma unroll
                for (int i = 0; i < 4; ++i) acc[i] += __shfl_xor(acc[i], 1);
                if (par == 0) *(LAS f32x4*)(nsum + 4 * qd) = acc;
            }
            if (w < 3) {
                const int lane = opaque(F.lane); const int r32 = lane & 31, hh = lane >> 5;
                const int jb = (w == 0) ? 0 : 1, sb = (w == 2) ? 1 : 0;
                const int srow = 32 * sb + r32, jrow = 32 * jb + r32;
                f32x16 g0, g1;
#pragma unroll
                for (int i = 0; i < 16; ++i) { g0[i] = 0.f; g1[i] = 0.f; }
                const int kbase = SC_K + srow * 1024, qbase = SC_Q + jrow * 1024; const int gk = gsw(srow), gq = gsw(jrow);
                bf16x8 ca0 = *(const LAS bf16x8*)(L + kbase + (((0 + hh) ^ gk) << 4)), cb0 = *(const LAS bf16x8*)(L + qbase + (((0 + hh) ^ gq) << 4));
                bf16x8 ca1 = *(const LAS bf16x8*)(L + kbase + (((2 + hh) ^ gk) << 4)), cb1 = *(const LAS bf16x8*)(L + qbase + (((2 + hh) ^ gq) << 4));
#pragma unroll
                for (int it = 0; it < 16; ++it) {
                    bf16x8 na0 = ca0, nb0 = cb0, na1 = ca1, nb1 = cb1;
                    if (it + 1 < 16) { const int c0 = 4 * (it + 1) + hh;
                        na0 = *(const LAS bf16x8*)(L + kbase + ((c0 ^ gk) << 4)); nb0 = *(const LAS bf16x8*)(L + qbase + ((c0 ^ gq) << 4));
                        na1 = *(const LAS bf16x8*)(L + kbase + (((c0 + 2) ^ gk) << 4)); nb1 = *(const LAS bf16x8*)(L + qbase + (((c0 + 2) ^ gq) << 4)); }
                    g0 = mfma32(ca0, cb0, g0); g1 = mfma32(ca1, cb1, g1);
                    ca0 = na0; cb0 = nb0; ca1 = na1; cb1 = nb1;
                }
                const float Mj = vecM[jrow]; float rs = 0.f;
#pragma unroll
                for (int g = 0; g < 4; ++g) {
                    const int s0 = 32 * sb + 8 * g + 4 * hh; const f32x4 av = *(const LAS f32x4*)(vecA + s0); float sc[4];
#pragma unroll
                    for (int i = 0; i < 4; ++i) { const float dm = (s0 + i <= jrow) ? fast_exp(av[i] - Mj) : 0.f; sc[i] = (g0[4 * g + i] + g1[4 * g + i]) * dm; rs += sc[i]; }
                    u32x2 pkv; pkv.x = pk2(sc[0], sc[1]); pkv.y = pk2(sc[2], sc[3]);
                    *(LAS u32x2*)(L + SC_S + jrow * SC_STR + s0 * 2) = pkv;
                }
                rs = xhalf_sum(rs);
                if (hh == 0) vecRS[sb * 64 + jrow] = rs;
            }
            }
            __syncthreads();
            __builtin_amdgcn_sched_barrier(0);
            f32x16 O[2];
            for (int rp_ = 0; rp_ < ((SCAN_DUP & 4) ? 2 : 1); ++rp_) {
#pragma unroll
            for (int jb = 0; jb < 2; ++jb)
#pragma unroll
                for (int i = 0; i < 16; ++i) O[jb][i] = 0.f;
                const int lane = opaque(F.lane); const int r32 = lane & 31, hh = lane >> 5;
#pragma unroll
                for (int t = 0; t < 8; ++t) {
#pragma unroll
                    for (int s2 = 0; s2 < 2; ++s2) {
                        const bf16x8 xs = pack_step(C[t], s2);
                        const int chunk = (dhalf * 256 + 32 * t + 16 * s2) / 8 + hh;
#pragma unroll
                        for (int jb = 0; jb < 2; ++jb) { const bf16x8 qb = *(const LAS bf16x8*)(L + SC_Q + qk_chunk(32 * jb + r32, chunk)); O[jb] = mfma32(xs, qb, O[jb]); }
                    }
                    if (t & 1) __builtin_amdgcn_sched_barrier(0);
                }
#pragma unroll
                for (int jb = 0; jb < 2; ++jb) { const float it = vecI[32 * jb + r32];
#pragma unroll
                    for (int i = 0; i < 16; ++i) O[jb][i] *= it; }
                const int i16 = lane & 15, tq = i16 >> 2, tp = i16 & 3, blk = (lane >> 4) & 1;
#pragma unroll
                for (int ks = 0; ks < 2; ++ks) {
                    const int s0 = 32 * dhalf + 16 * ks + 8 * hh;
                    const int qd = (32 * etile + 16 * blk + 4 * tp) >> 2;
                    const s16x4 lo = tr_read(L + SC_V + v_off(s0 + tq, qd)), hi = tr_read(L + SC_V + v_off(s0 + 4 + tq, qd));
                    const bf16x8 af = cat4(lo, hi);
#pragma unroll
                    for (int jb = 0; jb < 2; ++jb) { const bf16x8 sb = *(const LAS bf16x8*)(L + SC_S + (32 * jb + r32) * SC_STR + (32 * dhalf + 16 * ks + 8 * hh) * 2); O[jb] = mfma32(af, sb, O[jb]); }
                }
            }
            __syncthreads();
            __builtin_amdgcn_sched_barrier(0);
            {
                const int lane = opaque(F.lane);
#pragma unroll
                for (int i = 0; i < 16; ++i) red[((etile * 2 + dhalf) * 16 + i) * 64 + lane] = dhalf ? O[0][i] : O[1][i];
            }
            __syncthreads();
            __builtin_amdgcn_sched_barrier(0);
            {
                const int lane = opaque(F.lane); const int r32 = lane & 31, hh = lane >> 5;
                const int j = 32 * dhalf + r32;
                const float den = vecI[j] * vecQN[j] + (vecRS[j] + vecRS[64 + j]);
                const float dinv = 1.0f / fmaxf(fabsf(den), vecFL[j]);
                bf16_t* op = HO + (size_t)rowof(c, j) * ML_INNER + head * 512 + es * 128 + etile * 32 + 4 * hh;
#pragma unroll
                for (int g = 0; g < 4; ++g) { float v[4];
#pragma unroll
                    for (int i = 0; i < 4; ++i) v[i] = ((dhalf ? O[1][4 * g + i] : O[0][4 * g + i]) + red[((etile * 2 + (1 - dhalf)) * 16 + 4 * g + i) * 64 + lane]) * dinv;
                    u32x2 wv; wv.x = pk2(v[0], v[1]); wv.y = pk2(v[2], v[3]); *(u32x2*)(op + 8 * g) = wv; }
            }
            __builtin_amdgcn_sched_barrier(0);
            SCAN_STAMP(0);
            if (c + 1 < 68) issue(c + 1);
            __builtin_amdgcn_sched_barrier(0);
            SCAN_STAMP(1);
            float decay_keep;
            {
                const float decay = vecS[0]; decay_keep = decay;
                const float ndep = decay;
            __builtin_amdgcn_sched_barrier(0);
                int lane = opaque_dep(F.lane, ndep);
#pragma unroll
                for (int t = 0; t < 8; ++t)
#pragma unroll
                    for (int i = 0; i < 16; ++i) C[t][i] *= decay;
                bf16x8 vf[4];
                {
                    const int hh = lane >> 5, i16 = lane & 15, tq = i16 >> 2, tp = i16 & 3, blk = (lane >> 4) & 1;
#pragma unroll
                    for (int ks = 0; ks < 4; ++ks) {
                        const int s0 = 16 * ks + 8 * hh; const int qd = (32 * etile + 16 * blk + 4 * tp) >> 2;
                        const s16x4 lo = tr_read(L + SC_V + v_off(s0 + tq, qd)), hi = tr_read(L + SC_V + v_off(s0 + 4 + tq, qd));
                        const f32x4 w0 = *(const LAS f32x4*)(vecW + s0), w1 = *(const LAS f32x4*)(vecW + s0 + 4);
                        u32x4 pkv;
                        pkv.x = pk2(bf2f((bf16_t)lo[0]) * w0[0], bf2f((bf16_t)lo[1]) * w0[1]); pkv.y = pk2(bf2f((bf16_t)lo[2]) * w0[2], bf2f((bf16_t)lo[3]) * w0[3]);
                        pkv.z = pk2(bf2f((bf16_t)hi[0]) * w1[0], bf2f((bf16_t)hi[1]) * w1[1]); pkv.w = pk2(bf2f((bf16_t)hi[2]) * w1[2], bf2f((bf16_t)hi[3]) * w1[3]);
                        vf[ks] = __builtin_bit_cast(bf16x8, pkv);
                    }
                }
                __builtin_amdgcn_sched_barrier(0);
            SCAN_STAMP(3);
#pragma unroll
                for (int t = 0; t < 8; ++t) {
                    if (t >= 3) lane = opaque_dep(lane, C[t - 3][0]);
                    const int hh = lane >> 5, i16 = lane & 15, tq = i16 >> 2, tp = i16 & 3, blk = (lane >> 4) & 1;
                    const int qd = (dhalf * 256 + 32 * t + 16 * blk + 4 * tp) >> 2;
#pragma unroll
                    for (int ks = 0; ks < 4; ++ks) {
                        const int s0 = 16 * ks + 8 * hh;
                        const s16x4 lo = tr_read(L + SC_K + qk_off(s0 + tq, qd)), hi = tr_read(L + SC_K + qk_off(s0 + 4 + tq, qd));
                        C[t] = mfma32(cat4(lo, hi), vf[ks], C[t]);
                    }
                }
            }
            SCAN_STAMP(4);
            __syncthreads();
            SCAN_STAMP(5);
            nreg = nreg * decay_keep + nsum[F.tid];
            vecN[F.tid] = nreg;
            if (F.tid == 0) vecS[1] = vecS[2];
        }
    }
#if SCAN_PROBE
    if (F.bid == 0 && F.tid == 0) { unsigned long long tot = 0; for (int k = 0; k < 7; ++k) tot += acc_t[k]; ((float*)(F.ws + WS_CTL))[2048] = floorf(16.0f * (float)acc_t[SCAN_PROBE - 1] / (float)tot + 0.5f) / 16.0f; }
#endif
}

DI void phase_ml_finish(Frame& F) {
    const bf16_t* HF = (const bf16_t*)(F.ws + R_XM); const bf16_t* HBk = (const bf16_t*)(F.ws + R_HBW); const bf16_t* Z = (const bf16_t*)(F.ws + R_Z); bf16_t* XC = (bf16_t*)(F.ws + R_XC);
    const int gw = F.bid * 8 + F.wave, NGW = F.G * 8, lane = F.lane;
    f32x4 gwc[4][2], skc[4][2];
#pragma unroll
    for (int hd = 0; hd < 4; ++hd)
#pragma unroll
        for (int q = 0; q < 2; ++q) { gwc[hd][q] = *(const f32x4*)(F.in[IN_MLGNW] + hd * 512 + 8 * lane + 4 * q); skc[hd][q] = *(const f32x4*)(F.in[IN_MLSKIP] + hd * 512 + 8 * lane + 4 * q); }
    u32x4 nx[4][4];
    auto load_row = [&](int r) {
#pragma unroll
        for (int hd = 0; hd < 4; ++hd) { const size_t off = (size_t)r * ML_INNER + hd * 512 + 8 * lane;
            nx[hd][0] = *(const u32x4*)(HF + off); nx[hd][1] = *(const u32x4*)(HBk + off); nx[hd][2] = *(const u32x4*)(Z + off); nx[hd][3] = *(const u32x4*)(XC + off); }
    };
    if (gw < T) load_row(gw);
    for (int r = gw; r < T; r += NGW) {
        u32x4 cur[4][4];
#pragma unroll
        for (int hd = 0; hd < 4; ++hd)
#pragma unroll
            for (int q = 0; q < 4; ++q) cur[hd][q] = nx[hd][q];
        if (r + NGW < T) load_row(r + NGW);
#pragma unroll
        for (int hd = 0; hd < 4; ++hd) {
            const size_t off = (size_t)r * ML_INNER + hd * 512 + 8 * lane;
            const u32x4 a = cur[hd][0], bq = cur[hd][1], zc = cur[hd][2], xq = cur[hd][3];
            float h[8];
            h[0] = bflo(a.x) + bflo(bq.x); h[1] = bfhi(a.x) + bfhi(bq.x); h[2] = bflo(a.y) + bflo(bq.y); h[3] = bfhi(a.y) + bfhi(bq.y);
            h[4] = bflo(a.z) + bflo(bq.z); h[5] = bfhi(a.z) + bfhi(bq.z); h[6] = bflo(a.w) + bflo(bq.w); h[7] = bfhi(a.w) + bfhi(bq.w);
            float s = 0.f;
#pragma unroll
            for (int i = 0; i < 8; ++i) s += h[i];
            const float mu = wave_sum(s) * (1.0f / 512.0f); float q = 0.f;
#pragma unroll
            for (int i = 0; i < 8; ++i) { h[i] -= mu; q += h[i] * h[i]; }
            const float rstd = 1.0f / sqrtf(wave_sum(q) * (1.0f / 512.0f) + EPS);
            float zf[8], xf[8];
            zf[0] = bflo(zc.x); zf[1] = bfhi(zc.x); zf[2] = bflo(zc.y); zf[3] = bfhi(zc.y); zf[4] = bflo(zc.z); zf[5] = bfhi(zc.z); zf[6] = bflo(zc.w); zf[7] = bfhi(zc.w);
            xf[0] = bflo(xq.x); xf[1] = bfhi(xq.x); xf[2] = bflo(xq.y); xf[3] = bfhi(xq.y); xf[4] = bflo(xq.z); xf[5] = bfhi(xq.z); xf[6] = bflo(xq.w); xf[7] = bfhi(xq.w);
            float o[8];
#pragma unroll
            for (int i = 0; i < 8; ++i) o[i] = (h[i] * rstd * gwc[hd][i >> 2][i & 3] + skc[hd][i >> 2][i & 3] * xf[i]) * silu_f(zf[i]);
            u32x2 wv; wv.x = pk4_fp8(o[0], o[1], o[2], o[3]); wv.y = pk4_fp8(o[4], o[5], o[6], o[7]);
            *(u32x2*)(F.ws + R_V + off) = wv;
        }
    }
}

__global__ void __launch_bounds__(512, 2) mk_fwd(Args args) {
    extern __shared__ __attribute__((aligned(16))) unsigned char lds_raw[];
    Frame F;
    F.lds = (LAS unsigned char*)lds_raw; F.ws = args.ws; F.in = args.in; F.out = args.out;
    F.wave = __builtin_amdgcn_readfirstlane((int)threadIdx.x >> 6); F.lane = hw_lane(); F.tid = F.wave * 64 + F.lane; F.G = gridDim.x; F.bid = blockIdx.x;
    volatile LAS unsigned* lctl = (volatile LAS unsigned*)(F.lds + LDS_CTL);
    if (F.tid < 64) lctl[F.tid] = 0u;
    __syncthreads();
    unsigned* ctl = (unsigned*)(F.ws + WS_CTL);
    XcdBarrier bar; bar.bar = ctl + CW_BAR; bar.x = 0; bar.st = nullptr;
    if (!MK_PER_PHASE) bar = xcd_barrier_post(ctl + CW_BAR, lctl, F.tid == 0);
    const int lo = args.ph_lo, hi = args.ph_hi;
    int ph = 0;
    if (PHASE_PROBE >= 0) lctl[10] = (unsigned)__builtin_amdgcn_s_memrealtime();
#define NREP_(p) ((((unsigned long long)(MK_DUP) >> (p)) & 1ull) ? 2 : 1)
#define PHASE_BEGIN if (lo <= ph && ph < hi && ph <= MK_LAST_PHASE && (MK_ONLY < 0 || ph == MK_ONLY)) { if (PHASE_PROBE == ph) lctl[8] = (unsigned)__builtin_amdgcn_s_memrealtime(); for (int rep_ = 0; rep_ < NREP_(ph); ++rep_) { F.lane = hw_lane(); F.tid = F.wave * 64 + F.lane;
#define PHASE_END   if (!MK_PER_PHASE && (ph + 1 < hi || rep_ + 1 < NREP_(ph))) { const int l0 = hw_lane(); xcd_barrier(bar, F.wave == 0 && l0 == 0); } } if (PHASE_PROBE == ph) lctl[9] = (unsigned)__builtin_amdgcn_s_memrealtime() - lctl[8]; } ++ph;

    bf16_t* HB = (bf16_t*)(F.ws + WS_HB);
    bf16_t* XS = (bf16_t*)(F.ws + WS_XS);
    const float* modv = (const float*)(F.ws + WS_MODV);
    LAS int* tbl = (LAS int*)(F.lds + pg8::STAGE_BYTES);

    PHASE_BEGIN phase_prologue(F); PHASE_END

#define MOE_BLOCK(layer) \
    PHASE_BEGIN phase_norm2_router(F, layer); PHASE_END \
    PHASE_BEGIN { const int ntl = moe_build_table(F, layer, tbl); \
        MoeOrder S; S.G = F.G; S.c = F.bid; S.ntiles = ntl; S.K = D / 2; S.A = (const char*)(F.ws + WS_HB8); S.Bt = (const char*)(F.ws + WS_WMOE13); S.bstride = (size_t)1024 * D; \
        S.idx = (const int*)(F.ws + WS_ROUTE + 2 * MiB); S.gather = true; S.tbl = tbl; S.xcdmap = moe_xcd_balanced(F, tbl, ntl); \
        pg8::EpiMoE1 E{F.ws + R_HMID}; pg8::gemm_phase<pg8::EpiMoE1, MoeOrder, true>(F.lds, D / 2, S, E, F.tid); } PHASE_END \
    PHASE_BEGIN { const int ntl = moe_build_table(F, layer, tbl); \
        MoeOrder S; S.G = F.G; S.c = F.bid; S.ntiles = ntl; S.K = MOE_H / 2; S.A = (const char*)(F.ws + R_HMID); S.Bt = (const char*)(F.ws + WS_WMOE2); S.bstride = (size_t)1024 * MOE_H; \
        S.idx = nullptr; S.gather = false; S.tbl = tbl; S.xcdmap = moe_xcd_balanced(F, tbl, ntl); \
        pg8::EpiMoE2 E{F.ws + R_Y}; pg8::gemm_phase<pg8::EpiMoE2, MoeOrder, true>(F.lds, MOE_H / 2, S, E, F.tid); } PHASE_END

#define GEMM_DENSE8X(SKIP, Aptr, Wptr, N_, K_, EPI_T, ...) { pg8::DenseOrder S; S.init((const bf16_t*)(Aptr), (const bf16_t*)(Wptr), T, N_, (K_) / 2, F.G, F.bid, SKIP); EPI_T E{__VA_ARGS__}; pg8::gemm_phase<EPI_T, pg8::DenseOrder, true>(F.lds, (K_) / 2, S, E, F.tid); }
#define GEMM_DENSE8(...) GEMM_DENSE8X(0, __VA_ARGS__)
#define GEMM_DENSE(Aptr, Wptr, N_, K_, EPI_T, ...) { pg8::DenseOrder S; S.init((const bf16_t*)(Aptr), (const bf16_t*)(Wptr), T, N_, K_, F.G, F.bid); EPI_T E{__VA_ARGS__}; pg8::gemm_phase<EPI_T, pg8::DenseOrder>(F.lds, K_, S, E, F.tid); }

    PHASE_BEGIN phase_modulate<0>(F, 0); PHASE_END
    PHASE_BEGIN GEMM_DENSE8(F.ws + WS_HB8, F.ws + WS_WNAQKV, 3072, D, pg8::EpiBf16, (bf16_t*)(F.ws + R_QKV), 3072, 0, 0, 4, 0.125f * 1.4426950408889634f, 1.0f / 32.0f)
        in_gemm_tail(F, (T / 256) * 12, [&](int g0, int ng, LAS float* scr) { convert_matrix(F, F.in[IN_MLUP], D, 4096, (bf16_t*)(F.ws + WS_WMLUP), g0, ng, scr); }); PHASE_END
    PHASE_BEGIN phase_na_attn(F, 0, true); PHASE_END
    PHASE_BEGIN GEMM_DENSE8(F.ws + R_AO, F.ws + WS_WNAO, D, D, pg8::EpiResid, XS, modv + (size_t)0 * 9 * 6144 + 2048, 1.0f / 32.0f) convert_moe_in_tail(F, 0, (T / 256) * (D / 256)); PHASE_END
    MOE_BLOCK(0)
    PHASE_BEGIN phase_modulate<1>(F, 1); PHASE_END
    PHASE_BEGIN GEMM_DENSE(HB, F.ws + WS_WMLUP, 4096, D, pg8::EpiBf16, (bf16_t*)(F.ws + R_XM), ML_INNER, ML_INNER, (size_t)(R_Z - R_XM) / 2, 0, 1.0f, 1.0f)
        in_gemm_tail(F, (T / 256) * 16, [&](int g0, int ng, LAS float* scr) { convert_matrix_fp8(F, F.in[IN_MLDOWN], ML_INNER, D, F.ws + WS_WMLDN, g0, ng, scr); convert_matrix_fp8(F, F.in[IN_DAQKV], D, 3072, F.ws + WS_WDAQKV, g0, ng, scr); }); PHASE_END
    PHASE_BEGIN phase_ml_prep(F); PHASE_END
    PHASE_BEGIN phase_ml_scan(F); PHASE_END
    PHASE_BEGIN phase_ml_finish(F); PHASE_END
    PHASE_BEGIN GEMM_DENSE8(F.ws + R_V, F.ws + WS_WMLDN, D, ML_INNER, pg8::EpiResid, XS, modv + (size_t)1 * 9 * 6144 + 2048, 1.0f / 32.0f) convert_moe_in_tail(F, 1, (T / 256) * (D / 256));
        in_gemm_tail(F, (T / 256) * (D / 256), [&](int g0, int ng, LAS float* scr) { convert_matrix_fp8(F, F.in[IN_DAO], D, D, F.ws + WS_WDAO, g0, ng, scr);
            convert_matrix_fp8(F, F.in[IN_NAQKV] + (size_t)D * 3072, D, 3072, F.ws + WS_WNAQKV + (size_t)3072 * D, g0, ng, scr); convert_matrix_fp8(F, F.in[IN_NAO] + (size_t)D * D, D, D, F.ws + WS_WNAO + (size_t)D * D, g0, ng, scr); }); PHASE_END
    MOE_BLOCK(1)
    PHASE_BEGIN phase_modulate<1>(F, 2); PHASE_END
    PHASE_BEGIN GEMM_DENSE8(F.ws + WS_HB8, F.ws + WS_WDAQKV, 3072, D, pg8::EpiBf16Rope, (bf16_t*)(F.ws + R_QKV), (const float*)(F.ws + WS_MISC + 768 * 1024), 1.0f / 32.0f) PHASE_END
    PHASE_BEGIN phase_da_attn(F, true); PHASE_END
    PHASE_BEGIN GEMM_DENSE8(F.ws + R_AO, F.ws + WS_WDAO, D, D, pg8::EpiResid, XS, modv + (size_t)2 * 9 * 6144 + 2048, 1.0f / 32.0f) convert_moe_in_tail(F, 2, (T / 256) * (D / 256)); PHASE_END
    MOE_BLOCK(2)
    PHASE_BEGIN phase_modulate<1>(F, 3); { LAS float* scr = (LAS float*)(F.lds + F.wave * 16384); __syncthreads(); convert_moe(F, 3, F.bid * 8 + F.wave, F.G * 8, scr); } PHASE_END
    PHASE_BEGIN GEMM_DENSE8(F.ws + WS_HB8, F.ws + WS_WNAQKV + (size_t)3072 * D, 3072, D, pg8::EpiBf16, (bf16_t*)(F.ws + R_QKV), 3072, 0, 0, 4, 0.125f * 1.4426950408889634f, 1.0f / 32.0f) PHASE_END
    PHASE_BEGIN phase_na_attn(F, 1, false); PHASE_END
    PHASE_BEGIN GEMM_DENSE8X(1, F.ws + R_AO, F.ws + WS_WNAO + (size_t)D * D, D, D, pg8::EpiResid, XS, modv + (size_t)3 * 9 * 6144 + 2048, 1.0f / 32.0f) PHASE_END
    MOE_BLOCK(3)
    if (PHASE_PROBE >= 0 && F.bid == 0) { const float fr = (float)lctl[9] / (float)((unsigned)__builtin_amdgcn_s_memrealtime() - lctl[10]); ((float*)(F.ws + WS_CTL))[2048] = 0.04f * fr; }
    if (PHASE_PROBE >= 0) __syncthreads();
    if (lo <= ph && ph < hi) { F.lane = hw_lane(); F.tid = F.wave * 64 + F.lane; phase_modulate<3>(F, 3); } ++ph;
}
constexpr int N_PHASES = 1 + 7 + 9 + 7 + 7 + 1;

extern "C" void kernel_launch(void* const* d_in, const int* in_sizes, int n_in, void* d_out, int out_size, void* d_ws, size_t ws_size, hipStream_t stream) {
    static int grid = 0;
    if (grid == 0) {
        if (n_in != 33 || ws_size < WS_END) { fprintf(stderr, "kernel_launch: unexpected n_in %d or ws_size %zu (< %zu)\n", n_in, ws_size, (size_t)WS_END); grid = -1; return; }
        int dev = 0, cus = 0;
        if (hipGetDevice(&dev) != hipSuccess || hipDeviceGetAttribute(&cus, hipDeviceAttributeMultiprocessorCount, dev) != hipSuccess) { grid = -1; return; }
        if (hipFuncSetAttribute((const void*)mk_fwd, hipFuncAttributeMaxDynamicSharedMemorySize, LDS_BYTES) != hipSuccess) { fprintf(stderr, "kernel_launch: hipFuncSetAttribute failed\n"); grid = -1; return; }
        int per_cu = 0;
        if (hipOccupancyMaxActiveBlocksPerMultiprocessor(&per_cu, (const void*)mk_fwd, 512, LDS_BYTES) != hipSuccess || per_cu < 1) fprintf(stderr, "kernel_launch: occupancy query says %d\n", per_cu);
        (void)hipGetLastError();
        grid = cus;
    }
    if (grid < 0) return;
    (void)hipMemsetAsync((char*)d_ws + WS_CTL, 0, CTL_BYTES, stream);
    Args a{};
    for (int i = 0; i < 33; ++i) a.in[i] = (const float*)d_in[i];
    a.out = (float*)d_out; a.ws = (unsigned char*)d_ws;
#if MK_PER_PHASE
    for (int p = 0; p < N_PHASES; ++p) { a.ph_lo = p; a.ph_hi = p + 1; hipLaunchKernelGGL(mk_fwd, dim3(grid), dim3(512), LDS_BYTES, stream, a); }
#else
    a.ph_lo = 0; a.ph_hi = N_PHASES;
    hipLaunchKernelGGL(mk_fwd, dim3(grid), dim3(512), LDS_BYTES, stream, a);
#endif
}
```

```cpp
#include <hip/hip_runtime.h>
#include <cstdio>
#include <cstdint>

#define DI __device__ __forceinline__
#define LAS __attribute__((address_space(3)))
typedef unsigned short bf16_t;
typedef short bf16x8 __attribute__((ext_vector_type(8)));
typedef short s16x4 __attribute__((ext_vector_type(4)));
typedef float f32x2 __attribute__((ext_vector_type(2)));
typedef float f32x4 __attribute__((ext_vector_type(4)));
typedef float f32x16 __attribute__((ext_vector_type(16)));
typedef unsigned u32x2 __attribute__((ext_vector_type(2)));
typedef unsigned u32x4 __attribute__((ext_vector_type(4)));
typedef __bf16 nbf2 __attribute__((ext_vector_type(2)));
typedef int i32x4 __attribute__((ext_vector_type(4)));
typedef int i32x8 __attribute__((ext_vector_type(8)));

#ifndef MK_PER_PHASE
#define MK_PER_PHASE 0
#endif
#ifndef MK_DUP
#define MK_DUP 0ull
#endif
#ifndef SCAN_PROBE
#define SCAN_PROBE 0
#endif
#ifndef PREP_PROBE
#define PREP_PROBE 0
#endif
#ifndef PHASE_PROBE
#define PHASE_PROBE (-1)
#endif
#ifndef SCAN_DUP
#define SCAN_DUP 0
#endif
#ifndef MK_ONLY
#define MK_ONLY (-1)
#endif
#ifndef MK_LAST_PHASE
#define MK_LAST_PHASE 1000
#endif

constexpr int D = 1024, NB = 8, SEQ = 4096, NCTX = 256, TPB = SEQ + NCTX  , T = NB * TPB  ;
constexpr int NRT = T / 256;
constexpr float EPS = 1e-6f;
constexpr int ML_INNER = 2048;
constexpr int MOE_H = 512, NEXP = 32;
constexpr int MAXTILES = 304;

constexpr size_t MiB = 1u << 20;
constexpr size_t WS_CTL = 0, CTL_BYTES = 1 * MiB;
constexpr size_t WS_MODV = 1 * MiB;
constexpr size_t WS_MISC = 2 * MiB;
constexpr size_t WS_WNAQKV = 3 * MiB;
constexpr size_t WS_WNAO = 15 * MiB;
constexpr size_t WS_WMLUP = 19 * MiB;
constexpr size_t WS_WMLDN = 27 * MiB;
constexpr size_t WS_WDAQKV = 31 * MiB;
constexpr size_t WS_WDAO = 37 * MiB;
constexpr size_t WS_WMOE13 = 39 * MiB;
constexpr size_t WS_WMOE2 = 71 * MiB;
constexpr size_t WS_HB8 = 88 * MiB;
constexpr size_t WS_XS = 135 * MiB;
constexpr size_t WS_HB = 271 * MiB;
constexpr size_t WS_ROUTE = 339 * MiB;
constexpr size_t WS_R = 346 * MiB;
constexpr size_t R_QKV = WS_R;
constexpr size_t R_AO = WS_R + 204 * MiB;
constexpr size_t R_XM = WS_R;
constexpr size_t R_Z = WS_R + 136 * MiB;
constexpr size_t R_XC = WS_R + 272 * MiB;
constexpr size_t R_V = WS_R + 408 * MiB;
constexpr size_t R_HBW = WS_R + 544 * MiB;
constexpr size_t R_GATES = WS_R + 680 * MiB;
constexpr size_t R_HMID = WS_R;
constexpr size_t R_Y = WS_R + 76 * MiB;
constexpr size_t WS_END = WS_R + 683 * MiB;
constexpr int CW_BAR = 4096;
constexpr int CW_CNT = 16384;

constexpr int LDS_BYTES = 163840;
constexpr int LDS_CTL = LDS_BYTES - 256;

DI unsigned pk2(float lo, float hi) { f32x2 v = {lo, hi}; nbf2 r = __builtin_convertvector(v, nbf2); return __builtin_bit_cast(unsigned, r); }
DI unsigned pk4_fp8(float a, float b, float c, float d) { int r = 0; r = __builtin_amdgcn_cvt_pk_fp8_f32(a, b, r, false); r = __builtin_amdgcn_cvt_pk_fp8_f32(c, d, r, true); return (unsigned)r; }
DI float bflo(unsigned u) { return __builtin_bit_cast(float, u << 16); }
DI float bfhi(unsigned u) { return __builtin_bit_cast(float, u & 0xffff0000u); }
DI float bf2f(bf16_t b) { return __builtin_bit_cast(float, ((unsigned)b) << 16); }
DI int hw_lane() { int l; asm volatile("v_mbcnt_lo_u32_b32 %0, -1, 0\n\tv_mbcnt_hi_u32_b32 %0, -1, %0" : "=v"(l)); return l; }
DI int opaque(int v) { asm volatile("" : "+v"(v)); return v; }
DI int opaque_dep(int v, float dep) { asm volatile("" : "+v"(v) : "v"(dep)); return v; }
DI void dma16(const void* g, LAS unsigned char* dst) {
    unsigned keep;
    asm volatile("s_mov_b32 %0, m0\n\ts_mov_b32 m0, %2\n\ts_nop 0\n\tglobal_load_lds_dwordx4 %1, off\n\ts_mov_b32 m0, %0" : "=&s"(keep) : "v"(g), "s"((unsigned)(__UINTPTR_TYPE__)dst) : "memory");
}
DI float xhalf_max(float x) { unsigned a = __builtin_bit_cast(unsigned, x), c = a; asm volatile("" : "+v"(c)); const auto r = __builtin_amdgcn_permlane32_swap(a, c, false, false); return fmaxf(__builtin_bit_cast(float, r[0]), __builtin_bit_cast(float, r[1])); }
DI float xhalf_sum(float x) { return x + __shfl_xor(x, 32); }
DI float xhalf_sum_pl(float x) { unsigned a = __builtin_bit_cast(unsigned, x), c = a; asm volatile("" : "+v"(c)); const auto r = __builtin_amdgcn_permlane32_swap(a, c, false, false); return __builtin_bit_cast(float, r[0]) + __builtin_bit_cast(float, r[1]); }
DI float wave_sum(float v) {
#pragma unroll
    for (int o = 1; o < 64; o <<= 1) v += __shfl_xor(v, o);
    return v;
}
DI float fast_exp2(float x) { return __builtin_amdgcn_exp2f(x); }
DI float fast_exp(float x) { return __builtin_amdgcn_exp2f(x * 1.4426950408889634f); }
DI float fast_rcp(float x) { return __builtin_amdgcn_rcpf(x); }
DI float silu_f(float x) { return x * fast_rcp(1.f + fast_exp(-x)); }
DI f32x16 mfma32(bf16x8 a, bf16x8 b, f32x16 c) { return __builtin_amdgcn_mfma_f32_32x32x16_bf16(a, b, c, 0, 0, 0); }
DI f32x4 mfma16(bf16x8 a, bf16x8 b, f32x4 c) { return __builtin_amdgcn_mfma_f32_16x16x32_bf16(a, b, c, 0, 0, 0); }
DI int crow(int reg, int h) { return (reg & 3) + 8 * (reg >> 2) + 4 * h; }
DI bf16x8 pack_step(const f32x16& x, int s) {
    u32x4 p; p.x = pk2(x[8 * s], x[8 * s + 1]); p.y = pk2(x[8 * s + 2], x[8 * s + 3]); p.z = pk2(x[8 * s + 4], x[8 * s + 5]); p.w = pk2(x[8 * s + 6], x[8 * s + 7]);
    return __builtin_bit_cast(bf16x8, p);
}
DI s16x4 tr_read(const LAS unsigned char* p) { return __builtin_amdgcn_ds_read_tr16_b64_v4i16((LAS s16x4*)p); }
DI bf16x8 cat4(s16x4 lo, s16x4 hi) { return __builtin_shufflevector(lo, hi, 0, 1, 2, 3, 4, 5, 6, 7); }

#define XB_TMO      128
#define XB_XCNT(j)  (256  + 64 * (j))
#define XB_XSUB(j)  (1280 + 64 * (j))
#define XB_XGEN(j)  (2304 + 64 * (j))
#define XB_TOP      3328
#define XB_TOPGEN   3392
#define XCD_BAR_WORDS 3456
#define XB_SPIN_CAP (1u << 22)
DI unsigned xb_ld(unsigned* p)              { return __hip_atomic_load(p, __ATOMIC_RELAXED, __HIP_MEMORY_SCOPE_AGENT); }
DI unsigned xb_add(unsigned* p, unsigned v) { return __hip_atomic_fetch_add(p, v, __ATOMIC_RELAXED, __HIP_MEMORY_SCOPE_AGENT); }
DI unsigned xb_xcc_id() { return (unsigned)__builtin_amdgcn_s_getreg((3 << 11) | 20) & 0xFu; }
#define XB_SPIN(cond, bar) do { unsigned _sp = 0; while (cond) { __builtin_amdgcn_s_sleep(1); \
    if ((++_sp & 255u) == 0u) { if (xb_ld(&(bar)[XB_TMO])) break; if (_sp > XB_SPIN_CAP) { atomicAdd(&(bar)[XB_TMO], 1u); break; } } } } while (0)
struct XcdBarrier { unsigned* bar; unsigned x; volatile LAS unsigned* st; };
DI XcdBarrier xcd_barrier_post(unsigned* bar, volatile LAS unsigned* st, bool t0) {
    XcdBarrier b; b.bar = bar; b.x = xb_xcc_id(); b.st = st;
    if (t0) (void)xb_add(&bar[XB_XCNT(b.x)], 1u);
    return b;
}
DI void xcd_barrier_complete(unsigned* bar, unsigned x, unsigned& nloc, unsigned& nx) {
    const unsigned G = gridDim.x * gridDim.y * gridDim.z;
    unsigned sum, cnt, mine, sp = 0u;
    for (;;) {
        sum = 0u; cnt = 0u; mine = 0u;
#pragma unroll
        for (unsigned j = 0; j < 16; ++j) { const unsigned c = xb_ld(&bar[XB_XCNT(j)]); sum += c; cnt += (c > 0u) ? 1u : 0u; mine = (j == x) ? c : mine; }
        if (sum == G) break;
        __builtin_amdgcn_s_sleep(1);
        if ((++sp & 255u) == 0u) { if (xb_ld(&bar[XB_TMO])) break; if (sp > XB_SPIN_CAP) { atomicAdd(&bar[XB_TMO], 1u); break; } }
    }
    nloc = mine > 0u ? mine : 1u; nx = cnt > 0u ? cnt : 1u;
}
DI void xcd_barrier(const XcdBarrier& b, bool t0) {
    asm volatile("s_waitcnt vmcnt(0)" ::: "memory");
    __syncthreads();
    if (t0) {
        unsigned* bar = b.bar;
        __builtin_amdgcn_s_waitcnt(0);
        unsigned nloc = b.st[0], nx = b.st[1];
        if (nloc == 0u) { xcd_barrier_complete(bar, b.x, nloc, nx); b.st[0] = nloc; b.st[1] = nx; }
        const unsigned old = xb_add(&bar[XB_XSUB(b.x)], 1u);
        const unsigned gen = old / nloc;
        if (old + 1u == (gen + 1u) * nloc) {
            __builtin_amdgcn_fence(__ATOMIC_RELEASE, "agent");
            asm volatile("s_waitcnt vmcnt(0)" ::: "memory");
            const unsigned og = xb_add(&bar[XB_TOP], 1u);
            const unsigned tg = og / nx;
            if (og + 1u == (tg + 1u) * nx) xb_add(&bar[XB_TOPGEN], 1u);
            else XB_SPIN(xb_ld(&bar[XB_TOPGEN]) == tg, bar);
            __builtin_amdgcn_fence(__ATOMIC_ACQUIRE, "agent");
            xb_add(&bar[XB_XGEN(b.x)], 1u);
            asm volatile("s_waitcnt vmcnt(0)" ::: "memory");
        } else {
            XB_SPIN(xb_ld(&bar[XB_XGEN(b.x)]) == gen, bar);
            __builtin_amdgcn_fence(__ATOMIC_ACQUIRE, "agent");
            asm volatile("s_waitcnt vmcnt(0)" ::: "memory");
        }
    }
    __syncthreads();
}

namespace pg8 {
constexpr int BM = 256, BK = 64, HALF = 128, HTB = HALF * BK * 2, STAGE_BYTES = 8 * HTB, NXCD = 8, WGM = 8;
DI int lds_byte(int r, int c) { const int st = (r >> 4) * 2 + (c >> 5), rr = r & 15, cc = c & 31, ob = rr * 64 + cc * 2; return st * 1024 + (ob ^ (((ob >> 9) & 1) << 5)); }
DI void stage_rc(int b, int& R, int& C) { const int st = b / 1024, sb = b % 1024, swz = sb ^ (((sb >> 9) & 1) << 5); R = (st >> 1) * 16 + swz / 64; C = (st & 1) * 32 + (swz % 64) / 2; }
DI int perm32(int rho) { const int n = rho >> 4, i = rho & 15; return 8 * (i >> 2) + 4 * n + (i & 3); }
struct Unit { int pm, pn; const char* a; const char* b; int e, r0, cnt; };

struct DenseOrder {
    int nM, nN, nwg, G, c; const char* A; const char* Bt; size_t tstep; int skipctx;
    DI void init(const bf16_t* A_, const bf16_t* Bt_, int M, int N, int K, int G_, int c_, int skipctx_ = 0) { skipctx = skipctx_; nM = skipctx ? (M / BM) / 17 * 16 : M / BM; nN = N / BM; nwg = nM * nN; G = G_; c = c_; A = (const char*)A_; Bt = (const char*)Bt_; tstep = (size_t)BM * K * 2; }
    DI bool next(int i, Unit& u) const {
        const long L = (long)i * G + c; if (L >= nwg) return false;
        int wgid = (int)L; { const int q = nwg / NXCD, r = nwg % NXCD, xcd = wgid % NXCD, off = wgid / NXCD; wgid = (xcd < r ? xcd * (q + 1) : r * (q + 1) + (xcd - r) * q) + off; }
        const int nig = WGM * nN, gid = wgid / nig, fm = gid * WGM, gsz = (nM - fm) < WGM ? (nM - fm) : WGM;
        u.pm = fm + ((wgid % nig) % gsz); if (skipctx) u.pm = (u.pm >> 4) * 17 + 1 + (u.pm & 15); u.pn = (wgid % nig) / gsz; u.a = A + (size_t)u.pm * tstep; u.b = Bt + (size_t)u.pn * tstep; u.e = 0; u.r0 = 0; u.cnt = 0; return true;
    }
    DI void aoff(const Unit&, int K, const int (&R)[2], const int (&C)[2], unsigned (&va)[2][2]) const {
#pragma unroll
        for (int h = 0; h < 2; ++h)
#pragma unroll
            for (int i = 0; i < 2; ++i) va[h][i] = (unsigned)((R[i] + HALF * h) * K + C[i]) * 2u;
    }
};

template <class Epi, class Sched, bool FP8 = false>
DI void gemm_phase(LAS unsigned char* lds, const int K, const Sched& S, const Epi& E, const int tid) {
    const int wid = __builtin_amdgcn_readfirstlane(tid >> 6), lane = tid & 63, wr = wid >> 2, wc = wid & 3, fr = lane & 15, fq = lane >> 4;
    const int nt = K / BK;
    int Rr[2], Cc[2]; unsigned vb[2][2];
#pragma unroll
    for (int i = 0; i < 2; ++i) { stage_rc(tid * 16 + i * 8192, Rr[i], Cc[i]); const int Rb = Epi::PERM ? ((Rr[i] & ~31) + perm32(Rr[i] & 31)) : Rr[i];
#pragma unroll
        for (int h = 0; h < 2; ++h) vb[h][i] = (unsigned)((Rb + HALF * h) * K + Cc[i]) * 2u; }
    const size_t kstep = (size_t)(BK * 2);
    const unsigned ldsw = (unsigned)wid * 1024u;
    const int aoff = lds_byte(wr * 64 + fr, fq * 8), boff = lds_byte(wc * 32 + fr, fq * 8);
#define PG8_SA(b, h) (((b) * 2 + (h)) * HTB)
#define PG8_SB(b, h) ((4 + (b) * 2 + (h)) * HTB)
#define PG8_STAGE(bufoff, gbase, voff) do { _Pragma("unroll") for (int _i = 0; _i < 2; ++_i) \
        __builtin_amdgcn_global_load_lds((const unsigned*)((const char*)(gbase) + (voff)[_i]), (LAS unsigned*)(lds + (bufoff) + ldsw + _i * 8192), 16, 0, 0); } while (0)
#define PG8_LDA(dst, b, h) do { _Pragma("unroll") for (int m = 0; m < 4; ++m) { const i32x4 l_ = *(const LAS i32x4*)(lds + PG8_SA(b, h) + aoff + m * 2048); const i32x4 h_ = *(const LAS i32x4*)(lds + PG8_SA(b, h) + aoff + m * 2048 + 1024); dst[m] = __builtin_shufflevector(l_, h_, 0, 1, 2, 3, 4, 5, 6, 7); } } while (0)
#define PG8_LDB(dst, b, h) do { _Pragma("unroll") for (int n = 0; n < 2; ++n) { const i32x4 l_ = *(const LAS i32x4*)(lds + PG8_SB(b, h) + boff + n * 2048); const i32x4 h_ = *(const LAS i32x4*)(lds + PG8_SB(b, h) + boff + n * 2048 + 1024); dst[n] = __builtin_shufflevector(l_, h_, 0, 1, 2, 3, 4, 5, 6, 7); } } while (0)
#define PG8_LO(v) __builtin_bit_cast(bf16x8, __builtin_shufflevector(v, v, 0, 1, 2, 3))
#define PG8_HI(v) __builtin_bit_cast(bf16x8, __builtin_shufflevector(v, v, 4, 5, 6, 7))
#define PG8_MMA(ai, bj, At, Bt) do { __builtin_amdgcn_s_setprio(1); _Pragma("unroll") for (int m = 0; m < 4; ++m) _Pragma("unroll") for (int n = 0; n < 2; ++n) { \
        if constexpr (FP8) asm volatile("v_mfma_scale_f32_16x16x128_f8f6f4 %0, %1, %2, %0, %3, %3 op_sel_hi:[0,0,0]" : "+v"(acc[ai][bj][m][n]) : "v"(Bt[n]), "v"(At[m]), "v"(fp8_unit_scale)); \
        else { acc[ai][bj][m][n] = __builtin_amdgcn_mfma_f32_16x16x32_bf16(PG8_LO(Bt[n]), PG8_LO(At[m]), acc[ai][bj][m][n], 0, 0, 0); \
               acc[ai][bj][m][n] = __builtin_amdgcn_mfma_f32_16x16x32_bf16(PG8_HI(Bt[n]), PG8_HI(At[m]), acc[ai][bj][m][n], 0, 0, 0); } } __builtin_amdgcn_s_setprio(0); } while (0)
#define PG8_WAIT_V(n) asm volatile("s_waitcnt vmcnt(" #n ")" ::: "memory")
#define PG8_WAIT_L(n) asm volatile("s_waitcnt lgkmcnt(" #n ")" ::: "memory")
#define PG8_BAR __builtin_amdgcn_s_barrier()
#define PG8_SCHED __builtin_amdgcn_sched_barrier(0)
    Unit cur, nxt; int ui = 0;
    if (!S.next(0, cur)) return;
    f32x4 acc[2][2][4][2];
#pragma unroll
    for (int a = 0; a < 2; ++a)
#pragma unroll
        for (int b = 0; b < 2; ++b)
#pragma unroll
            for (int m = 0; m < 4; ++m)
#pragma unroll
                for (int n = 0; n < 2; ++n) acc[a][b][m][n] = (f32x4){0.f, 0.f, 0.f, 0.f};
    i32x8 At[4], B0[2], B1[2];
    const int fp8_unit_scale = 0x7f7f7f7f;
    unsigned vac[2][2], van[2][2];
    S.aoff(cur, K, Rr, Cc, vac);
    const char* cA = cur.a; const char* cB = cur.b;
    PG8_STAGE(PG8_SB(0, 0), cB, vb[0]); PG8_STAGE(PG8_SB(0, 1), cB, vb[1]); PG8_STAGE(PG8_SA(0, 0), cA, vac[0]); PG8_STAGE(PG8_SA(0, 1), cA, vac[1]);
    if (wr == 1) PG8_BAR;
    PG8_WAIT_V(2); PG8_BAR;
    PG8_STAGE(PG8_SB(1, 0), cB + kstep, vb[0]); PG8_STAGE(PG8_SA(1, 0), cA + kstep, vac[0]); PG8_STAGE(PG8_SB(1, 1), cB + kstep, vb[1]);
    PG8_WAIT_V(6); PG8_BAR;
    for (;;) {
        const bool has_next = S.next(ui + 1, nxt);
        const char* nA = has_next ? nxt.a : cA; const char* nB = has_next ? nxt.b : cB;
        if (has_next) S.aoff(nxt, K, Rr, Cc, van);
        else {
#pragma unroll
            for (int h = 0; h < 2; ++h)
#pragma unroll
                for (int i = 0; i < 2; ++i) van[h][i] = vac[h][i]; }
#pragma nounroll
        for (int t = 0; t < nt; t += 2) {
            const bool last = (t == nt - 2);
            const char* a1 = cA + (size_t)(t + 1) * kstep;
            const char* a2 = last ? nA : cA + (size_t)(t + 2) * kstep; const char* b2 = last ? nB : cB + (size_t)(t + 2) * kstep;
            const char* a3 = a2 + kstep; const char* b3 = b2 + kstep;
            unsigned v2[2][2];
#pragma unroll
            for (int h = 0; h < 2; ++h)
#pragma unroll
                for (int i = 0; i < 2; ++i) v2[h][i] = last ? van[h][i] : vac[h][i];
            PG8_LDB(B0, 0, 0); PG8_LDB(B1, 0, 1); PG8_SCHED; PG8_LDA(At, 0, 0); PG8_STAGE(PG8_SA(1, 1), a1, vac[1]);
            PG8_WAIT_V(8); PG8_WAIT_L(0); PG8_BAR; PG8_MMA(0, 0, At, B0); PG8_MMA(0, 1, At, B1); PG8_BAR; PG8_SCHED;
            PG8_LDA(At, 0, 1); PG8_STAGE(PG8_SB(0, 0), b2, vb[0]); PG8_STAGE(PG8_SB(0, 1), b2, vb[1]); PG8_STAGE(PG8_SA(0, 0), a2, v2[0]);
            PG8_WAIT_V(8); PG8_WAIT_L(0); PG8_BAR; PG8_MMA(1, 0, At, B0); PG8_MMA(1, 1, At, B1); PG8_BAR; PG8_SCHED;
            PG8_LDB(B0, 1, 0); PG8_LDB(B1, 1, 1); PG8_SCHED; PG8_LDA(At, 1, 0); PG8_STAGE(PG8_SA(0, 1), a2, v2[1]);
            PG8_WAIT_V(8); PG8_WAIT_L(0); PG8_BAR; PG8_MMA(0, 0, At, B0); PG8_MMA(0, 1, At, B1); PG8_BAR; PG8_SCHED;
            PG8_LDA(At, 1, 1); PG8_STAGE(PG8_SB(1, 0), b3, vb[0]); PG8_STAGE(PG8_SB(1, 1), b3, vb[1]); PG8_STAGE(PG8_SA(1, 0), a3, v2[0]);
            PG8_WAIT_V(8); PG8_WAIT_L(0); PG8_BAR; PG8_MMA(1, 0, At, B0); PG8_MMA(1, 1, At, B1); PG8_BAR; PG8_SCHED;
        }
        if (wr == 0) PG8_BAR;
        if constexpr (FP8) asm volatile("s_nop 15\n\ts_nop 15\n\ts_nop 15" ::: "memory");
        E(acc, cur, wr, wc, fr, fq);
        if (!has_next) break;
#pragma unroll
        for (int a = 0; a < 2; ++a)
#pragma unroll
            for (int b = 0; b < 2; ++b)
#pragma unroll
                for (int m = 0; m < 4; ++m)
#pragma unroll
                    for (int n = 0; n < 2; ++n) acc[a][b][m][n] = (f32x4){0.f, 0.f, 0.f, 0.f};
        cur = nxt; cA = nA; cB = nB; ++ui;
#pragma unroll
        for (int h = 0; h < 2; ++h)
#pragma unroll
            for (int i = 0; i < 2; ++i) vac[h][i] = van[h][i];
        if (wr == 1) PG8_BAR;
    }
    PG8_WAIT_V(0);
    PG8_BAR;
#undef PG8_SA
#undef PG8_SB
#undef PG8_STAGE
#undef PG8_LDA
#undef PG8_LDB
#undef PG8_MMA
#undef PG8_WAIT_V
#undef PG8_WAIT_L
#undef PG8_BAR
#undef PG8_SCHED
}

struct EpiBf16 {
    static constexpr bool PERM = true;
    bf16_t* O; int ldc; int split_cols; size_t split_stride; int qtiles; float qs; float os;
    DI void operator()(const f32x4 (&acc)[2][2][4][2], const Unit& u, int wr, int wc, int fr, int fq) const {
        const int row0 = u.pm * BM + wr * 64 + fr; int colt = u.pn * BM; bf16_t* base = O;
        if (split_cols) { const int t = colt / split_cols; base += (size_t)t * split_stride; colt -= t * split_cols; }
        const int col0 = colt + wc * 32 + 8 * fq; const float sc = ((u.pn < qtiles) ? qs : 1.0f) * os;
#pragma unroll
        for (int ai = 0; ai < 2; ++ai)
#pragma unroll
            for (int m = 0; m < 4; ++m) { bf16_t* rowp = base + (size_t)(row0 + ai * HALF + m * 16) * ldc + col0;
#pragma unroll
                for (int bj = 0; bj < 2; ++bj) { const f32x4 v0 = acc[ai][bj][m][0] * sc, v1 = acc[ai][bj][m][1] * sc;
                    u32x4 w; w.x = pk2(v0[0], v0[1]); w.y = pk2(v0[2], v0[3]); w.z = pk2(v1[0], v1[1]); w.w = pk2(v1[2], v1[3]);
                    *(u32x4*)(rowp + bj * HALF) = w; } }
    }
};
struct EpiBf16Rope {
    static constexpr bool PERM = true;
    bf16_t* O; const float* rope; float os;
    DI void operator()(const f32x4 (&acc)[2][2][4][2], const Unit& u, int wr, int wc, int fr, int fq) const {
        const int row0 = u.pm * BM + wr * 64 + fr; const int col0 = u.pn * BM + wc * 32 + 8 * fq;
        const int jj = u.pm % 17; const bool dorope = (u.pn < 8) && (jj != 0);
        const float qs = ((u.pn < 4) ? 0.125f * 1.4426950408889634f : 1.0f) * os;
        const bool first = fq < 2; const int fbase = 8 * (fq & 1);
        auto body = [&](const int ai, const int m, const f32x4 t0, const f32x4 t1, const f32x4 t2, const f32x4 t3) {
            bf16_t* rowp = O + (size_t)(row0 + ai * HALF + m * 16) * 3072 + col0;
            const float cs[8] = {t0[0], t0[2], t1[0], t1[2], t2[0], t2[2], t3[0], t3[2]}, sn[8] = {t0[1], t0[3], t1[1], t1[3], t2[1], t2[3], t3[1], t3[3]};
#pragma unroll
            for (int bj = 0; bj < 2; ++bj) { f32x4 v0 = acc[ai][bj][m][0], v1 = acc[ai][bj][m][1];
                if (dorope) {
                    float x[8] = {v0[0], v0[1], v0[2], v0[3], v1[0], v1[1], v1[2], v1[3]};
#pragma unroll
                    for (int e = 0; e < 8; ++e) { const float p = __shfl_xor(x[e], 32); x[e] = first ? (x[e] * cs[e] - p * sn[e]) : (x[e] * cs[e] + p * sn[e]); }
                    v0 = (f32x4){x[0], x[1], x[2], x[3]}; v1 = (f32x4){x[4], x[5], x[6], x[7]};
                }
                v0 = v0 * qs; v1 = v1 * qs;
                u32x4 w; w.x = pk2(v0[0], v0[1]); w.y = pk2(v0[2], v0[3]); w.z = pk2(v1[0], v1[1]); w.w = pk2(v1[2], v1[3]);
                *(u32x4*)(rowp + bj * HALF) = w; }
        };
        if (wc & 1) {
            f32x4 tab[4][4];
#pragma unroll
            for (int m = 0; m < 4; ++m) { const float* tb = rope + ((dorope ? (16 * m + fr) : 0) * 16 + fbase) * 2;
#pragma unroll
                for (int q = 0; q < 4; ++q) tab[m][q] = *(const f32x4*)(tb + 4 * q); }
            __builtin_amdgcn_sched_barrier(0);
#pragma unroll
            for (int ai = 0; ai < 2; ++ai)
#pragma unroll
                for (int m = 0; m < 4; ++m) body(ai, m, tab[m][0], tab[m][1], tab[m][2], tab[m][3]);
        } else {
            f32x4 tab[2][4];
#pragma unroll
            for (int ai = 0; ai < 2; ++ai) { const float* tb = rope + ((dorope ? ((jj - 1) * 4 + 2 * ai + wr) : 0) * 16 + fbase) * 2;
#pragma unroll
                for (int q = 0; q < 4; ++q) tab[ai][q] = *(const f32x4*)(tb + 4 * q); }
            __builtin_amdgcn_sched_barrier(0);
#pragma unroll
            for (int ai = 0; ai < 2; ++ai)
#pragma unroll
                for (int m = 0; m < 4; ++m) body(ai, m, tab[ai][0], tab[ai][1], tab[ai][2], tab[ai][3]);
        }
    }
};
struct EpiMoE1 {
    static constexpr bool PERM = true;
    unsigned char* O;
    DI void operator()(const f32x4 (&acc)[2][2][4][2], const Unit& u, int wr, int wc, int fr, int fq) const {
        const int row0 = u.pm * BM + wr * 64 + fr; const int col0 = (u.pn * BM + wc * 32 + 8 * fq) >> 1;
        const float is = 1.0f / 32.0f;
#pragma unroll
        for (int ai = 0; ai < 2; ++ai)
#pragma unroll
            for (int m = 0; m < 4; ++m) { unsigned char* rowp = O + (size_t)(row0 + ai * HALF + m * 16) * MOE_H + col0;
#pragma unroll
                for (int bj = 0; bj < 2; ++bj) { const f32x4 a = acc[ai][bj][m][0] * is, b = acc[ai][bj][m][1] * (is * 8.0f);
                    *(unsigned*)(rowp + bj * (HALF / 2)) = pk4_fp8(silu_f(a[0]) * b[0], silu_f(a[1]) * b[1], silu_f(a[2]) * b[2], silu_f(a[3]) * b[3]); } }
    }
};
struct EpiMoE2 {
    static constexpr bool PERM = true;
    unsigned char* O;
    DI void operator()(const f32x4 (&acc)[2][2][4][2], const Unit& u, int wr, int wc, int fr, int fq) const {
        const int row0 = u.pm * BM + wr * 64 + fr; const int col0 = u.pn * BM + wc * 32 + 8 * fq;
        const float is = 16.0f / 256.0f;
#pragma unroll
        for (int ai = 0; ai < 2; ++ai)
#pragma unroll
            for (int m = 0; m < 4; ++m) { unsigned char* rowp = O + (size_t)(row0 + ai * HALF + m * 16) * D + col0;
#pragma unroll
                for (int bj = 0; bj < 2; ++bj) { const f32x4 v0 = acc[ai][bj][m][0] * is, v1 = acc[ai][bj][m][1] * is;
                    u32x2 w; w.x = pk4_fp8(v0[0], v0[1], v0[2], v0[3]); w.y = pk4_fp8(v1[0], v1[1], v1[2], v1[3]);
                    *(u32x2*)(rowp + bj * HALF) = w; } }
    }
};
struct EpiResid {
    static constexpr bool PERM = false;
    bf16_t* XS; const float* modv_gate; float os;
    DI void operator()(const f32x4 (&acc)[2][2][4][2], const Unit& u, int wr, int wc, int fr, int fq) const {
        const int row0 = u.pm * BM + wr * 64 + fr, col0 = u.pn * BM + wc * 32 + 4 * fq;
        const int bb = u.pm / 17, jj = u.pm - bb * 17; const int mr = (jj == 0) ? 8 : bb;
        const float* gp = modv_gate + (size_t)mr * 6144 + col0;
        f32x4 gv[2][2];
#pragma unroll
        for (int bj = 0; bj < 2; ++bj)
#pragma unroll
            for (int n = 0; n < 2; ++n) gv[bj][n] = *(const f32x4*)(gp + bj * HALF + n * 16) * os;
        u32x2 ro[2][4][2][2];
#pragma unroll
        for (int ai = 0; ai < 2; ++ai)
#pragma unroll
            for (int m = 0; m < 4; ++m) { const bf16_t* rowp = XS + (size_t)(row0 + ai * HALF + m * 16) * D + col0;
#pragma unroll
                for (int bj = 0; bj < 2; ++bj)
#pragma unroll
                    for (int n = 0; n < 2; ++n) ro[ai][m][bj][n] = *(const u32x2*)(rowp + bj * HALF + n * 16); }
        __builtin_amdgcn_sched_barrier(0);
#pragma unroll
        for (int ai = 0; ai < 2; ++ai)
#pragma unroll
            for (int m = 0; m < 4; ++m) { bf16_t* rowp = XS + (size_t)(row0 + ai * HALF + m * 16) * D + col0;
#pragma unroll
                for (int bj = 0; bj < 2; ++bj)
#pragma unroll
                    for (int n = 0; n < 2; ++n) { u32x2* p = (u32x2*)(rowp + bj * HALF + n * 16); const u32x2 o = ro[ai][m][bj][n]; const f32x4 a = acc[ai][bj][m][n], g = gv[bj][n];
                        u32x2 w; w.x = pk2(bflo(o.x) + g[0] * a[0], bfhi(o.x) + g[1] * a[1]); w.y = pk2(bflo(o.y) + g[2] * a[2], bfhi(o.y) + g[3] * a[3]); *p = w; } }
    }
};
}

struct Args { const float* in[33]; float* out; unsigned char* ws; int ph_lo, ph_hi; };
struct Frame {
    LAS unsigned char* lds;
    unsigned char* ws;
    const float* const* in;
    float* out;
    int tid, lane, wave, G, bid;
};
#define IN_X 0
#define IN_C 1
#define IN_CTX 2
#define IN_CCTX 3
#define IN_MODW 4
#define IN_MODB 5
#define IN_NORMG 6
#define IN_FINALG 7
#define IN_NAQKV 8
#define IN_NAO 9
#define IN_NARPB 10
#define IN_MLUP 11
#define IN_MLCONVW 12
#define IN_MLCONVB 13
#define IN_MLWQ 14
#define IN_MLWK 15
#define IN_MLWV 16
#define IN_MLWGATE 17
#define IN_MLBGATE 18
#define IN_MLGNW 19
#define IN_MLSKIP 20
#define IN_MLDOWN 21
#define IN_DAQKV 22
#define IN_DALAM 23
#define IN_DASUBLN 24
#define IN_DAO 25
#define IN_MOEWG 26
#define IN_MOEBG 27
#define IN_MOEWR 28
#define IN_MOEBR 29
#define IN_MOEW1 30
#define IN_MOEW3 31
#define IN_MOEW2 32

DI void transpose_item(const float* W, int ldw, int K, bf16_t* WT, int k0, int n0src, int n0dst, LAS float* scr, int lane) {
#pragma unroll
    for (int i = 0; i < 32; ++i) { const int kk = 2 * i + (lane >> 5); scr[kk * 33 + (lane & 31)] = W[(size_t)(k0 + kk) * ldw + n0src + (lane & 31)]; }
    asm volatile("s_waitcnt lgkmcnt(0)" ::: "memory");
    const int c = lane & 7;
#pragma unroll
    for (int j = 0; j < 4; ++j) { const int n = (lane >> 3) + 8 * j; const LAS float* s = scr + (8 * c) * 33 + n;
        u32x4 o; o.x = pk2(s[0 * 33], s[1 * 33]); o.y = pk2(s[2 * 33], s[3 * 33]); o.z = pk2(s[4 * 33], s[5 * 33]); o.w = pk2(s[6 * 33], s[7 * 33]);
        *(u32x4*)(WT + (size_t)(n0dst + n) * K + k0 + 8 * c) = o; }
    asm volatile("s_waitcnt lgkmcnt(0)" ::: "memory");
}
DI void convert_matrix(Frame& F, const float* W, int K, int N, bf16_t* WT, int gw0, int ngw, LAS float* scr) {
    const int nblk = N / 32, nitems = (K / 64) * nblk;
    for (int it = gw0; it < nitems; it += ngw) { const int kb = it / nblk, nb = it - kb * nblk; transpose_item(W, N, K, WT, kb * 64, nb * 32, nb * 32, scr, F.lane); }
}
template <class RowMap>
DI void transpose_item_fp8(const float* W, int ldw, int K, unsigned char* WT, int k0, int n0src, const RowMap& drow, LAS float* scr, int lane) {
#pragma unroll
    for (int i = 0; i < 32; ++i) { const int kk = 2 * i + (lane >> 5); scr[kk * 33 + (lane & 31)] = W[(size_t)(k0 + kk) * ldw + n0src + (lane & 31)] * 32.0f; }
    asm volatile("s_waitcnt lgkmcnt(0)" ::: "memory");
    const int n = lane >> 1, hf = lane & 1; const LAS float* sp = scr + (32 * hf) * 33 + n;
    u32x4 o0, o1;
    o0.x = pk4_fp8(sp[0 * 33], sp[1 * 33], sp[2 * 33], sp[3 * 33]); o0.y = pk4_fp8(sp[4 * 33], sp[5 * 33], sp[6 * 33], sp[7 * 33]);
    o0.z = pk4_fp8(sp[8 * 33], sp[9 * 33], sp[10 * 33], sp[11 * 33]); o0.w = pk4_fp8(sp[12 * 33], sp[13 * 33], sp[14 * 33], sp[15 * 33]);
    o1.x = pk4_fp8(sp[16 * 33], sp[17 * 33], sp[18 * 33], sp[19 * 33]); o1.y = pk4_fp8(sp[20 * 33], sp[21 * 33], sp[22 * 33], sp[23 * 33]);
    o1.z = pk4_fp8(sp[24 * 33], sp[25 * 33], sp[26 * 33], sp[27 * 33]); o1.w = pk4_fp8(sp[28 * 33], sp[29 * 33], sp[30 * 33], sp[31 * 33]);
    unsigned char* dp = WT + (size_t)drow(n0src + n) * K + k0 + 32 * hf;
    *(u32x4*)dp = o0; *(u32x4*)(dp + 16) = o1;
    asm volatile("s_waitcnt lgkmcnt(0)" ::: "memory");
}
DI void convert_matrix_fp8(Frame& F, const float* W, int K, int N, unsigned char* WT, int gw0, int ngw, LAS float* scr) {
    const int nblk = N / 32, nitems = (K / 64) * nblk;
    auto rm = [&](int col) -> int { return col; };
    for (int it = gw0; it < nitems; it += ngw) { const int kb = it / nblk, nb = it - kb * nblk; transpose_item_fp8(W, N, K, WT, kb * 64, nb * 32, rm, scr, F.lane); }
}
DI void convert_moe(Frame& F, int layer, int gw0, int ngw, LAS float* scr) {
    const float* w1 = F.in[IN_MOEW1] + (size_t)layer * NEXP * D * MOE_H;
    const float* w3 = F.in[IN_MOEW3] + (size_t)layer * NEXP * D * MOE_H;
    const float* w2 = F.in[IN_MOEW2] + (size_t)layer * NEXP * MOE_H * D;
    unsigned char* W13T = F.ws + WS_WMOE13; unsigned char* W2T = F.ws + WS_WMOE2;
    const int per_mat = 16 * 16, per_e13 = 2 * per_mat, per_e2 = 8 * 32, per_e = per_e13 + per_e2, nitems = NEXP * per_e;
    const int lane = F.lane;
    for (int it = gw0; it < nitems; it += ngw) {
        const int e = it / per_e; int r = it - e * per_e;
        if (r < per_e13) {
            const int which = r / per_mat; r -= which * per_mat; const int kb = r >> 4, nb = r & 15;
            const float* W = (which ? w3 : w1) + (size_t)e * D * MOE_H;
            auto rm = [&](int col) -> int { return 8 * (col >> 2) + (col & 3) + 4 * which; };
            transpose_item_fp8(W, MOE_H, D, W13T + (size_t)e * 1024 * D, kb * 64, nb * 32, rm, scr, lane);
        } else {
            r -= per_e13; const int kb = r >> 5, nb = r & 31;
            auto rm = [&](int col) -> int { return col; };
            transpose_item_fp8(w2 + (size_t)e * MOE_H * D, D, MOE_H, W2T + (size_t)e * D * MOE_H, kb * 64, nb * 32, rm, scr, lane);
        }
    }
}

DI void convert_moe_in_tail(Frame& F, int layer, int nwg) {
    const int rem = nwg % F.G;
    if (F.bid < rem) return;
    __syncthreads();
    LAS float* scr = (LAS float*)(F.lds + F.wave * 16384);
    convert_moe(F, layer, (F.bid - rem) * 8 + F.wave, (F.G - rem) * 8, scr);
}

template <class Fn>
DI void in_gemm_tail(Frame& F, int nwg, Fn fn) {
    const int rem = nwg % F.G;
    if (F.bid < rem) return;
    __syncthreads();
    fn((F.bid - rem) * 8 + F.wave, (F.G - rem) * 8, (LAS float*)(F.lds + F.wave * 16384));
}

DI void phase_prologue(Frame& F) {
#ifdef TLB_TOUCH
    {
        const int gt = F.bid * 512 + F.tid, NTT = F.G * 512; unsigned acc = 0u;
        const int idxs[9] = {IN_X, IN_MODW, IN_NAQKV, IN_MLUP, IN_MLDOWN, IN_DAQKV, IN_MOEW1, IN_MOEW3, IN_MOEW2};
        const size_t lens[9] = {(size_t)NB * SEQ * D, (size_t)4 * D * 6144, (size_t)2 * D * 3072, (size_t)D * 4096, (size_t)ML_INNER * D, (size_t)D * 3072, (size_t)4 * NEXP * D * MOE_H, (size_t)4 * NEXP * D * MOE_H, (size_t)4 * NEXP * MOE_H * D};
#pragma unroll
        for (int a = 0; a < 9; ++a) { const unsigned* p = (const unsigned*)F.in[idxs[a]]; const size_t npages = lens[a] / 1024;
            for (size_t pg = gt; pg < npages; pg += NTT) acc ^= __builtin_nontemporal_load(p + pg * 1024); }
        if (acc == 0x12345678u) ((unsigned*)(F.ws + WS_CTL))[3000] = acc;
    }
#endif
    LAS float* scr = (LAS float*)(F.lds + F.wave * 16384);
    const int gw = F.bid * 8 + F.wave, NGW = F.G * 8;
    convert_matrix_fp8(F, F.in[IN_NAQKV], D, 3072, F.ws + WS_WNAQKV, gw, NGW, scr);
    convert_matrix_fp8(F, F.in[IN_NAO], D, D, F.ws + WS_WNAO, gw, NGW, scr);
    {
        bf16_t* WrT = (bf16_t*)(F.ws + WS_MISC);
        const int gt = F.bid * 512 + F.tid, NT = F.G * 512;
        for (int i = gt; i < 4 * 48 * 1024; i += NT) {
            const int l = i / (48 * 1024), r = i - l * 48 * 1024, n = r >> 10, k = r & 1023; float v = 0.f;
            if (n < 4) v = F.in[IN_MOEWG][((size_t)l * D + k) * 4 + n]; else if (n < 36) v = F.in[IN_MOEWR][((size_t)l * D + k) * 32 + (n - 4)];
            WrT[i] = (bf16_t)(pk2(v, 0.f) & 0xffffu);
        }
        bf16_t* WGt = (bf16_t*)(F.ws + WS_MISC + 512 * 1024);
        const float* wq = F.in[IN_MLWQ]; const float* wk = F.in[IN_MLWK]; const float* wv = F.in[IN_MLWV]; const float* wg = F.in[IN_MLWGATE];
        for (int i = gt; i < 16 * 4096; i += NT) {
            const int n = i >> 12, k = i & 4095; float v = 0.f;
            if (k < 2048) { const int g = k >> 2, ii = k & 3;
                for (int o = 0; o < 4; ++o) v += wq[g * 16 + ii * 4 + o] * wg[(size_t)(4 * g + o) * 16 + n] + wk[g * 16 + ii * 4 + o] * wg[(size_t)(2048 + 4 * g + o) * 16 + n];
            } else { const int kk = k - 2048, g = kk >> 2, ii = kk & 3;
                for (int o = 0; o < 4; ++o) v += wv[g * 16 + ii * 4 + o] * wg[(size_t)(4096 + 4 * g + o) * 16 + n]; }
            WGt[i] = (bf16_t)(pk2(v, 0.f) & 0xffffu);
        }
        float* rope = (float*)(F.ws + WS_MISC + 768 * 1024);
        for (int i = gt; i < 64 * 16; i += NT) { const int pos = i >> 4, f = i & 15; const float fr = powf(10000.0f, -(float)(2 * f) / 32.0f); const float ang = (float)pos * fr;
            rope[2 * i] = cosf(ang); rope[2 * i + 1] = sinf(ang); }
    }
    {
        __syncthreads();
        LAS float* sc = (LAS float*)F.lds;
        LAS float* red = (LAS float*)(F.lds + 40960);
        for (int i = F.tid; i < 9 * 1024; i += 512) { const int r = i >> 10, k = i & 1023; const float v = (r < 8) ? F.in[IN_C][r * 1024 + k] : F.in[IN_CCTX][k]; sc[i] = silu_f(v); }
        __syncthreads();
        float* modv = (float*)(F.ws + WS_MODV);
        const int c4 = (F.tid & 31) * 4, ks = F.tid >> 5;
        for (int it = F.bid; it < 4 * 48; it += F.G) {
            const int l = it / 48, n0 = (it - l * 48) * 128;
            const float* W = F.in[IN_MODW] + (size_t)l * D * 6144 + n0 + c4;
            f32x4 a[9];
#pragma unroll
            for (int r = 0; r < 9; ++r) a[r] = f32x4{0.f, 0.f, 0.f, 0.f};
#pragma unroll 8
            for (int j = 0; j < 64; ++j) { const int k = j * 16 + ks; const f32x4 w = *(const f32x4*)(W + (size_t)k * 6144);
#pragma unroll
                for (int r = 0; r < 9; ++r) { const float sv = sc[r * 1024 + k]; a[r] += w * sv; } }
#pragma unroll
            for (int r = 0; r < 9; ++r) *(LAS f32x4*)(red + (ks * 9 + r) * 128 + c4) = a[r];
            __syncthreads();
            for (int i = F.tid; i < 9 * 128; i += 512) { const int r = i >> 7, c2 = i & 127; float sum = F.in[IN_MODB][l * 6144 + n0 + c2];
#pragma unroll
                for (int g = 0; g < 16; ++g) sum += red[(g * 9 + r) * 128 + c2];
                modv[((size_t)l * 9 + r) * 6144 + n0 + c2] = sum; }
            __syncthreads();
        }
    }
}

struct RouteRec { int e0, e1, r0, r1; float w0, w1; int p0, p1; };
#if SCAN_PROBE || PREP_PROBE || (PHASE_PROBE >= 0)
#define PROBE_SCALE (1.0f + sqrtf(((const float*)(F.ws + WS_CTL))[2048]))
#else
#define PROBE_SCALE 1.0f
#endif
template <int MODE>
DI void phase_modulate(Frame& F, int layer) {
    const int gw = F.bid * 8 + F.wave, NGW = F.G * 8, lane = F.lane;
    const int RPW = (T + NGW - 1) / NGW;
    const int r_begin = gw * RPW, r_end = (r_begin + RPW < T) ? r_begin + RPW : T;
    bf16_t* XS = (bf16_t*)(F.ws + WS_XS); bf16_t* HB = (bf16_t*)(F.ws + WS_HB);
    const float* modv = (const float*)(F.ws + WS_MODV);
    const RouteRec* route = (const RouteRec*)(F.ws + WS_ROUTE);
    const unsigned char* Y = F.ws + R_Y;
    const int sh_off = (MODE == 2) ? 3072 : 0, sc_off = sh_off + 1024;
    const float* ng = F.in[IN_NORMG] + (size_t)layer * 2 * D + ((MODE == 2) ? D : 0);
    constexpr bool COMB = (MODE == 1 || MODE == 3);
    constexpr int NR = COMB ? 4 : 4;
    int tb = 0;
    if (COMB) {
        const int pl = (MODE == 3) ? 3 : layer - 1;
        unsigned* cntp = (unsigned*)(F.ws + WS_CTL) + CW_CNT + pl * 32 * 64;
        int c = (lane < 32) ? (int)__hip_atomic_load(cntp + lane * 64, __ATOMIC_RELAXED, __HIP_MEMORY_SCOPE_AGENT) : 0;
        int ntl = (c + 255) >> 8, incl = ntl;
#pragma unroll
        for (int o = 1; o < 32; o <<= 1) { const int t = __shfl_up(incl, o); if ((lane & 31) >= o) incl += t; }
        tb = incl - ntl;
    }
    const float* gnp = (MODE == 3) ? F.in[IN_FINALG] : ng;
    f32x4 gnc[4], shc[4], scc[4]; int mr_c = -1;
#pragma unroll
    for (int j = 0; j < 4; ++j) { gnc[j] = *(const f32x4*)(gnp + 4 * lane + 256 * j); shc[j] = (f32x4){0.f, 0.f, 0.f, 0.f}; scc[j] = shc[j]; }
    for (int rb = r_begin; rb < r_end; rb += NR) {
        f32x4 v[NR][4]; int rr[NR]; bool ok[NR];
#pragma unroll
        for (int k = 0; k < NR; ++k) { ok[k] = rb + k < r_end; rr[k] = ok[k] ? rb + k : r_end - 1; if (MODE == 3 && rr[k] % TPB < NCTX) { ok[k] = false; rr[k] = (rr[k] / TPB) * TPB + NCTX; } }
#pragma unroll
        for (int k = 0; k < NR; ++k) {
            const int r = rr[k]; const int b = r / TPB, t = r - b * TPB; const bool isctx = t < NCTX;
            if (MODE == 0) { const float* src = isctx ? F.in[IN_CTX] + ((size_t)b * NCTX + t) * D : F.in[IN_X] + ((size_t)b * SEQ + (t - NCTX)) * D;
#pragma unroll
                for (int j = 0; j < 4; ++j) v[k][j] = *(const f32x4*)(src + 4 * lane + 256 * j);
            } else {
#pragma unroll
                for (int j = 0; j < 4; ++j) { const u32x2 u = *(const u32x2*)(XS + (size_t)r * D + 4 * lane + 256 * j); v[k][j] = (f32x4){bflo(u.x), bfhi(u.x), bflo(u.y), bfhi(u.y)}; }
            }
        }
        if (COMB) {
            const int pl = (MODE == 3) ? 3 : layer - 1;
            unsigned y0[NR][4], y1[NR][4]; float w0[NR], w1[NR];
#pragma unroll
            for (int k = 0; k < NR; ++k) {
                const RouteRec rec = route[rr[k]];
                const int s0 = __shfl(tb, rec.e0) * 256 + rec.r0, s1 = __shfl(tb, rec.e1) * 256 + rec.r1; w0[k] = rec.w0 * (1.0f / 16.0f); w1[k] = rec.w1 * (1.0f / 16.0f);
#pragma unroll
                for (int j = 0; j < 4; ++j) { y0[k][j] = *(const unsigned*)(Y + (size_t)s0 * D + 4 * lane + 256 * j); y1[k][j] = *(const unsigned*)(Y + (size_t)s1 * D + 4 * lane + 256 * j); }
            }
#pragma unroll
            for (int k = 0; k < NR; ++k) {
                const int r = rr[k]; const int b = r / TPB, t = r - b * TPB; const int mr = (t < NCTX) ? 8 : b;
                const float* g2 = modv + ((size_t)pl * 9 + mr) * 6144 + 5120;
#pragma unroll
                for (int j = 0; j < 4; ++j) {
                    const f32x4 gg = *(const f32x4*)(g2 + 4 * lane + 256 * j);
                    const f32x2 a01 = __builtin_amdgcn_cvt_pk_f32_fp8((int)y0[k][j], false), a23 = __builtin_amdgcn_cvt_pk_f32_fp8((int)y0[k][j], true);
                    const f32x2 b01 = __builtin_amdgcn_cvt_pk_f32_fp8((int)y1[k][j], false), b23 = __builtin_amdgcn_cvt_pk_f32_fp8((int)y1[k][j], true);
                    f32x4 yy; yy[0] = w0[k] * a01[0] + w1[k] * b01[0]; yy[1] = w0[k] * a01[1] + w1[k] * b01[1]; yy[2] = w0[k] * a23[0] + w1[k] * b23[0]; yy[3] = w0[k] * a23[1] + w1[k] * b23[1];
                    v[k][j] = v[k][j] + gg * yy;
                }
            }
        }
#pragma unroll
        for (int k = 0; k < NR; ++k) {
            if (!ok[k]) continue;
            const int r = rr[k]; const int b = r / TPB, t = r - b * TPB; const bool isctx = t < NCTX; const int mr = isctx ? 8 : b;
            if (MODE == 0 || MODE == 1) {
#pragma unroll
                for (int j = 0; j < 4; ++j) { u32x2 w; w.x = pk2(v[k][j][0], v[k][j][1]); w.y = pk2(v[k][j][2], v[k][j][3]); *(u32x2*)(XS + (size_t)r * D + 4 * lane + 256 * j) = w; }
            }
            float ss = 0.f;
#pragma unroll
            for (int j = 0; j < 4; ++j) ss += (v[k][j][0] * v[k][j][0] + v[k][j][1] * v[k][j][1]) + (v[k][j][2] * v[k][j][2] + v[k][j][3] * v[k][j][3]);
            const float rstd = 1.0f / sqrtf(wave_sum(ss) * (1.0f / D) + EPS);
            if (MODE == 3) {
                if (!isctx) { float* o = F.out + ((size_t)b * SEQ + (t - NCTX)) * D;
#pragma unroll
                    for (int j = 0; j < 4; ++j) *(f32x4*)(o + 4 * lane + 256 * j) = v[k][j] * rstd * gnc[j] * PROBE_SCALE; }
            } else {
                if (__builtin_amdgcn_readfirstlane(mr) != mr_c) { mr_c = __builtin_amdgcn_readfirstlane(mr); const float* mv = modv + ((size_t)layer * 9 + mr_c) * 6144;
#pragma unroll
                    for (int j = 0; j < 4; ++j) { shc[j] = *(const f32x4*)(mv + sh_off + 4 * lane + 256 * j); scc[j] = *(const f32x4*)(mv + sc_off + 4 * lane + 256 * j) + 1.0f; } }
#pragma unroll
                for (int j = 0; j < 4; ++j) {
                    const f32x4 o = v[k][j] * rstd * gnc[j] * scc[j] + shc[j];
                    if (MODE == 2 || (MODE == 1 && layer == 1)) { u32x2 w; w.x = pk2(o[0], o[1]); w.y = pk2(o[2], o[3]); *(u32x2*)(HB + (size_t)r * D + 4 * lane + 256 * j) = w; }
                    if (!(MODE == 1 && layer == 1)) *(unsigned*)(F.ws + WS_HB8 + (size_t)r * D + 4 * lane + 256 * j) = pk4_fp8(o[0], o[1], o[2], o[3]);
                }
            }
        }
    }
    if (MODE == 2) {
        asm volatile("s_waitcnt vmcnt(0)" ::: "memory");
        const bf16_t* WrT = (const bf16_t*)(F.ws + WS_MISC) + (size_t)layer * 48 * 1024;
        LAS float* lg = (LAS float*)(F.lds + F.wave * 3072);
        unsigned* cntp = (unsigned*)(F.ws + WS_CTL) + CW_CNT + layer * 32 * 64;
        RouteRec* routew = (RouteRec*)(F.ws + WS_ROUTE);
        int* idx = (int*)(F.ws + WS_ROUTE + 2 * MiB);
        const float* bg = F.in[IN_MOEBG] + layer * 4; const float* br = F.in[IN_MOEBR] + layer * 32;
        for (int t0 = r_begin; t0 < r_end; t0 += 16) {
            int ar = t0 + (lane & 15); if (ar >= r_end) ar = r_end - 1;
            const bf16_t* ap = HB + (size_t)ar * D + 8 * (lane >> 4);
            const bf16_t* bp = WrT + (size_t)(lane & 15) * D + 8 * (lane >> 4);
            f32x4 a0 = {0.f, 0.f, 0.f, 0.f}, a1 = a0, a2 = a0;
#pragma unroll 8
            for (int ks = 0; ks < 32; ++ks) {
                const bf16x8 af = *(const bf16x8*)(ap + 32 * ks);
                a0 = mfma16(af, *(const bf16x8*)(bp + 32 * ks), a0);
                a1 = mfma16(af, *(const bf16x8*)(bp + 16 * D + 32 * ks), a1);
                a2 = mfma16(af, *(const bf16x8*)(bp + 32 * D + 32 * ks), a2);
            }
#pragma unroll
            for (int i = 0; i < 4; ++i) { const int row = (lane >> 4) * 4 + i; lg[row * 48 + (lane & 15)] = a0[i]; lg[row * 48 + 16 + (lane & 15)] = a1[i]; lg[row * 48 + 32 + (lane & 15)] = a2[i]; }
            asm volatile("s_waitcnt lgkmcnt(0)" ::: "memory");
            const int row = t0 + lane;
            if (lane < 16 && row < r_end) {
                const LAS float* L = lg + lane * 48;
                float gl[4]; int gi = 0; float gm = -3.0e38f;
#pragma unroll
                for (int k = 0; k < 4; ++k) { gl[k] = L[k] + bg[k]; if (gl[k] > gm) { gm = gl[k]; gi = k; } }
                float gs = 0.f;
#pragma unroll
                for (int k = 0; k < 4; ++k) gs += fast_exp(gl[k] - gm);
                const float gval = 1.0f / gs;
                float el[8]; float em = -3.0e38f; int i0 = 0;
#pragma unroll
                for (int k = 0; k < 8; ++k) { el[k] = L[4 + 8 * gi + k] + br[8 * gi + k]; if (el[k] > em) { em = el[k]; i0 = k; } }
                float em2 = -3.0e38f; int i1 = 0;
#pragma unroll
                for (int k = 0; k < 8; ++k) if (k != i0 && el[k] > em2) { em2 = el[k]; i1 = k; }
                const float p0 = 1.0f, p1 = fast_exp(em2 - em);
                const float inv = 1.0f / (p0 + p1);
                RouteRec rec; rec.e0 = gi * 8 + i0; rec.e1 = gi * 8 + i1; rec.w0 = gval * p0 * inv; rec.w1 = gval * p1 * inv;
                rec.r0 = (int)__hip_atomic_fetch_add(cntp + rec.e0 * 64, 1u, __ATOMIC_RELAXED, __HIP_MEMORY_SCOPE_AGENT);
                rec.r1 = (int)__hip_atomic_fetch_add(cntp + rec.e1 * 64, 1u, __ATOMIC_RELAXED, __HIP_MEMORY_SCOPE_AGENT);
                rec.p0 = 0; rec.p1 = 0;
                routew[row] = rec;
                idx[(size_t)rec.e0 * T + rec.r0] = row; idx[(size_t)rec.e1 * T + rec.r1] = row;
            }
            asm volatile("s_waitcnt lgkmcnt(0)" ::: "memory");
        }
    }
}

DI void phase_norm2_router(Frame& F, int layer) {
    const int lane = F.lane, w = F.wave, tid = F.tid;
    const int RPB = (T + F.G - 1) / F.G;
    const int row_beg = F.bid * RPB, row_end = (row_beg + RPB < T) ? row_beg + RPB : T;
    const bf16_t* XS = (const bf16_t*)(F.ws + WS_XS);
    const float* modv = (const float*)(F.ws + WS_MODV);
    const float* ng = F.in[IN_NORMG] + (size_t)layer * 2 * D + D;
    LAS unsigned char* XT = F.lds;
    LAS float* part = (LAS float*)(F.lds + 32768);
    LAS float* lg = (LAS float*)(F.lds + 32768 + 24576);
    LAS u32x4* lrec = (LAS u32x4*)(F.lds + 61440);
    LAS unsigned* lcnt = (LAS unsigned*)(F.lds + 61440 + 32768);
    const bf16_t* WrT = (const bf16_t*)(F.ws + WS_MISC) + (size_t)layer * 48 * 1024;
    unsigned* cntp = (unsigned*)(F.ws + WS_CTL) + CW_CNT + layer * 32 * 64;
    RouteRec* routew = (RouteRec*)(F.ws + WS_ROUTE);
    int* idx = (int*)(F.ws + WS_ROUTE + 2 * MiB);
    const float* bg = F.in[IN_MOEBG] + layer * 4; const float* br = F.in[IN_MOEBR] + layer * 32;
    bf16x8 bwr[3][4];
#pragma unroll
    for (int nt = 0; nt < 3; ++nt)
#pragma unroll
        for (int ks = 0; ks < 4; ++ks) bwr[nt][ks] = *(const bf16x8*)(WrT + (size_t)(16 * nt + (lane & 15)) * D + 128 * w + 32 * ks + 8 * (lane >> 4));
    f32x4 gn[4];
#pragma unroll
    for (int j = 0; j < 4; ++j) gn[j] = *(const f32x4*)(ng + 4 * lane + 256 * j);
    f32x4 shc[4], scc[4]; int mr_c = -1;
#pragma unroll
    for (int j = 0; j < 4; ++j) { shc[j] = (f32x4){0.f, 0.f, 0.f, 0.f}; scc[j] = shc[j]; }
    u32x2 nx[2][4];
    auto load_rows = [&](int r0) {
#pragma unroll
        for (int k = 0; k < 2; ++k) { const int r = min(r0 + 2 * w + k, row_end - 1);
#pragma unroll
            for (int j = 0; j < 4; ++j) nx[k][j] = *(const u32x2*)(XS + (size_t)r * D + 4 * lane + 256 * j); }
    };
    load_rows(row_beg);
    if (tid < 64) lcnt[tid] = 0u;
    for (int r0 = row_beg; r0 < row_end; r0 += 16) {
        u32x2 cur[2][4];
#pragma unroll
        for (int k = 0; k < 2; ++k)
#pragma unroll
            for (int j = 0; j < 4; ++j) cur[k][j] = nx[k][j];
        if (r0 + 16 < row_end) load_rows(r0 + 16);
#pragma unroll
        for (int k = 0; k < 2; ++k) {
            const int rl = 2 * w + k, r = r0 + rl; const bool ok = r < row_end; const int rc = ok ? r : row_end - 1;
            const int b = rc / TPB, t = rc - b * TPB; const int mr = (t < NCTX) ? 8 : b;
            f32x4 v[4]; float ss = 0.f;
#pragma unroll
            for (int j = 0; j < 4; ++j) { v[j] = (f32x4){bflo(cur[k][j].x), bfhi(cur[k][j].x), bflo(cur[k][j].y), bfhi(cur[k][j].y)}; ss += (v[j][0] * v[j][0] + v[j][1] * v[j][1]) + (v[j][2] * v[j][2] + v[j][3] * v[j][3]); }
            const float rstd = 1.0f / sqrtf(wave_sum(ss) * (1.0f / D) + EPS);
            if (__builtin_amdgcn_readfirstlane(mr) != mr_c) { mr_c = __builtin_amdgcn_readfirstlane(mr); const float* mv = modv + ((size_t)layer * 9 + mr_c) * 6144;
#pragma unroll
                for (int j = 0; j < 4; ++j) { shc[j] = *(const f32x4*)(mv + 3072 + 4 * lane + 256 * j); scc[j] = *(const f32x4*)(mv + 4096 + 4 * lane + 256 * j) + 1.0f; } }
#pragma unroll
            for (int j = 0; j < 4; ++j) {
                const f32x4 o = v[j] * rstd * gn[j] * scc[j] + shc[j];
                if (ok) *(unsigned*)(F.ws + WS_HB8 + (size_t)r * D + 4 * lane + 256 * j) = pk4_fp8(o[0], o[1], o[2], o[3]);
                u32x2 pw; pw.x = pk2(o[0], o[1]); pw.y = pk2(o[2], o[3]);
                const int chunk = (lane >> 1) + 32 * j;
                *(LAS u32x2*)(XT + rl * 2048 + ((chunk ^ rl) << 4) + (lane & 1) * 8) = pw;
            }
        }
        __syncthreads();
        {
            const int rr = lane & 15; const LAS unsigned char* abase = XT + rr * 2048;
            f32x4 a0 = {0.f, 0.f, 0.f, 0.f}, a1 = a0, a2 = a0;
#pragma unroll
            for (int ks = 0; ks < 4; ++ks) { const int c = 16 * w + 4 * ks + (lane >> 4); const bf16x8 af = *(const LAS bf16x8*)(abase + ((c ^ rr) << 4));
                a0 = mfma16(af, bwr[0][ks], a0); a1 = mfma16(af, bwr[1][ks], a1); a2 = mfma16(af, bwr[2][ks], a2); }
            LAS float* pp = part + w * 768;
#pragma unroll
            for (int i = 0; i < 4; ++i) { const int row = (lane >> 4) * 4 + i; pp[row * 48 + (lane & 15)] = a0[i]; pp[row * 48 + 16 + (lane & 15)] = a1[i]; pp[row * 48 + 32 + (lane & 15)] = a2[i]; }
        }
        __syncthreads();
        for (int vI = tid; vI < 768; vI += 512) { float s = 0.f;
#pragma unroll
            for (int ww = 0; ww < 8; ++ww) s += part[ww * 768 + vI];
            lg[vI] = s; }
        __syncthreads();
        if (tid < 16 && r0 + tid < row_end && (layer == 3 && (r0 + tid) % TPB < NCTX)) lrec[2 * (r0 + tid - row_beg)] = (u32x4){0xffffffffu, 0u, 0u, 0u};
        else if (tid < 16 && r0 + tid < row_end) {
            const int row = r0 + tid;
            const LAS float* Lr = lg + tid * 48;
            float gl[4]; int gi = 0; float gm = -3.0e38f;
#pragma unroll
            for (int k = 0; k < 4; ++k) { gl[k] = Lr[k] + bg[k]; if (gl[k] > gm) { gm = gl[k]; gi = k; } }
            float gs = 0.f;
#pragma unroll
            for (int k = 0; k < 4; ++k) gs += fast_exp(gl[k] - gm);
            const float gval = 1.0f / gs;
            float el[8]; float em = -3.0e38f; int i0 = 0;
#pragma unroll
            for (int k = 0; k < 8; ++k) { el[k] = Lr[4 + 8 * gi + k] + br[8 * gi + k]; if (el[k] > em) { em = el[k]; i0 = k; } }
            float em2 = -3.0e38f; int i1 = 0;
#pragma unroll
            for (int k = 0; k < 8; ++k) if (k != i0 && el[k] > em2) { em2 = el[k]; i1 = k; }
            const float p1 = fast_exp(em2 - em);
            const float inv = 1.0f / (1.0f + p1);
            RouteRec rec; rec.e0 = gi * 8 + i0; rec.e1 = gi * 8 + i1; rec.w0 = gval * inv; rec.w1 = gval * p1 * inv;
            rec.r0 = (int)__hip_atomic_fetch_add(lcnt + rec.e0, 1u, __ATOMIC_RELAXED, __HIP_MEMORY_SCOPE_WORKGROUP);
            rec.r1 = (int)__hip_atomic_fetch_add(lcnt + rec.e1, 1u, __ATOMIC_RELAXED, __HIP_MEMORY_SCOPE_WORKGROUP);
            rec.p0 = 0; rec.p1 = 0;
            lrec[2 * (row - row_beg)] = (u32x4){(unsigned)rec.e0, (unsigned)rec.e1, (unsigned)rec.r0, (unsigned)rec.r1}; lrec[2 * (row - row_beg) + 1] = (u32x4){__float_as_uint(rec.w0), __float_as_uint(rec.w1), 0u, 0u};
        }
    }
    __syncthreads();
    if (tid < 32) { const unsigned c = lcnt[tid]; lcnt[32 + tid] = c ? __hip_atomic_fetch_add(cntp + tid * 64, c, __ATOMIC_RELAXED, __HIP_MEMORY_SCOPE_AGENT) : 0u; }
    __syncthreads();
    for (int i = tid; i < row_end - row_beg; i += 512) {
        const u32x4 ra = lrec[2 * i], rb = lrec[2 * i + 1];
        if ((int)ra.x < 0) continue;
        RouteRec rec; rec.e0 = (int)ra.x; rec.e1 = (int)ra.y; rec.r0 = (int)ra.z; rec.r1 = (int)ra.w; rec.w0 = __uint_as_float(rb.x); rec.w1 = __uint_as_float(rb.y); rec.p0 = 0; rec.p1 = 0;
        rec.r0 += (int)lcnt[32 + rec.e0]; rec.r1 += (int)lcnt[32 + rec.e1];
        const int row = row_beg + i;
        routew[row] = rec;
        idx[(size_t)rec.e0 * T + rec.r0] = row; idx[(size_t)rec.e1 * T + rec.r1] = row;
    }
}

struct MoeOrder {
    int G, c, ntiles, K; const char* A; const char* Bt; size_t bstride; const int* idx; bool gather; bool xcdmap;
    const LAS int* tbl;
    DI bool next(int i, pg8::Unit& u) const {
        int rt, pn, e = 0;
        if (xcdmap) {
            const int x = c & 7, j = c >> 3; const int U = j + 32 * i; int tt = U >> 2; pn = U & 3; bool found = false;
            for (int k = 0; k < 4; ++k) { const int ee = x + 8 * k; const int n = tbl[ee + 1] - tbl[ee]; if (!found) { if (tt < n) { e = ee; found = true; } else tt -= n; } }
            if (!found) return false;
            rt = tbl[e] + tt;
        } else {
        const long L = (long)i * G + c; if (L >= (long)ntiles * 4) return false;
        rt = (int)(L >> 2); pn = (int)(L & 3);
        for (int k = 1; k < 32; ++k) if (tbl[k] <= rt) e = k;
        }
        u.pm = rt; u.pn = pn; u.e = e; u.r0 = (rt - tbl[e]) * 256; u.cnt = tbl[64 + e];
        u.a = gather ? A : A + (size_t)rt * 256 * K * 2;
        u.b = Bt + (size_t)e * bstride + (size_t)pn * 256 * K * 2;
        return true;
    }
    DI void aoff(const pg8::Unit& u, int K_, const int (&R)[2], const int (&C)[2], unsigned (&va)[2][2]) const {
#pragma unroll
        for (int h = 0; h < 2; ++h)
#pragma unroll
            for (int i = 0; i < 2; ++i) {
                if (gather) { int rr = u.r0 + R[i] + 128 * h; if (rr >= u.cnt) rr = 0; const int tok = idx[(size_t)u.e * T + rr]; va[h][i] = (unsigned)(tok * K_ + C[i]) * 2u; }
                else va[h][i] = (unsigned)((R[i] + 128 * h) * K_ + C[i]) * 2u;
            }
    }
};
DI int moe_build_table(Frame& F, int layer, LAS int* tbl) {
    __syncthreads();
    if (F.tid < 64) {
        unsigned* cntp = (unsigned*)(F.ws + WS_CTL) + CW_CNT + layer * 32 * 64;
        const int lane = F.tid;
        int c = (lane < 32) ? (int)__hip_atomic_load(cntp + lane * 64, __ATOMIC_RELAXED, __HIP_MEMORY_SCOPE_AGENT) : 0;
        int ntl = (c + 255) >> 8, incl = ntl;
#pragma unroll
        for (int o = 1; o < 32; o <<= 1) { const int t = __shfl_up(incl, o); if ((lane & 31) >= o) incl += t; }
        if (lane < 32) { tbl[lane] = incl - ntl; tbl[64 + lane] = c; }
        if (lane == 31) tbl[32] = incl;
    }
    __syncthreads();
    return tbl[32];
}

DI bool moe_xcd_balanced(const Frame& F, const LAS int* tbl, int ntl) {
    if (F.G != 256) return false;
    int mx = 0;
    for (int x = 0; x < 8; ++x) { int sum = 0; for (int k = 0; k < 4; ++k) sum += tbl[x + 8 * k + 1] - tbl[x + 8 * k]; mx = sum > mx ? sum : mx; }
    return mx * 8 <= ntl + (ntl >> 2) + 8;
}

template <int DV> struct FlashSt { f32x16 o[DV / 32]; float m, l; };
template <int DV, int KSTR, int VSTR, bool MASK, class SF>
DI void flash_subtile(const LAS unsigned char* kb, const LAS unsigned char* vb, const bf16x8 (&qf)[4], FlashSt<DV>& st, const float scale_l2e, const int lane, const SF& sfun) {
    const int r = lane & 31, h = lane >> 5;
    f32x16 s;
#pragma unroll
    for (int i = 0; i < 16; ++i) s[i] = 0.f;
#pragma unroll
    for (int ks = 0; ks < 4; ++ks) { const bf16x8 a = *(const LAS bf16x8*)(kb + r * KSTR + (16 * ks + 8 * h) * 2); s = mfma32(a, qf[ks], s); }
    float mx = -INFINITY;
#pragma unroll
    for (int i = 0; i < 16; ++i) { s[i] = s[i] * scale_l2e; if (MASK) s[i] += sfun(i); mx = fmaxf(mx, s[i]); }
    mx = fmaxf(mx, __shfl_xor(mx, 32));
    const float mnew = fmaxf(st.m, mx);
    const float muse = (mnew == -INFINITY) ? 0.f : mnew;
    const float alpha = fast_exp2(st.m - muse);
    float rs = 0.f;
#pragma unroll
    for (int i = 0; i < 16; ++i) { s[i] = fast_exp2(s[i] - muse); rs += s[i]; }
    rs += __shfl_xor(rs, 32);
    st.l = st.l * alpha + rs; st.m = mnew;
#pragma unroll
    for (int d = 0; d < DV / 32; ++d)
#pragma unroll
        for (int i = 0; i < 16; ++i) st.o[d][i] *= alpha;
    const bf16x8 p0 = pack_step(s, 0), p1 = pack_step(s, 1);
    const int i16 = lane & 15, q = i16 >> 2, p = i16 & 3, blk = (lane >> 4) & 1;
    const LAS unsigned char* vl = vb + (4 * h + q) * VSTR + (16 * blk + 4 * p) * 2;
#pragma unroll
    for (int d = 0; d < DV / 32; ++d) {
        const s16x4 lo0 = tr_read(vl + d * 64), hi0 = tr_read(vl + 8 * VSTR + d * 64);
        const s16x4 lo1 = tr_read(vl + 16 * VSTR + d * 64), hi1 = tr_read(vl + 24 * VSTR + d * 64);
        st.o[d] = mfma32(cat4(lo0, hi0), p0, st.o[d]);
        st.o[d] = mfma32(cat4(lo1, hi1), p1, st.o[d]);
    }
}

DI int naf(int row) { return (((row >> 1) & 1) << 2) | ((row >> 2) & 3); }
DI void phase_na_attn(Frame& F, int j  , bool with_ctx) {
    const bf16_t* QKV = (const bf16_t*)(F.ws + R_QKV); unsigned char* AO = F.ws + R_AO;
    const float* rpb = F.in[IN_NARPB] + (size_t)j * 16 * 15 * 31;
    LAS unsigned char* L = F.lds;
    LAS float* biasp = (LAS float*)(L + 65536);
    LAS float* bias = biasp + 64;
    LAS float* ninf = biasp + 64 + 465 + 64;
    const int w = F.wave;
    const int n_lat = NB * 16 * 8, n_units = n_lat + (with_ctx ? NB * 16 : 0);
    const int ncb = w & 3, rq = w >> 2;
    const int kst = __builtin_amdgcn_readfirstlane((ncb == 0) ? 0 : (ncb == 1) ? 8 : (ncb == 2) ? 24 : 32);
    for (int unit0 = F.bid; unit0 < n_units; unit0 += F.G) {
        int unit = unit0;
        if (F.G == 256 && unit0 < n_lat) { const int k = unit0 >> 8, wv = unit0 & 255; unit = ((k * 32 + (wv & 7) * 4 + ((wv >> 3) >> 3)) << 3) | ((wv >> 3) & 7); }
    const int lane = hw_lane(), tid = w * 64 + lane, r32 = lane & 31, hh = lane >> 5;
    const int q4 = (lane & 15) >> 2, p4 = lane & 3, blk = (lane >> 4) & 1, LP = 2 * blk + (p4 >> 1);
    const int K0w = (kst + r32) * 128 + ((hh ^ naf(kst + r32)) << 4), K0c = r32 * 128 + ((hh ^ naf(r32)) << 4);
    const int xbw = (kst >> 2) & 3;
    const int V0w = (4 * hh + q4) * 128 + ((q4 >> 1) << 6) + ((LP ^ ((xbw + hh) & 3)) << 4) + (p4 & 1) * 8;
    const int V0c = (4 * hh + q4) * 128 + ((q4 >> 1) << 6) + ((LP ^ (hh & 3)) << 4) + (p4 & 1) * 8;
    const int drow0 = 16 * w + (lane >> 3), dpos = lane & 7;
    const int dsrc0 = (dpos ^ naf(drow0)) * 8, dsrc1 = (dpos ^ naf(drow0 + 8)) * 8;
    {
        const bool lat = unit < n_lat;
        int b, head, rg = 0;
        if (lat) { b = unit >> 7; head = (unit >> 3) & 15; rg = unit & 7; } else { const int u2 = unit - n_lat; b = u2 >> 4; head = u2 & 15; }
        const int r0 = 8 * rg;
        const int kr_lo = min(max(r0 - 4, 0), 56), kr_hi = min(max(r0 + 3, 0), 56) + 7;
        const int nwin = lat ? (kr_hi - kr_lo + 2) / 2 : 0, ntile = 2 + nwin;
        __syncthreads();
        for (int i = tid; i < 64 + 465 + 64 + 128; i += 512) { const int bi = i - 64; biasp[i] = (bi >= 0 && bi < 465) ? rpb[head * 465 + bi] * 1.4426950408889634f : (i >= 64 + 465 + 64 ? -INFINITY : 0.f); }
        const bf16_t* kvbase = QKV + (size_t)(b * TPB) * 3072 + 1024 + head * 64;
        auto issue = [&](int t) {
            LAS unsigned char* dst = L + (t & 1) * 32768 + w * 2048;
            int tok0, tok1;
            if (t < 2) { tok0 = 128 * t + drow0; tok1 = tok0 + 8; }
            else { const int kr0 = kr_lo + 2 * (t - 2); const int ra = drow0, rb = drow0 + 8;
                tok0 = NCTX + min(kr0 + (ra >> 6), 63) * 64 + (ra & 63); tok1 = NCTX + min(kr0 + (rb >> 6), 63) * 64 + (rb & 63); }
            const bf16_t* p0 = kvbase + (size_t)tok0 * 3072 + dsrc0; const bf16_t* p1 = kvbase + (size_t)tok1 * 3072 + dsrc1;
            dma16(p0, dst);
            dma16(p1, (dst + 1024));
            dma16((p0 + 1024), (dst + 16384));
            dma16((p1 + 1024), (dst + 16384 + 1024));
        };
        issue(0);
        int qtok[2], qr[2]; const int qc = 16 * ncb + (r32 & 15);
#pragma unroll
        for (int qi = 0; qi < 2; ++qi) {
            if (lat) { qr[qi] = r0 + 4 * rq + 2 * qi + (r32 >> 4); qtok[qi] = b * TPB + NCTX + qr[qi] * 64 + qc; }
            else { qr[qi] = 0; qtok[qi] = b * TPB + 32 * w + r32; }
        }
        bf16x8 qf[2][4];
#pragma unroll
        for (int qi = 0; qi < 2; ++qi)
#pragma unroll
            for (int ks = 0; ks < 4; ++ks) qf[qi][ks] = *(const bf16x8*)(QKV + (size_t)qtok[qi] * 3072 + head * 64 + 16 * ks + 8 * hh);
#pragma unroll
        for (int qi = 0; qi < 2; ++qi)
#pragma unroll
            for (int ks = 0; ks < 4; ++ks) asm volatile("" : "+v"(qf[qi][ks]));
        const int wst = min(max(qc - 8, 0), 48);
        unsigned colmask = 0u;
#pragma unroll
        for (int i = 0; i < 16; ++i) { const int kc = kst + crow(i, hh); if (kc >= wst && kc < wst + 16) colmask |= 1u << i; }
        const int wr0 = r0 + 4 * rq; const int wlo = min(max(wr0 - 4, 0), 56), whi = min(max(wr0 + 3 - 4, 0), 56) + 7;
        const int qlo0 = min(max(wr0 - 4, 0), 56), qhi0 = min(max(wr0 + 1 - 4, 0), 56) + 7, qlo1 = min(max(wr0 + 2 - 4, 0), 56), qhi1 = min(max(wr0 + 3 - 4, 0), 56) + 7;
        f32x16 O[2][2]; float mrun[2], lrun[2];
#pragma unroll
        for (int qi = 0; qi < 2; ++qi) { mrun[qi] = -INFINITY; lrun[qi] = 0.f;
#pragma unroll
            for (int d = 0; d < 2; ++d)
#pragma unroll
                for (int i = 0; i < 16; ++i) O[qi][d][i] = 0.f; }
        auto subtile = [&](const LAS unsigned char* kb, const LAS unsigned char* vb, const int K0x, const int V0x, const bool masked, const int kr) {
            const int K0t = opaque(K0x), V0t = opaque(V0x);
            bf16x8 P[2][2];
            const bool use0 = !masked || (kr >= qlo0 && kr <= qhi0), use1 = !masked || (kr >= qlo1 && kr <= qhi1);
#pragma unroll
            for (int qi = 0; qi < 2; ++qi) {
                if (!(qi ? use1 : use0)) continue;
                f32x16 s;
                if (masked) {
                    const int rs = min(max(qr[qi] - 4, 0), 56); const bool rowok = (kr >= rs) && (kr < rs + 8);
                    const int dyc = min(max(kr - qr[qi] + 7, 0), 14);
                    const int delta = -qc + kst + 4 * hh;
                    const LAS float* bp = rowok ? (bias + opaque(dyc * 31 + 15 + delta)) : (ninf + opaque(64 + delta));
#pragma unroll
                    for (int i = 0; i < 16; ++i) s[i] = ((colmask >> i) & 1u) ? bp[(i & 3) + 8 * (i >> 2)] : -INFINITY;
                } else {
#pragma unroll
                    for (int i = 0; i < 16; ++i) s[i] = 0.f;
                }
#pragma unroll
                for (int ks = 0; ks < 4; ++ks) { const bf16x8 kf = *(const LAS bf16x8*)(kb + (K0t ^ (ks << 5))); s = mfma32(kf, qf[qi][ks], s); }
                float mx = s[0];
#pragma unroll
                for (int i = 1; i < 16; ++i) mx = fmaxf(mx, s[i]);
                mx = xhalf_max(mx);
                if (__any(mx > mrun[qi] + 8.0f)) {
                    const float mnew = fmaxf(mrun[qi], mx); const float alpha = fast_exp2(mrun[qi] - mnew);
                    mrun[qi] = mnew; lrun[qi] *= alpha;
#pragma unroll
                    for (int d = 0; d < 2; ++d)
#pragma unroll
                        for (int i = 0; i < 16; ++i) O[qi][d][i] *= alpha;
                }
                const float mu = mrun[qi]; float rsum = 0.f;
#pragma unroll
                for (int i = 0; i < 16; ++i) { s[i] = fast_exp2(s[i] - mu); rsum += s[i]; }
                lrun[qi] += rsum;
                P[qi][0] = pack_step(s, 0); P[qi][1] = pack_step(s, 1);
            }
#pragma unroll
            for (int d = 0; d < 2; ++d)
#pragma unroll
                for (int s2 = 0; s2 < 2; ++s2) {
                    const int va = V0t ^ (d << 6); const s16x4 lo = tr_read(vb + s2 * 2048 + va), hi = tr_read(vb + s2 * 2048 + 1024 + (va ^ 32));
                    const bf16x8 vf = cat4(lo, hi);
                    if (use0) O[0][d] = mfma32(vf, P[0][s2], O[0][d]);
                    if (use1) O[1][d] = mfma32(vf, P[1][s2], O[1][d]);
                }
        };
        for (int t = 0; t < ntile; ++t) {
            asm volatile("s_waitcnt vmcnt(0)" ::: "memory"); __builtin_amdgcn_s_barrier(); asm volatile("" ::: "memory");
            if (t + 1 < ntile) issue(t + 1);
            const LAS unsigned char* Kb = L + (t & 1) * 32768; const LAS unsigned char* Vb = Kb + 16384;
            if (t < 2) {
#pragma nounroll
                for (int sb = 0; sb < 4; ++sb) subtile(Kb + sb * 4096, Vb + sb * 4096, K0c, V0c, false, 0);
            } else {
#pragma nounroll
                for (int jr = 0; jr < 2; ++jr) { const int kr = kr_lo + 2 * (t - 2) + jr;
                    if (kr >= wlo && kr <= whi) subtile(Kb + jr * 8192, Vb + jr * 8192 + kst * 128, K0w, V0w, true, kr); }
            }
        }
#pragma unroll
        for (int qi = 0; qi < 2; ++qi) {
            if (!lat && qi == 1) continue;
            const float inv = 1.0f / (lrun[qi] + __shfl_xor(lrun[qi], 32));
            const int l2 = hw_lane(), r2 = l2 & 31, h2 = l2 >> 5;
            const int qt2 = lat ? (b * TPB + NCTX + (r0 + 4 * rq + 2 * qi + (r2 >> 4)) * 64 + 16 * ncb + (r2 & 15)) : (b * TPB + 32 * w + r2);
            unsigned char* op = AO + (size_t)qt2 * D + head * 64 + 4 * h2;
#pragma unroll
            for (int d = 0; d < 2; ++d)
#pragma unroll
                for (int g = 0; g < 4; ++g) *(unsigned*)(op + 32 * d + 8 * g) = pk4_fp8(O[qi][d][4 * g] * inv, O[qi][d][4 * g + 1] * inv, O[qi][d][4 * g + 2] * inv, O[qi][d][4 * g + 3] * inv);
        }
    }
    }
}

DI int gsw(int p) { return ((p & 3) << 2) | ((p >> 2) & 3); }
DI void phase_da_attn(Frame& F, bool with_ctx) {
    const bf16_t* QKV = (const bf16_t*)(F.ws + R_QKV); unsigned char* AO = F.ws + R_AO;
    LAS unsigned char* L = F.lds;
    LAS float* xch = (LAS float*)L;
    LAS float* misc = (LAS float*)(L + 131072);
    const int w = F.wave;
    const float lambda_init = 0.8f - 0.6f * expf(-0.3f * 2.0f);
    __syncthreads();
    if (w == 0) { const int lane = F.lane; const float* lam = F.in[IN_DALAM]; const float a = wave_sum(lam[lane] * lam[64 + lane]), c2 = wave_sum(lam[128 + lane] * lam[192 + lane]);
        if (lane == 0) misc[0] = expf(a) - expf(c2) + lambda_init; }
    __syncthreads();
    const float lam_full = misc[0];
    const int n_lat = NB * 8 * 16, n_units = n_lat + (with_ctx ? NB * 8 : 0);
    const int map = w >> 2, qw = w & 3;
    for (int unit0 = F.bid; unit0 < n_units; unit0 += F.G) {
        int unit = unit0;
        if (F.G == 256 && unit0 < n_lat) { const int k = unit0 >> 8, wv = unit0 & 255; unit = ((k * 16 + (wv & 7) * 2 + ((wv >> 3) >> 4)) << 4) | ((wv >> 3) & 15); }
        const int lane = hw_lane(), r32 = lane & 31, hh = lane >> 5;
        const int K0 = r32 * 256 + ((((map * 8 + hh) ^ gsw(r32))) << 4);
        const int q4 = (lane & 15) >> 2, p4 = lane & 3, blk = (lane >> 4) & 1, LP = 2 * blk + (p4 >> 1);
        const int V0 = (4 * hh + q4) * 256 + (q4 << 6) + ((LP ^ (hh & 3)) << 4) + (p4 & 1) * 8;
        const int drow0 = 8 * w + (lane >> 4), dpos = lane & 15;
        const int dsrc0 = (dpos ^ gsw(drow0)) * 8, dsrc1 = (dpos ^ gsw(drow0 + 4)) * 8;
        const bool lat = unit < n_lat;
        int b, head, qb;
        if (lat) { b = unit >> 7; head = (unit >> 4) & 7; qb = unit & 15; } else { const int u2 = unit - n_lat; b = u2 >> 3; head = u2 & 7; qb = 0; }
        const int qtok0 = b * TPB + (lat ? NCTX : 0) + qb * 256 + qw * 64;
        __syncthreads();
        const bf16_t* kbase = QKV + (size_t)(b * TPB) * 3072 + 1024 + head * 128;
        auto issue = [&](int t) {
            LAS unsigned char* dst = L + (t & 1) * 32768 + w * 2048;
            const bf16_t* r0 = kbase + (size_t)(t * 64 + drow0) * 3072; const bf16_t* r1 = r0 + (size_t)4 * 3072;
            dma16((r0 + dsrc0), dst);
            dma16((r1 + dsrc1), (dst + 1024));
            dma16((r0 + 1024 + dsrc0), (dst + 16384));
            dma16((r1 + 1024 + dsrc1), (dst + 16384 + 1024));
        };
        issue(0);
        bf16x8 qf[2][4];
#pragma unroll
        for (int qi = 0; qi < 2; ++qi)
#pragma unroll
            for (int ks = 0; ks < 4; ++ks) qf[qi][ks] = *(const bf16x8*)(QKV + (size_t)(qtok0 + 32 * qi + r32) * 3072 + head * 128 + map * 64 + 16 * ks + 8 * hh);
#pragma unroll
        for (int qi = 0; qi < 2; ++qi)
#pragma unroll
            for (int ks = 0; ks < 4; ++ks) asm volatile("" : "+v"(qf[qi][ks]));
        f32x16 O[2][4]; float mrun[2], lrun[2];
#pragma unroll
        for (int qi = 0; qi < 2; ++qi) { mrun[qi] = 0.f; lrun[qi] = 0.f;
#pragma unroll
            for (int d = 0; d < 4; ++d)
#pragma unroll
                for (int i = 0; i < 16; ++i) O[qi][d][i] = 0.f; }
        const int ntile = lat ? 68 : 4;
        for (int t = 0; t < ntile; ++t) {
            asm volatile("s_waitcnt vmcnt(0)" ::: "memory"); __builtin_amdgcn_s_barrier(); asm volatile("" ::: "memory");
            if (t + 1 < ntile) issue(t + 1);
            const LAS unsigned char* Kb = L + (t & 1) * 32768; const LAS unsigned char* Vb = Kb + 16384;
#pragma unroll
            for (int kb = 0; kb < 2; ++kb) {
                const bool first = (t == 0) && (kb == 0);
                const int K0t = opaque(K0), V0t = opaque(V0);
                bf16x8 P[2][2];
#pragma unroll
                for (int qi = 0; qi < 2; ++qi) {
                    f32x16 s; { float ninit = -mrun[qi]; asm volatile("" : "+v"(ninit));
#pragma unroll
                        for (int i = 0; i < 16; ++i) s[i] = ninit; }
#pragma unroll
                    for (int ks = 0; ks < 4; ++ks) { const bf16x8 kf = *(const LAS bf16x8*)(Kb + kb * 8192 + (K0t ^ (ks << 5))); s = mfma32(kf, qf[qi][ks], s); }
                    if (first) {
                        float mx = s[0];
#pragma unroll
                        for (int i = 1; i < 16; ++i) mx = fmaxf(mx, s[i]);
                        mx = xhalf_max(mx); mrun[qi] += mx;
#pragma unroll
                        for (int i = 0; i < 16; ++i) s[i] -= mx;
                    }
                    float rs = 0.f;
#pragma unroll
                    for (int i = 0; i < 16; ++i) { s[i] = fast_exp2(s[i]); rs += s[i]; }
                    if (!first && __any(!(rs < 0x1p30f))) {
                        { float ninit = -mrun[qi]; asm volatile("" : "+v"(ninit));
#pragma unroll
                          for (int i = 0; i < 16; ++i) s[i] = ninit; }
#pragma unroll
                        for (int ks = 0; ks < 4; ++ks) { const bf16x8 kf = *(const LAS bf16x8*)(Kb + kb * 8192 + (K0t ^ (ks << 5))); s = mfma32(kf, qf[qi][ks], s); }
                        float mx = s[0];
#pragma unroll
                        for (int i = 1; i < 16; ++i) mx = fmaxf(mx, s[i]);
                        mx = xhalf_max(mx);
                        const float shift = fmaxf(mx, 0.f), alpha = fast_exp2(-shift);
                        mrun[qi] += shift; lrun[qi] *= alpha;
#pragma unroll
                        for (int d = 0; d < 4; ++d)
#pragma unroll
                            for (int i = 0; i < 16; ++i) O[qi][d][i] *= alpha;
                        rs = 0.f;
#pragma unroll
                        for (int i = 0; i < 16; ++i) { s[i] = fast_exp2(s[i] - shift); rs += s[i]; }
                    }
                    lrun[qi] += rs;
                    P[qi][0] = pack_step(s, 0); P[qi][1] = pack_step(s, 1);
                }
#pragma unroll
                for (int d = 0; d < 4; ++d)
#pragma unroll
                    for (int s2 = 0; s2 < 2; ++s2) {
                        const int va = V0t ^ (d << 6); const s16x4 lo = tr_read(Vb + (32 * kb + 16 * s2) * 256 + va), hi = tr_read(Vb + (32 * kb + 16 * s2) * 256 + 2048 + (va ^ 32));
                        const bf16x8 vf = cat4(lo, hi);
                        O[0][d] = mfma32(vf, P[0][s2], O[0][d]);
                        O[1][d] = mfma32(vf, P[1][s2], O[1][d]);
                    }
            }
        }
        lrun[0] += __shfl_xor(lrun[0], 32); lrun[1] += __shfl_xor(lrun[1], 32);
        __syncthreads();
        const int lane2 = hw_lane(), r32b = lane2 & 31, hhb = lane2 >> 5;
        if (map == 1) {
#pragma unroll
            for (int qi = 0; qi < 2; ++qi) { const float inv = 1.0f / lrun[qi];
#pragma unroll
                for (int d = 0; d < 4; ++d)
#pragma unroll
                    for (int i = 0; i < 16; ++i) xch[(qw * 128 + qi * 64 + d * 16 + i) * 64 + lane2] = O[qi][d][i] * inv; }
        }
        __syncthreads();
        if (map == 0) {
            const float* sg = F.in[IN_DASUBLN];
#pragma unroll
            for (int qi = 0; qi < 2; ++qi) {
                const float inv = 1.0f / lrun[qi]; float ss = 0.f;
#pragma unroll
                for (int d = 0; d < 4; ++d)
#pragma unroll
                    for (int i = 0; i < 16; ++i) { const float v = O[qi][d][i] * inv - lam_full * xch[(qw * 128 + qi * 64 + d * 16 + i) * 64 + lane2]; O[qi][d][i] = v; ss += v * v; }
                ss += __shfl_xor(ss, 32);
                const float rn = (1.0f - lambda_init) / sqrtf(ss * (1.0f / 128.0f) + EPS);
                unsigned char* op = AO + (size_t)(b * TPB + (lat ? NCTX : 0) + qb * 256 + qw * 64 + 32 * qi + r32b) * D + head * 128 + 4 * hhb;
#pragma unroll
                for (int d = 0; d < 4; ++d)
#pragma unroll
                    for (int g = 0; g < 4; ++g) { const f32x4 gg = *(const f32x4*)(sg + 32 * d + 8 * g + 4 * hhb);
                        *(unsigned*)(op + 32 * d + 8 * g) = pk4_fp8(O[qi][d][4 * g] * rn * gg[0], O[qi][d][4 * g + 1] * rn * gg[1], O[qi][d][4 * g + 2] * rn * gg[2], O[qi][d][4 * g + 3] * rn * gg[3]); }
            }
        }
    }
}

#if PREP_PROBE
#define PREP_STAMP(k) do { const unsigned long long t_ = __builtin_amdgcn_s_memtime(); pacc[k] += t_ - plast; plast = t_; } while (0)
#else
#define PREP_STAMP(k) do { } while (0)
#endif
DI void phase_ml_prep(Frame& F) {
#if PREP_PROBE
    unsigned long long pacc[4] = {0, 0, 0, 0}; unsigned long long plast = __builtin_amdgcn_s_memtime();
#endif
    const bf16_t* XM = (const bf16_t*)(F.ws + R_XM); bf16_t* XC = (bf16_t*)(F.ws + R_XC); bf16_t* V = (bf16_t*)(F.ws + R_V); float* GATES = (float*)(F.ws + R_GATES);
    const bf16_t* WGt = (const bf16_t*)(F.ws + WS_MISC + 512 * 1024);
    LAS unsigned char* XT = F.lds;
    LAS float* part = (LAS float*)(F.lds + 131072);
    const int tid = F.tid, lane = F.lane, w = F.wave;
    const int g = tid;
    f32x2 cw2[5][2], cb2[2], wv2[4][2];
#pragma unroll
    for (int jj = 0; jj < 5; ++jj) { const f32x4 a = *(const f32x4*)(F.in[IN_MLCONVW] + jj * ML_INNER + 4 * g); cw2[jj][0] = (f32x2){a[0], a[1]}; cw2[jj][1] = (f32x2){a[2], a[3]}; }
    { const f32x4 a = *(const f32x4*)(F.in[IN_MLCONVB] + 4 * g); cb2[0] = (f32x2){a[0], a[1]}; cb2[1] = (f32x2){a[2], a[3]}; }
#pragma unroll
    for (int i = 0; i < 4; ++i) { const f32x4 a = *(const f32x4*)(F.in[IN_MLWV] + g * 16 + 4 * i); wv2[i][0] = (f32x2){a[0], a[1]}; wv2[i][1] = (f32x2){a[2], a[3]}; }
    const float bgate = (tid < 256) ? F.in[IN_MLBGATE][tid & 15] : 0.f;
    auto load_rows = [&](int tile, u32x2 (&rw)[20], unsigned& mask) {
        const int t0 = tile * 16; const int b = t0 / TPB, tt = t0 - b * TPB; const int seg0 = b * TPB + (tt < NCTX ? 0 : NCTX), seg1 = b * TPB + (tt < NCTX ? NCTX : TPB);
        unsigned m = 0u;
#pragma unroll
        for (int i = 0; i < 20; ++i) { const int row = t0 - 2 + i; const bool in = (row >= seg0 && row < seg1); const int rc = in ? row : t0; m |= (in ? 1u : 0u) << i;
            rw[i] = *(const u32x2*)(XM + (size_t)rc * ML_INNER + 4 * g); }
        mask = m;
    };
    u32x2 nxt[20]; unsigned nmask = 0u;
    if (F.bid < T / 16) load_rows(F.bid, nxt, nmask);
    for (int tile = F.bid; tile < T / 16; tile += F.G) {
        const int t0 = tile * 16;
        bf16x8 bw[16];
#pragma unroll
        for (int ks = 0; ks < 16; ++ks) bw[ks] = *(const bf16x8*)(WGt + (size_t)(lane & 15) * 4096 + w * 512 + 32 * ks + 8 * (lane >> 4));
        u32x2 raw[20]; const unsigned cmask = nmask;
#pragma unroll
        for (int i = 0; i < 20; ++i) raw[i] = nxt[i];
        if (tile + F.G < T / 16) load_rows(tile + F.G, nxt, nmask);
#pragma unroll
        for (int i = 0; i < 20; ++i) if (!((cmask >> i) & 1u)) { raw[i].x = 0u; raw[i].y = 0u; }
#if PREP_PROBE
        asm volatile("s_waitcnt vmcnt(0)" ::: "memory"); PREP_STAMP(0);
#endif
#pragma unroll
        for (int i = 0; i < 16; ++i) {
            f32x2 a01 = cb2[0], a23 = cb2[1];
#pragma unroll
            for (int jj = 0; jj < 5; ++jj) { const u32x2 u = raw[i + jj]; a01 += cw2[jj][0] * (f32x2){bflo(u.x), bfhi(u.x)}; a23 += cw2[jj][1] * (f32x2){bflo(u.y), bfhi(u.y)}; }
            const float x0 = bflo(raw[i + 2].x), x1 = bfhi(raw[i + 2].x), x2 = bflo(raw[i + 2].y), x3 = bfhi(raw[i + 2].y);
            const f32x2 v01 = wv2[0][0] * x0 + wv2[1][0] * x1 + wv2[2][0] * x2 + wv2[3][0] * x3, v23 = wv2[0][1] * x0 + wv2[1][1] * x1 + wv2[2][1] * x2 + wv2[3][1] * x3;
            u32x2 xcp; xcp.x = pk2(silu_f(a01[0]), silu_f(a01[1])); xcp.y = pk2(silu_f(a23[0]), silu_f(a23[1]));
            u32x2 vp; vp.x = pk2(v01[0], v01[1]); vp.y = pk2(v23[0], v23[1]);
            *(u32x2*)(XC + (size_t)(t0 + i) * ML_INNER + 4 * g) = xcp;
            *(u32x2*)(V + (size_t)(t0 + i) * ML_INNER + 4 * g) = vp;
            const int lo = i * 4096 + (((g >> 1) ^ i) << 4) + (g & 1) * 8;
            *(LAS u32x2*)(XT + lo) = xcp; *(LAS u32x2*)(XT + 65536 + lo) = raw[i + 2];
        }
        PREP_STAMP(1);
        __syncthreads();
        PREP_STAMP(2);
        {
            const int tok = lane & 15; const LAS unsigned char* abase = XT + (w >> 2) * 65536 + tok * 4096;
            f32x4 acc = {0.f, 0.f, 0.f, 0.f};
#pragma unroll
            for (int ks = 0; ks < 16; ++ks) { const int c = (w & 3) * 64 + 4 * ks + (lane >> 4); acc = mfma16(*(const LAS bf16x8*)(abase + ((c ^ tok) << 4)), bw[ks], acc); }
#pragma unroll
            for (int i = 0; i < 4; ++i) part[w * 256 + ((lane >> 4) * 4 + i) * 16 + (lane & 15)] = acc[i];
        }
        __syncthreads();
        if (tid < 256) { const int row = tid >> 4, n = tid & 15; float s = bgate;
#pragma unroll
            for (int ww = 0; ww < 8; ++ww) s += part[ww * 256 + tid];
            if ((n >> 2) & 1) s = fminf(s, 0.f) - log1pf(expf(-fabsf(s)));
            GATES[(size_t)(t0 + row) * 16 + n] = s; }
        PREP_STAMP(3);
    }
#if PREP_PROBE
    if (F.bid == 0 && F.tid == 0) { unsigned long long tot = 0; for (int k = 0; k < 4; ++k) tot += pacc[k]; ((float*)(F.ws + WS_CTL))[2048] = floorf(8.0f * (float)pacc[PREP_PROBE - 1] / (float)tot + 0.5f) / 8.0f; }
#endif
}

constexpr int SC_Q = 0, SC_K = 65536, SC_V = 131072, SC_S = 147456  , SC_VEC = 156672  ;
constexpr int SC_STR = 144;
DI int qk_off(int p, int qd) { const int grp = qd >> 2, q4 = qd & 3; const int pq = (q4 == 1) ? 2 : (q4 == 2) ? 1 : q4; const int c = grp * 2 + (pq >> 1); return p * 1024 + ((c ^ gsw(p)) << 4) + ((pq & 1) << 3); }
DI int qk_chunk(int p, int c) { return p * 1024 + ((c ^ gsw(p)) << 4); }
DI int v_off(int s, int qd) { const int c = qd >> 1; return s * 256 + ((c ^ gsw(s)) << 4) + ((qd & 1) << 3); }

#ifndef SCAN_PROBE
#define SCAN_PROBE 0
#endif
#if SCAN_PROBE
#define SCAN_STAMP(k) do { const unsigned long long t_ = __builtin_amdgcn_s_memtime(); acc_t[((k) + 6) % 7] += t_ - last_t; last_t = t_; } while (0)
#else
#define SCAN_STAMP(k) do { } while (0)
#endif
DI void phase_ml_scan(Frame& F) {
#if SCAN_PROBE
    unsigned long long acc_t[7] = {0, 0, 0, 0, 0, 0, 0}; unsigned long long last_t = __builtin_amdgcn_s_memtime();
#endif
    const bf16_t* XC = (const bf16_t*)(F.ws + R_XC); const bf16_t* V = (const bf16_t*)(F.ws + R_V); const float* GATES = (const float*)(F.ws + R_GATES);
    bf16_t* HF = (bf16_t*)(F.ws + R_XM); bf16_t* HBk = (bf16_t*)(F.ws + R_HBW);
    LAS unsigned char* L = F.lds;
    LAS float* vecA = (LAS float*)(L + SC_VEC);
    LAS float* vecM = vecA + 64;
    LAS float* vecI = vecA + 128;
    LAS float* vecW = vecA + 192;
    LAS float* vecRS = vecA + 256;
    LAS float* vecQN = vecA + 512;
    LAS float* vecN = vecA + 576;
    LAS float* vecS = vecA + 1088;
    LAS float* vecFL = vecA + 1152;
    LAS float* red = (LAS float*)(L + SC_Q);
    LAS float* nsum = (LAS float*)(L + SC_VEC + 4864);
    const int w = F.wave;
    const int etile = w & 3, dhalf = w >> 2;
    for (int unit = F.bid; unit < 256; unit += F.G) {
        const int chain = unit >> 2, es = unit & 3; const int b = chain >> 3, dir = (chain >> 2) & 1, head = chain & 3;
        bf16_t* HO = dir ? HBk : HF;
        f32x16 C[8];
#pragma unroll
        for (int t = 0; t < 8; ++t)
#pragma unroll
            for (int i = 0; i < 16; ++i) C[t][i] = 0.f;
        __syncthreads();
        vecN[F.tid] = 0.f; float nreg = 0.f;
        if (F.tid == 0) { vecS[1] = -INFINITY; }
        { const int j = F.tid >> 4, c4 = F.tid & 15; *(LAS unsigned*)(L + SC_S + j * SC_STR + 64 + 4 * c4) = 0u; if (F.tid < 32) vecRS[64 + F.tid] = 0.f; }
        u32x2 xr[16]; u32x4 vr[2]; float g_i = 0.f, g_f = 0.f;
        auto rowof = [&](int c, int p) -> int { const bool cx = c < 4; const int cc = cx ? c : c - 4; const int seglen = cx ? NCTX : SEQ; const int st = 64 * cc + p; const int segtok = dir ? (seglen - 1 - st) : st; return b * TPB + (cx ? 0 : NCTX) + segtok; };
        auto issue = [&](int c) {
            const bool cx = c < 4; const int cc = cx ? c : c - 4; const int seglen = cx ? NCTX : SEQ;
            const int R0 = b * TPB + (cx ? 0 : NCTX) + (dir ? (seglen - 1 - 64 * cc) : 64 * cc); const int sgn = dir ? -1 : 1;
            const int tid = opaque(F.tid);
            { const int l = tid & 63; const bf16_t* xp = XC + (ptrdiff_t)(R0 + sgn * (l & 15)) * ML_INNER + head * 512 + 64 * w + 4 * (l >> 4); const ptrdiff_t xstep = (ptrdiff_t)sgn * 16 * ML_INNER;
#pragma unroll
              for (int gi = 0; gi < 4; ++gi)
#pragma unroll
                for (int rb = 0; rb < 4; ++rb) xr[gi * 4 + rb] = *(const u32x2*)(xp + gi * 16 + rb * xstep); }
            const bf16_t* vp = V + (ptrdiff_t)(R0 + sgn * (tid >> 4)) * ML_INNER + head * 512 + es * 128 + 8 * (tid & 15); const ptrdiff_t vstep = (ptrdiff_t)sgn * 32 * ML_INNER;
            vr[0] = *(const u32x4*)vp; vr[1] = *(const u32x4*)(vp + vstep);
            if (w == 0) { const int row = R0 + sgn * tid; g_i = GATES[(size_t)row * 16 + dir * 8 + head]; g_f = GATES[(size_t)row * 16 + dir * 8 + 4 + head]; }
        };
        { const int l = hw_lane(); const int n = l & 15, kq = l >> 4; const bool nz = kq == (n >> 2);
          u32x4* frec = (u32x4*)(F.ws + WS_HB) + (size_t)(F.bid * 512 + w * 64 + l) * 4;
          u32x2 uq[4], uk[4];
#pragma unroll
          for (int gi = 0; gi < 4; ++gi) { const int wofs = (head * 128 + 4 * (4 * w + gi) + kq) * 16 + (n & 3);
              const float* pq = F.in[IN_MLWQ] + wofs; const float* pk = F.in[IN_MLWK] + wofs; const float qs = nz ? 0.044194173824159216f : 0.f, ks = nz ? 1.f : 0.f;
              uq[gi].x = pk2(pq[0] * qs, pq[4] * qs); uq[gi].y = pk2(pq[8] * qs, pq[12] * qs); uk[gi].x = pk2(pk[0] * ks, pk[4] * ks); uk[gi].y = pk2(pk[8] * ks, pk[12] * ks); }
          frec[0] = (u32x4){uq[0].x, uq[0].y, uq[1].x, uq[1].y}; frec[1] = (u32x4){uq[2].x, uq[2].y, uq[3].x, uq[3].y};
          frec[2] = (u32x4){uk[0].x, uk[0].y, uk[1].x, uk[1].y}; frec[3] = (u32x4){uk[2].x, uk[2].y, uk[3].x, uk[3].y};
          asm volatile("s_waitcnt vmcnt(0)" ::: "memory"); }
        issue(0);
        for (int c = 0; c < 68; ++c) {
            s16x4 aq[4], ak[4];
            { const int l = opaque(F.lane); const u32x4* frec = (const u32x4*)(F.ws + WS_HB) + (size_t)(F.bid * 512 + w * 64 + l) * 4;
              const u32x4 f0 = frec[0], f1 = frec[1], f2 = frec[2], f3 = frec[3];
              aq[0] = __builtin_bit_cast(s16x4, (u32x2){f0.x, f0.y}); aq[1] = __builtin_bit_cast(s16x4, (u32x2){f0.z, f0.w}); aq[2] = __builtin_bit_cast(s16x4, (u32x2){f1.x, f1.y}); aq[3] = __builtin_bit_cast(s16x4, (u32x2){f1.z, f1.w});
              ak[0] = __builtin_bit_cast(s16x4, (u32x2){f2.x, f2.y}); ak[1] = __builtin_bit_cast(s16x4, (u32x2){f2.z, f2.w}); ak[2] = __builtin_bit_cast(s16x4, (u32x2){f3.x, f3.y}); ak[3] = __builtin_bit_cast(s16x4, (u32x2){f3.z, f3.w}); }
            __syncthreads();
            for (int rp_ = 0; rp_ < ((SCAN_DUP & 1) ? 2 : 1); ++rp_) {
                const int tid = opaque(F.tid);
                { const int l = tid & 63; const int row = l & 15, nq = l >> 4; const int pq_ = (nq == 1) ? 2 : (nq == 2) ? 1 : nq;
                  const int base = row * 1024 + ((((8 * w) | (pq_ >> 1)) ^ gsw(row)) << 4) + ((pq_ & 1) << 3);
#pragma unroll
                  for (int gi = 0; gi < 4; ++gi)
#pragma unroll
                    for (int rb = 0; rb < 4; ++rb) {
                        const s16x4 xb = __builtin_bit_cast(s16x4, xr[gi * 4 + rb]);
                        const f32x4 dq = __builtin_amdgcn_mfma_f32_16x16x16bf16_1k(aq[gi], xb, (f32x4){0.f, 0.f, 0.f, 0.f}, 0, 0, 0);
                        const f32x4 dk = __builtin_amdgcn_mfma_f32_16x16x16bf16_1k(ak[gi], xb, (f32x4){0.f, 0.f, 0.f, 0.f}, 0, 0, 0);
                        u32x2 qq; qq.x = pk2(dq[0], dq[1]); qq.y = pk2(dq[2], dq[3]); u32x2 kk; kk.x = pk2(dk[0], dk[1]); kk.y = pk2(dk[2], dk[3]);
                        const int off = (base ^ ((2 * gi) << 4)) + rb * 16384; *(LAS u32x2*)(L + SC_Q + off) = qq; *(LAS u32x2*)(L + SC_K + off) = kk; } }
#pragma unroll
                for (int i = 0; i < 2; ++i) { const int id = tid + 512 * i; const int p = id >> 4, ch = id & 15; *(LAS u32x4*)(L + SC_V + p * 256 + ((ch ^ gsw(p)) << 4)) = vr[i]; }
            }
            if (w == 0) {
                const int lane = opaque(F.lane);
                const float ig = g_i, lf = g_f;
                float bc = lf;
#pragma unroll
                for (int o = 1; o < 64; o <<= 1) { const float t = __shfl_up(bc, o); if (lane >= o) bc += t; }
                const float a = ig - bc; float pm = a;
#pragma unroll
                for (int o = 1; o < 64; o <<= 1) { const float t = __shfl_up(pm, o); if (lane >= o) pm = fmaxf(pm, t); }
                const float mprev = vecS[1];
                const float M = fmaxf(mprev, pm);
                const float M63 = __shfl(M, 63), blast = __shfl(bc, 63);
                vecA[lane] = a; vecM[lane] = M; vecI[lane] = fast_exp(mprev - M); vecW[lane] = fast_exp(a - M63);
                vecFL[lane] = fast_exp(-(bc + M));
                if (lane == 0) { vecS[0] = fast_exp(mprev - M63); vecS[2] = blast + M63; }
            }
            __syncthreads();
            __builtin_amdgcn_sched_barrier(0);
            for (int rp_ = 0; rp_ < ((SCAN_DUP & 2) ? 2 : 1); ++rp_) {
            {
                const int tid = opaque(F.tid);
                const int j = tid >> 3, part = tid & 7; float s = 0.f;
#pragma unroll
                for (int cc = 0; cc < 8; ++cc) { const int chunk = cc * 8 + part;
                    const u32x4 u = *(const LAS u32x4*)(L + SC_Q + qk_chunk(j, chunk));
                    const int grp = chunk >> 1, hq = chunk & 1; const int d0 = grp * 16 + (hq ? 4 : 0), d1 = grp * 16 + (hq ? 12 : 8);
                    const f32x4 n0 = *(const LAS f32x4*)(vecN + d0), n1 = *(const LAS f32x4*)(vecN + d1);
                    s += bflo(u.x) * n0[0] + bfhi(u.x) * n0[1] + bflo(u.y) * n0[2] + bfhi(u.y) * n0[3];
                    s += bflo(u.z) * n1[0] + bfhi(u.z) * n1[1] + bflo(u.w) * n1[2] + bfhi(u.w) * n1[3]; }
                s += __shfl_xor(s, 1); s += __shfl_xor(s, 2); s += __shfl_xor(s, 4);
                if (part == 0) vecQN[j] = s;
            }
            __builtin_amdgcn_sched_barrier(0);
            if (w >= 4) {
                const int t2 = opaque(F.tid) - 256; const int qd = t2 >> 1, par = t2 & 1; f32x4 acc = {0.f, 0.f, 0.f, 0.f};
#pragma unroll 8
                for (int i = 0; i < 32; ++i) { const int s_ = 2 * i + par; const u32x2 kv = *(const LAS u32x2*)(L + SC_K + qk_off(s_, qd)); const float ws_ = vecW[s_];
                    acc[0] += ws_ * bflo(kv.x); acc[1] += ws_ * bfhi(kv.x); acc[2] += ws_ * bflo(kv.y); acc[3] += ws_ * bfhi(kv.y); }
#pragma unroll
                for (int i = 0; i < 4; ++i) acc[i] += __shfl_xor(acc[i], 1);
                if (par == 0) *(LAS f32x4*)(nsum + 4 * qd) = acc;
            }
            if (w < 3) {
                const int lane = opaque(F.lane); const int r32 = lane & 31, hh = lane >> 5;
                const int jb = (w == 0) ? 0 : 1, sb = (w == 2) ? 1 : 0;
                const int srow = 32 * sb + r32, jrow = 32 * jb + r32;
                f32x16 g0, g1;
#pragma unroll
                for (int i = 0; i < 16; ++i) { g0[i] = 0.f; g1[i] = 0.f; }
                const int kbase = SC_K + srow * 1024, qbase = SC_Q + jrow * 1024; const int gk = gsw(srow), gq = gsw(jrow);
                bf16x8 ca0 = *(const LAS bf16x8*)(L + kbase + (((0 + hh) ^ gk) << 4)), cb0 = *(const LAS bf16x8*)(L + qbase + (((0 + hh) ^ gq) << 4));
                bf16x8 ca1 = *(const LAS bf16x8*)(L + kbase + (((2 + hh) ^ gk) << 4)), cb1 = *(const LAS bf16x8*)(L + qbase + (((2 + hh) ^ gq) << 4));
#pragma unroll
                for (int it = 0; it < 16; ++it) {
                    bf16x8 na0 = ca0, nb0 = cb0, na1 = ca1, nb1 = cb1;
                    if (it + 1 < 16) { const int c0 = 4 * (it + 1) + hh;
                        na0 = *(const LAS bf16x8*)(L + kbase + ((c0 ^ gk) << 4)); nb0 = *(const LAS bf16x8*)(L + qbase + ((c0 ^ gq) << 4));
                        na1 = *(const LAS bf16x8*)(L + kbase + (((c0 + 2) ^ gk) << 4)); nb1 = *(const LAS bf16x8*)(L + qbase + (((c0 + 2) ^ gq) << 4)); }
                    g0 = mfma32(ca0, cb0, g0); g1 = mfma32(ca1, cb1, g1);
                    ca0 = na0; cb0 = nb0; ca1 = na1; cb1 = nb1;
                }
                const float Mj = vecM[jrow]; float rs = 0.f;
#pragma unroll
                for (int g = 0; g < 4; ++g) {
                    const int s0 = 32 * sb + 8 * g + 4 * hh; const f32x4 av = *(const LAS f32x4*)(vecA + s0); float sc[4];
#pragma unroll
                    for (int i = 0; i < 4; ++i) { const float dm = (s0 + i <= jrow) ? fast_exp(av[i] - Mj) : 0.f; sc[i] = (g0[4 * g + i] + g1[4 * g + i]) * dm; rs += sc[i]; }
                    u32x2 pkv; pkv.x = pk2(sc[0], sc[1]); pkv.y = pk2(sc[2], sc[3]);
                    *(LAS u32x2*)(L + SC_S + jrow * SC_STR + s0 * 2) = pkv;
                }
                rs = xhalf_sum(rs);
                if (hh == 0) vecRS[sb * 64 + jrow] = rs;
            }
            }
            __syncthreads();
            __builtin_amdgcn_sched_barrier(0);
            f32x16 O[2];
            for (int rp_ = 0; rp_ < ((SCAN_DUP & 4) ? 2 : 1); ++rp_) {
#pragma unroll
            for (int jb = 0; jb < 2; ++jb)
#pragma unroll
                for (int i = 0; i < 16; ++i) O[jb][i] = 0.f;
                const int lane = opaque(F.lane); const int r32 = lane & 31, hh = lane >> 5;
#pragma unroll
                for (int t = 0; t < 8; ++t) {
#pragma unroll
                    for (int s2 = 0; s2 < 2; ++s2) {
                        const bf16x8 xs = pack_step(C[t], s2);
                        const int chunk = (dhalf * 256 + 32 * t + 16 * s2) / 8 + hh;
#pragma unroll
                        for (int jb = 0; jb < 2; ++jb) { const bf16x8 qb = *(const LAS bf16x8*)(L + SC_Q + qk_chunk(32 * jb + r32, chunk)); O[jb] = mfma32(xs, qb, O[jb]); }
                    }
                    if (t & 1) __builtin_amdgcn_sched_barrier(0);
                }
#pragma unroll
                for (int jb = 0; jb < 2; ++jb) { const float it = vecI[32 * jb + r32];
#pragma unroll
                    for (int i = 0; i < 16; ++i) O[jb][i] *= it; }
                const int i16 = lane & 15, tq = i16 >> 2, tp = i16 & 3, blk = (lane >> 4) & 1;
#pragma unroll
                for (int ks = 0; ks < 2; ++ks) {
                    const int s0 = 32 * dhalf + 16 * ks + 8 * hh;
                    const int qd = (32 * etile + 16 * blk + 4 * tp) >> 2;
                    const s16x4 lo = tr_read(L + SC_V + v_off(s0 + tq, qd)), hi = tr_read(L + SC_V + v_off(s0 + 4 + tq, qd));
                    const bf16x8 af = cat4(lo, hi);
#pragma unroll
                    for (int jb = 0; jb < 2; ++jb) { const bf16x8 sb = *(const LAS bf16x8*)(L + SC_S + (32 * jb + r32) * SC_STR + (32 * dhalf + 16 * ks + 8 * hh) * 2); O[jb] = mfma32(af, sb, O[jb]); }
                }
            }
            __syncthreads();
            __builtin_amdgcn_sched_barrier(0);
            {
                const int lane = opaque(F.lane);
#pragma unroll
                for (int i = 0; i < 16; ++i) red[((etile * 2 + dhalf) * 16 + i) * 64 + lane] = dhalf ? O[0][i] : O[1][i];
            }
            __syncthreads();
            __builtin_amdgcn_sched_barrier(0);
            {
                const int lane = opaque(F.lane); const int r32 = lane & 31, hh = lane >> 5;
                const int j = 32 * dhalf + r32;
                const float den = vecI[j] * vecQN[j] + (vecRS[j] + vecRS[64 + j]);
                const float dinv = 1.0f / fmaxf(fabsf(den), vecFL[j]);
                bf16_t* op = HO + (size_t)rowof(c, j) * ML_INNER + head * 512 + es * 128 + etile * 32 + 4 * hh;
#pragma unroll
                for (int g = 0; g < 4; ++g) { float v[4];
#pragma unroll
                    for (int i = 0; i < 4; ++i) v[i] = ((dhalf ? O[1][4 * g + i] : O[0][4 * g + i]) + red[((etile * 2 + (1 - dhalf)) * 16 + 4 * g + i) * 64 + lane]) * dinv;
                    u32x2 wv; wv.x = pk2(v[0], v[1]); wv.y = pk2(v[2], v[3]); *(u32x2*)(op + 8 * g) = wv; }
            }
            __builtin_amdgcn_sched_barrier(0);
            SCAN_STAMP(0);
            if (c + 1 < 68) issue(c + 1);
            __builtin_amdgcn_sched_barrier(0);
            SCAN_STAMP(1);
            float decay_keep;
            {
                const float decay = vecS[0]; decay_keep = decay;
                const float ndep = decay;
            __builtin_amdgcn_sched_barrier(0);
                int lane = opaque_dep(F.lane, ndep);
#pragma unroll
                for (int t = 0; t < 8; ++t)
#pragma unroll
                    for (int i = 0; i < 16; ++i) C[t][i] *= decay;
                bf16x8 vf[4];
                {
                    const int hh = lane >> 5, i16 = lane & 15, tq = i16 >> 2, tp = i16 & 3, blk = (lane >> 4) & 1;
#pragma unroll
                    for (int ks = 0; ks < 4; ++ks) {
                        const int s0 = 16 * ks + 8 * hh; const int qd = (32 * etile + 16 * blk + 4 * tp) >> 2;
                        const s16x4 lo = tr_read(L + SC_V + v_off(s0 + tq, qd)), hi = tr_read(L + SC_V + v_off(s0 + 4 + tq, qd));
                        const f32x4 w0 = *(const LAS f32x4*)(vecW + s0), w1 = *(const LAS f32x4*)(vecW + s0 + 4);
                        u32x4 pkv;
                        pkv.x = pk2(bf2f((bf16_t)lo[0]) * w0[0], bf2f((bf16_t)lo[1]) * w0[1]); pkv.y = pk2(bf2f((bf16_t)lo[2]) * w0[2], bf2f((bf16_t)lo[3]) * w0[3]);
                        pkv.z = pk2(bf2f((bf16_t)hi[0]) * w1[0], bf2f((bf16_t)hi[1]) * w1[1]); pkv.w = pk2(bf2f((bf16_t)hi[2]) * w1[2], bf2f((bf16_t)hi[3]) * w1[3]);
                        vf[ks] = __builtin_bit_cast(bf16x8, pkv);
                    }
                }
                __builtin_amdgcn_sched_barrier(0);
            SCAN_STAMP(3);
#pragma unroll
                for (int t = 0; t < 8; ++t) {
                    if (t >= 3) lane = opaque_dep(lane, C[t - 3][0]);
                    const int hh = lane >> 5, i16 = lane & 15, tq = i16 >> 2, tp = i16 & 3, blk = (lane >> 4) & 1;
                    const int qd = (dhalf * 256 + 32 * t + 16 * blk + 4 * tp) >> 2;
#pragma unroll
                    for (int ks = 0; ks < 4; ++ks) {
                        const int s0 = 16 * ks + 8 * hh;
                        const s16x4 lo = tr_read(L + SC_K + qk_off(s0 + tq, qd)), hi = tr_read(L + SC_K + qk_off(s0 + 4 + tq, qd));
                        C[t] = mfma32(cat4(lo, hi), vf[ks], C[t]);
                    }
                }
            }
            SCAN_STAMP(4);
            __syncthreads();
            SCAN_STAMP(5);
            nreg = nreg * decay_keep + nsum[F.tid];
            vecN[F.tid] = nreg;
            if (F.tid == 0) vecS[1] = vecS[2];
        }
    }
#if SCAN_PROBE
    if (F.bid == 0 && F.tid == 0) { unsigned long long tot = 0; for (int k = 0; k < 7; ++k) tot += acc_t[k]; ((float*)(F.ws + WS_CTL))[2048] = floorf(16.0f * (float)acc_t[SCAN_PROBE - 1] / (float)tot + 0.5f) / 16.0f; }
#endif
}

DI void phase_ml_finish(Frame& F) {
    const bf16_t* HF = (const bf16_t*)(F.ws + R_XM); const bf16_t* HBk = (const bf16_t*)(F.ws + R_HBW); const bf16_t* Z = (const bf16_t*)(F.ws + R_Z); bf16_t* XC = (bf16_t*)(F.ws + R_XC);
    const int gw = F.bid * 8 + F.wave, NGW = F.G * 8, lane = F.lane;
    f32x4 gwc[4][2], skc[4][2];
#pragma unroll
    for (int hd = 0; hd < 4; ++hd)
#pragma unroll
        for (int q = 0; q < 2; ++q) { gwc[hd][q] = *(const f32x4*)(F.in[IN_MLGNW] + hd * 512 + 8 * lane + 4 * q); skc[hd][q] = *(const f32x4*)(F.in[IN_MLSKIP] + hd * 512 + 8 * lane + 4 * q); }
    u32x4 nx[4][4];
    auto load_row = [&](int r) {
#pragma unroll
        for (int hd = 0; hd < 4; ++hd) { const size_t off = (size_t)r * ML_INNER + hd * 512 + 8 * lane;
            nx[hd][0] = *(const u32x4*)(HF + off); nx[hd][1] = *(const u32x4*)(HBk + off); nx[hd][2] = *(const u32x4*)(Z + off); nx[hd][3] = *(const u32x4*)(XC + off); }
    };
    if (gw < T) load_row(gw);
    for (int r = gw; r < T; r += NGW) {
        u32x4 cur[4][4];
#pragma unroll
        for (int hd = 0; hd < 4; ++hd)
#pragma unroll
            for (int q = 0; q < 4; ++q) cur[hd][q] = nx[hd][q];
        if (r + NGW < T) load_row(r + NGW);
#pragma unroll
        for (int hd = 0; hd < 4; ++hd) {
            const size_t off = (size_t)r * ML_INNER + hd * 512 + 8 * lane;
            const u32x4 a = cur[hd][0], bq = cur[hd][1], zc = cur[hd][2], xq = cur[hd][3];
            float h[8];
            h[0] = bflo(a.x) + bflo(bq.x); h[1] = bfhi(a.x) + bfhi(bq.x); h[2] = bflo(a.y) + bflo(bq.y); h[3] = bfhi(a.y) + bfhi(bq.y);
            h[4] = bflo(a.z) + bflo(bq.z); h[5] = bfhi(a.z) + bfhi(bq.z); h[6] = bflo(a.w) + bflo(bq.w); h[7] = bfhi(a.w) + bfhi(bq.w);
            float s = 0.f;
#pragma unroll
            for (int i = 0; i < 8; ++i) s += h[i];
            const float mu = wave_sum(s) * (1.0f / 512.0f); float q = 0.f;
#pragma unroll
            for (int i = 0; i < 8; ++i) { h[i] -= mu; q += h[i] * h[i]; }
            const float rstd = 1.0f / sqrtf(wave_sum(q) * (1.0f / 512.0f) + EPS);
            float zf[8], xf[8];
            zf[0] = bflo(zc.x); zf[1] = bfhi(zc.x); zf[2] = bflo(zc.y); zf[3] = bfhi(zc.y); zf[4] = bflo(zc.z); zf[5] = bfhi(zc.z); zf[6] = bflo(zc.w); zf[7] = bfhi(zc.w);
            xf[0] = bflo(xq.x); xf[1] = bfhi(xq.x); xf[2] = bflo(xq.y); xf[3] = bfhi(xq.y); xf[4] = bflo(xq.z); xf[5] = bfhi(xq.z); xf[6] = bflo(xq.w); xf[7] = bfhi(xq.w);
            float o[8];
#pragma unroll
            for (int i = 0; i < 8; ++i) o[i] = (h[i] * rstd * gwc[hd][i >> 2][i & 3] + skc[hd][i >> 2][i & 3] * xf[i]) * silu_f(zf[i]);
            u32x2 wv; wv.x = pk4_fp8(o[0], o[1], o[2], o[3]); wv.y = pk4_fp8(o[4], o[5], o[6], o[7]);
            *(u32x2*)(F.ws + R_V + off) = wv;
        }
    }
}

__global__ void __launch_bounds__(512, 2) mk_fwd(Args args) {
    extern __shared__ __attribute__((aligned(16))) unsigned char lds_raw[];
    Frame F;
    F.lds = (LAS unsigned char*)lds_raw; F.ws = args.ws; F.in = args.in; F.out = args.out;
    F.wave = __builtin_amdgcn_readfirstlane((int)threadIdx.x >> 6); F.lane = hw_lane(); F.tid = F.wave * 64 + F.lane; F.G = gridDim.x; F.bid = blockIdx.x;
    volatile LAS unsigned* lctl = (volatile LAS unsigned*)(F.lds + LDS_CTL);
    if (F.tid < 64) lctl[F.tid] = 0u;
    __syncthreads();
    unsigned* ctl = (unsigned*)(F.ws + WS_CTL);
    XcdBarrier bar; bar.bar = ctl + CW_BAR; bar.x = 0; bar.st = nullptr;
    if (!MK_PER_PHASE) bar = xcd_barrier_post(ctl + CW_BAR, lctl, F.tid == 0);
    const int lo = args.ph_lo, hi = args.ph_hi;
    int ph = 0;
    if (PHASE_PROBE >= 0) lctl[10] = (unsigned)__builtin_amdgcn_s_memrealtime();
#define NREP_(p) ((((unsigned long long)(MK_DUP) >> (p)) & 1ull) ? 2 : 1)
#define PHASE_BEGIN if (lo <= ph && ph < hi && ph <= MK_LAST_PHASE && (MK_ONLY < 0 || ph == MK_ONLY)) { if (PHASE_PROBE == ph) lctl[8] = (unsigned)__builtin_amdgcn_s_memrealtime(); for (int rep_ = 0; rep_ < NREP_(ph); ++rep_) { F.lane = hw_lane(); F.tid = F.wave * 64 + F.lane;
#define PHASE_END   if (!MK_PER_PHASE && (ph + 1 < hi || rep_ + 1 < NREP_(ph))) { const int l0 = hw_lane(); xcd_barrier(bar, F.wave == 0 && l0 == 0); } } if (PHASE_PROBE == ph) lctl[9] = (unsigned)__builtin_amdgcn_s_memrealtime() - lctl[8]; } ++ph;

    bf16_t* HB = (bf16_t*)(F.ws + WS_HB);
    bf16_t* XS = (bf16_t*)(F.ws + WS_XS);
    const float* modv = (const float*)(F.ws + WS_MODV);
    LAS int* tbl = (LAS int*)(F.lds + pg8::STAGE_BYTES);

    PHASE_BEGIN phase_prologue(F); PHASE_END

#define MOE_BLOCK(layer) \
    PHASE_BEGIN phase_norm2_router(F, layer); PHASE_END \
    PHASE_BEGIN { const int ntl = moe_build_table(F, layer, tbl); \
        MoeOrder S; S.G = F.G; S.c = F.bid; S.ntiles = ntl; S.K = D / 2; S.A = (const char*)(F.ws + WS_HB8); S.Bt = (const char*)(F.ws + WS_WMOE13); S.bstride = (size_t)1024 * D; \
        S.idx = (const int*)(F.ws + WS_ROUTE + 2 * MiB); S.gather = true; S.tbl = tbl; S.xcdmap = moe_xcd_balanced(F, tbl, ntl); \
        pg8::EpiMoE1 E{F.ws + R_HMID}; pg8::gemm_phase<pg8::EpiMoE1, MoeOrder, true>(F.lds, D / 2, S, E, F.tid); } PHASE_END \
    PHASE_BEGIN { const int ntl = moe_build_table(F, layer, tbl); \
        MoeOrder S; S.G = F.G; S.c = F.bid; S.ntiles = ntl; S.K = MOE_H / 2; S.A = (const char*)(F.ws + R_HMID); S.Bt = (const char*)(F.ws + WS_WMOE2); S.bstride = (size_t)1024 * MOE_H; \
        S.idx = nullptr; S.gather = false; S.tbl = tbl; S.xcdmap = moe_xcd_balanced(F, tbl, ntl); \
        pg8::EpiMoE2 E{F.ws + R_Y}; pg8::gemm_phase<pg8::EpiMoE2, MoeOrder, true>(F.lds, MOE_H / 2, S, E, F.tid); } PHASE_END

#define GEMM_DENSE8X(SKIP, Aptr, Wptr, N_, K_, EPI_T, ...) { pg8::DenseOrder S; S.init((const bf16_t*)(Aptr), (const bf16_t*)(Wptr), T, N_, (K_) / 2, F.G, F.bid, SKIP); EPI_T E{__VA_ARGS__}; pg8::gemm_phase<EPI_T, pg8::DenseOrder, true>(F.lds, (K_) / 2, S, E, F.tid); }
#define GEMM_DENSE8(...) GEMM_DENSE8X(0, __VA_ARGS__)
#define GEMM_DENSE(Aptr, Wptr, N_, K_, EPI_T, ...) { pg8::DenseOrder S; S.init((const bf16_t*)(Aptr), (const bf16_t*)(Wptr), T, N_, K_, F.G, F.bid); EPI_T E{__VA_ARGS__}; pg8::gemm_phase<EPI_T, pg8::DenseOrder>(F.lds, K_, S, E, F.tid); }

    PHASE_BEGIN phase_modulate<0>(F, 0); PHASE_END
    PHASE_BEGIN GEMM_DENSE8(F.ws + WS_HB8, F.ws + WS_WNAQKV, 3072, D, pg8::EpiBf16, (bf16_t*)(F.ws + R_QKV), 3072, 0, 0, 4, 0.125f * 1.4426950408889634f, 1.0f / 32.0f)
        in_gemm_tail(F, (T / 256) * 12, [&](int g0, int ng, LAS float* scr) { convert_matrix(F, F.in[IN_MLUP], D, 4096, (bf16_t*)(F.ws + WS_WMLUP), g0, ng, scr); }); PHASE_END
    PHASE_BEGIN phase_na_attn(F, 0, true); PHASE_END
    PHASE_BEGIN GEMM_DENSE8(F.ws + R_AO, F.ws + WS_WNAO, D, D, pg8::EpiResid, XS, modv + (size_t)0 * 9 * 6144 + 2048, 1.0f / 32.0f) convert_moe_in_tail(F, 0, (T / 256) * (D / 256)); PHASE_END
    MOE_BLOCK(0)
    PHASE_BEGIN phase_modulate<1>(F, 1); PHASE_END
    PHASE_BEGIN GEMM_DENSE(HB, F.ws + WS_WMLUP, 4096, D, pg8::EpiBf16, (bf16_t*)(F.ws + R_XM), ML_INNER, ML_INNER, (size_t)(R_Z - R_XM) / 2, 0, 1.0f, 1.0f)
        in_gemm_tail(F, (T / 256) * 16, [&](int g0, int ng, LAS float* scr) { convert_matrix_fp8(F, F.in[IN_MLDOWN], ML_INNER, D, F.ws + WS_WMLDN, g0, ng, scr); convert_matrix_fp8(F, F.in[IN_DAQKV], D, 3072, F.ws + WS_WDAQKV, g0, ng, scr); }); PHASE_END
    PHASE_BEGIN phase_ml_prep(F); PHASE_END
    PHASE_BEGIN phase_ml_scan(F); PHASE_END
    PHASE_BEGIN phase_ml_finish(F); PHASE_END
    PHASE_BEGIN GEMM_DENSE8(F.ws + R_V, F.ws + WS_WMLDN, D, ML_INNER, pg8::EpiResid, XS, modv + (size_t)1 * 9 * 6144 + 2048, 1.0f / 32.0f) convert_moe_in_tail(F, 1, (T / 256) * (D / 256));
        in_gemm_tail(F, (T / 256) * (D / 256), [&](int g0, int ng, LAS float* scr) { convert_matrix_fp8(F, F.in[IN_DAO], D, D, F.ws + WS_WDAO, g0, ng, scr);
            convert_matrix_fp8(F, F.in[IN_NAQKV] + (size_t)D * 3072, D, 3072, F.ws + WS_WNAQKV + (size_t)3072 * D, g0, ng, scr); convert_matrix_fp8(F, F.in[IN_NAO] + (size_t)D * D, D, D, F.ws + WS_WNAO + (size_t)D * D, g0, ng, scr); }); PHASE_END
    MOE_BLOCK(1)
    PHASE_BEGIN phase_modulate<1>(F, 2); PHASE_END
    PHASE_BEGIN GEMM_DENSE8(F.ws + WS_HB8, F.ws + WS_WDAQKV, 3072, D, pg8::EpiBf16Rope, (bf16_t*)(F.ws + R_QKV), (const float*)(F.ws + WS_MISC + 768 * 1024), 1.0f / 32.0f) PHASE_END
    PHASE_BEGIN phase_da_attn(F, true); PHASE_END
    PHASE_BEGIN GEMM_DENSE8(F.ws + R_AO, F.ws + WS_WDAO, D, D, pg8::EpiResid, XS, modv + (size_t)2 * 9 * 6144 + 2048, 1.0f / 32.0f) convert_moe_in_tail(F, 2, (T / 256) * (D / 256)); PHASE_END
    MOE_BLOCK(2)
    PHASE_BEGIN phase_modulate<1>(F, 3); { LAS float* scr = (LAS float*)(F.lds + F.wave * 16384); __syncthreads(); convert_moe(F, 3, F.bid * 8 + F.wave, F.G * 8, scr); } PHASE_END
    PHASE_BEGIN GEMM_DENSE8(F.ws + WS_HB8, F.ws + WS_WNAQKV + (size_t)3072 * D, 3072, D, pg8::EpiBf16, (bf16_t*)(F.ws + R_QKV), 3072, 0, 0, 4, 0.125f * 1.4426950408889634f, 1.0f / 32.0f) PHASE_END
    PHASE_BEGIN phase_na_attn(F, 1, false); PHASE_END
    PHASE_BEGIN GEMM_DENSE8X(1, F.ws + R_AO, F.ws + WS_WNAO + (size_t)D * D, D, D, pg8::EpiResid, XS, modv + (size_t)3 * 9 * 6144 + 2048, 1.0f / 32.0f) PHASE_END
    MOE_BLOCK(3)
    if (PHASE_PROBE >= 0 && F.bid == 0) { const float fr = (float)lctl[9] / (float)((unsigned)__builtin_amdgcn_s_memrealtime() - lctl[10]); ((float*)(F.ws + WS_CTL))[2048] = 0.04f * fr; }
    if (PHASE_PROBE >= 0) __syncthreads();
    if (lo <= ph && ph < hi) { F.lane = hw_lane(); F.tid = F.wave * 64 + F.lane; phase_modulate<3>(F, 3); } ++ph;
}
constexpr int N_PHASES = 1 + 7 + 9 + 7 + 7 + 1;

extern "C" void kernel_launch(void* const* d_in, const int* in_sizes, int n_in, void* d_out, int out_size, void* d_ws, size_t ws_size, hipStream_t stream) {
    static int grid = 0;
    if (grid == 0) {
        if (n_in != 33 || ws_size < WS_END) { fprintf(stderr, "kernel_launch: unexpected n_in %d or ws_size %zu (< %zu)\n", n_in, ws_size, (size_t)WS_END); grid = -1; return; }
        int dev = 0, cus = 0;
        if (hipGetDevice(&dev) != hipSuccess || hipDeviceGetAttribute(&cus, hipDeviceAttributeMultiprocessorCount, dev) != hipSuccess) { grid = -1; return; }
        if (hipFuncSetAttribute((const void*)mk_fwd, hipFuncAttributeMaxDynamicSharedMemorySize, LDS_BYTES) != hipSuccess) { fprintf(stderr, "kernel_launch: hipFuncSetAttribute failed\n"); grid = -1; return; }
        int per_cu = 0;
        if (hipOccupancyMaxActiveBlocksPerMultiprocessor(&per_cu, (const void*)mk_fwd, 512, LDS_BYTES) != hipSuccess || per_cu < 1) fprintf(stderr, "kernel_launch: occupancy query says %d\n", per_cu);
        (void)hipGetLastError();
        grid = cus;
    }
    if (grid < 0) return;
    (void)hipMemsetAsync((char*)d_ws + WS_CTL, 0, CTL_BYTES, stream);
    Args a{};
    for (int i = 0; i < 33; ++i) a.in[i] = (const float*)d_in[i];
    a.out = (float*)d_out; a.ws = (unsigned char*)d_ws;
#if MK_PER_PHASE
    for (int p = 0; p < N_PHASES; ++p) { a.ph_lo = p; a.ph_hi = p + 1; hipLaunchKernelGGL(mk_fwd, dim3(grid), dim3(512), LDS_BYTES, stream, a); }
#else
    a.ph_lo = 0; a.ph_hi = N_PHASES;
    hipLaunchKernelGGL(mk_fwd, dim3(grid), dim3(512), LDS_BYTES, stream, a);
#endif
}
```
